# Optimizing an MI355X kernel written in HIP

```python
import jax, jax.numpy as jnp
from jax import lax
import numpy as np

D_MODEL = 1024
BATCH = 8
SEQ = 8192
DEPTH = 4

CHUNK = 64
P_DIM = 256
G_WIDTH = 1024
G_GROUPS = 8
G_GROUP_DIM = G_WIDTH // G_GROUPS
G_BLOCK = 128
M_HEADS = 4
M_QK_DIM = 128
M_V_DIM = 256
M_QK = M_HEADS * M_QK_DIM
M_V = M_HEADS * M_V_DIM
M_CHUNK = CHUNK
FORGET_BIAS = 3.0
N_EXPERTS = 64
TOP_K = 8
N_GROUPS = 8
TOPK_GROUPS = 4
D_EXPERT = 256
D_SHARED = 256
ROUTE_SCALE = 2.5
MOE_POS_BLOCK = 128
ALPHA = (2 * DEPTH) ** 0.25
BETA = (8 * DEPTH) ** -0.25
LN_EPS = 1e-5
RMS_EPS = 1e-6
D_IN = 2 * G_WIDTH + 2 * M_QK + 2 * M_V + 2 * M_HEADS + 2 * D_MODEL
SPLIT_POINTS = (
    G_WIDTH,
    2 * G_WIDTH,
    2 * G_WIDTH + M_QK,
    2 * G_WIDTH + 2 * M_QK,
    2 * G_WIDTH + 2 * M_QK + M_V,
    2 * G_WIDTH + 2 * M_QK + 2 * M_V,
    2 * G_WIDTH + 2 * M_QK + 2 * M_V + M_HEADS,
    2 * G_WIDTH + 2 * M_QK + 2 * M_V + 2 * M_HEADS,
    2 * G_WIDTH + 2 * M_QK + 2 * M_V + 2 * M_HEADS + D_MODEL,
)
F_OFF = 2 * G_WIDTH + 2 * M_QK + 2 * M_V + M_HEADS

kernel_name = "hybrid_gmlp_mlstm_moe_deepnorm"


def layer_norm(x, g, b):
    xf = x.astype(jnp.float32)
    mu = jnp.mean(xf, -1, keepdims=True)
    var = jnp.mean(jnp.square(xf - mu), -1, keepdims=True)
    return ((xf - mu) * lax.rsqrt(var + LN_EPS) * g + b).astype(x.dtype)


def spatial_gating(u, v, ln_g, ln_b, w_s, b_s):
    B, S, _ = v.shape
    v = layer_norm(v, ln_g, ln_b)
    v = v.reshape(B, S // G_BLOCK, G_BLOCK, G_GROUPS, G_GROUP_DIM)
    pos = jnp.arange(G_BLOCK)
    mask = (pos[None, :] // CHUNK) <= (pos[:, None] // CHUNK)
    w = jnp.where(mask[None], w_s, jnp.zeros((), w_s.dtype))
    mixed = jnp.einsum('gts,bnsgc->bntgc', w, v) + b_s.T[None, None, :, :, None]
    return u * mixed.reshape(B, S, G_WIDTH)


def mlstm_chunkwise(q, k, v, i_pre, f_pre):
    B, S, H, _ = q.shape
    L = M_CHUNK
    NC = S // L

    def to_chunks(t):
        t = t.reshape((B, NC, L, H) + t.shape[3:])
        return jnp.moveaxis(t, (1, 3), (0, 2))

    q = q * (M_QK_DIM ** -0.5)
    lf = jax.nn.log_sigmoid(f_pre)
    xs = (to_chunks(q), to_chunks(k), to_chunks(v), to_chunks(i_pre), to_chunks(lf))
    tri = jnp.tril(jnp.ones((L, L), dtype=bool))

    def step(carry, inp):
        C, n, m = carry
        qb, kb, vb, li, lfb = inp
        b = jnp.cumsum(lfb, axis=-1)
        d = b[..., :, None] - b[..., None, :] + li[..., None, :]
        d = jnp.where(tri, d, -jnp.inf)
        inter = b + m[..., None]
        m_t = jnp.maximum(inter, jnp.max(d, -1))
        w_intra = jnp.exp(d - m_t[..., None])
        w_inter = jnp.exp(inter - m_t)
        s = jnp.einsum('bhtd,bhsd->bhts', qb, kb) * w_intra
        num = (jnp.einsum('bhts,bhsv->bhtv', s, vb)
               + w_inter[..., None] * jnp.einsum('bhtd,bhdv->bhtv', qb, C))
        den = jnp.sum(s, -1) + w_inter * jnp.einsum('bhtd,bhd->bht', qb, n)
        h = num / jnp.maximum(jnp.abs(den), jnp.exp(-m_t))[..., None]
        b_last = b[..., -1]
        g = b_last[..., None] - b + li
        m_new = jnp.maximum(b_last + m, jnp.max(g, -1))
        decay = jnp.exp(b_last + m - m_new)
        wk = jnp.exp(g - m_new[..., None])[..., None] * kb
        C = decay[..., None, None] * C + jnp.einsum('bhsd,bhsv->bhdv', wk, vb)
        n = decay[..., None] * n + jnp.sum(wk, -2)
        return (C, n, m_new), h

    init = (jnp.zeros((B, H, M_QK_DIM, M_V_DIM), jnp.float32),
            jnp.zeros((B, H, M_QK_DIM), jnp.float32),
            jnp.zeros((B, H), jnp.float32))
    _, h = lax.scan(step, init, xs)
    return jnp.moveaxis(h, (0, 2), (1, 3)).reshape(B, S, H, M_V_DIM)


def token_mixer(x, w_in, b_in, sg_ln_g, sg_ln_b, w_s, b_s, mh_g, w_pa, w_pb, w_out):
    B, S, _ = x.shape
    f32 = jnp.float32
    z = jnp.einsum('bsd,de->bse', x, w_in) + b_in
    u, v, q, k, vm, o, ig, fg, ga, gb = jnp.split(z, SPLIT_POINTS, axis=-1)
    a = spatial_gating(jax.nn.gelu(u, approximate=False), jax.nn.gelu(v, approximate=False),
                       sg_ln_g, sg_ln_b, w_s, b_s)
    h = mlstm_chunkwise(q.reshape(B, S, M_HEADS, M_QK_DIM).astype(f32),
                        k.reshape(B, S, M_HEADS, M_QK_DIM).astype(f32),
                        vm.reshape(B, S, M_HEADS, M_V_DIM).astype(f32),
                        ig.astype(f32), fg.astype(f32))
    h = h * lax.rsqrt(jnp.mean(h * h, -1, keepdims=True) + RMS_EPS)
    mb = (jax.nn.sigmoid(o.astype(f32)) * (h.reshape(B, S, M_V) * mh_g)).astype(x.dtype)
    y = jax.nn.sigmoid(ga) * (a @ w_pa) + jax.nn.sigmoid(gb) * (mb @ w_pb)
    return y @ w_out


def moe(x, w_router, b_router, w_gate_e, w_up_e, w_down_e, w_gate_s, w_up_s, w_down_s):
    B, S, D = x.shape
    nblk = S // MOE_POS_BLOCK
    T = B * MOE_POS_BLOCK
    xt = x.reshape(B, nblk, MOE_POS_BLOCK, D).transpose(1, 0, 2, 3).reshape(nblk, T, D)
    per_group = N_EXPERTS // N_GROUPS

    def block(xb):
        scores = jax.nn.sigmoid(jnp.einsum('td,de->te', xb, w_router).astype(jnp.float32))
        sel = scores + b_router.astype(jnp.float32)
        grp_score = jnp.sum(lax.top_k(sel.reshape(T, N_GROUPS, per_group), 2)[0], -1)
        _, gidx = lax.top_k(grp_score, TOPK_GROUPS)
        gmask = jnp.any(gidx[..., None] == jnp.arange(N_GROUPS), axis=-2)
        emask = jnp.repeat(gmask, per_group, axis=-1)
        _, eidx = lax.top_k(jnp.where(emask, sel, -jnp.inf), TOP_K)
        wsel = jnp.take_along_axis(scores, eidx, -1)
        wsel = wsel / jnp.sum(wsel, -1, keepdims=True) * ROUTE_SCALE
        combine = jnp.zeros((T, N_EXPERTS), jnp.float32).at[jnp.arange(T)[:, None], eidx].set(wsel)
        hg = jnp.einsum('td,edf->tef', xb, w_gate_e)
        hu = jnp.einsum('td,edf->tef', xb, w_up_e)
        hid = jax.nn.silu(hg) * hu * combine[..., None].astype(xb.dtype)
        routed = jnp.einsum('tef,efd->td', hid, w_down_e)
        shared = (jax.nn.silu(xb @ w_gate_s) * (xb @ w_up_s)) @ w_down_s
        return routed + shared

    out = lax.map(block, xt)
    return out.reshape(nblk, B, MOE_POS_BLOCK, D).transpose(1, 0, 2, 3).reshape(B, S, D)


def setup_inputs(seed: int = 0) -> dict:
    key = jax.random.key(seed)
    ks = jax.random.split(key, 32)
    L = DEPTH

    def nrm(k, shape, scale):
        return jax.random.normal(k, shape, jnp.float32) * scale

    forget_off = jnp.zeros((D_IN,), jnp.float32).at[F_OFF:F_OFF + M_HEADS].set(FORGET_BIAS)
    return {
        "x": nrm(ks[0], (BATCH, SEQ, D_MODEL), 1.0),
        "p": nrm(ks[1], (DEPTH, BATCH, SEQ, P_DIM), 1.0),
        "w_in": nrm(ks[2], (L, D_MODEL, D_IN), D_MODEL ** -0.5),
        "b_in": nrm(ks[3], (L, D_IN), 0.02) + forget_off,
        "sg_ln_g": 1.0 + nrm(ks[4], (L, G_WIDTH), 0.02),
        "sg_ln_b": nrm(ks[5], (L, G_WIDTH), 0.02),
        "w_s": nrm(ks[6], (L, G_GROUPS, G_BLOCK, G_BLOCK), G_BLOCK ** -0.5),
        "b_s": 1.0 + nrm(ks[7], (L, G_GROUPS, G_BLOCK), 0.02),
        "mh_g": 1.0 + nrm(ks[8], (L, M_V), 0.02),
        "w_pa": nrm(ks[9], (L, G_WIDTH, D_MODEL), G_WIDTH ** -0.5 * BETA),
        "w_pb": nrm(ks[10], (L, M_V, D_MODEL), M_V ** -0.5 * BETA),
        "w_out": nrm(ks[11], (L, D_MODEL, D_MODEL), D_MODEL ** -0.5 * BETA),
        "ln1_g": 1.0 + nrm(ks[12], (L, D_MODEL), 0.02),
        "ln1_b": nrm(ks[13], (L, D_MODEL), 0.02),
        "w_router": nrm(ks[14], (L, D_MODEL, N_EXPERTS), D_MODEL ** -0.5),
        "b_router": nrm(ks[15], (L, N_EXPERTS), 0.01),
        "w_gate_e": nrm(ks[16], (L, N_EXPERTS, D_MODEL, D_EXPERT), D_MODEL ** -0.5),
        "w_up_e": nrm(ks[17], (L, N_EXPERTS, D_MODEL, D_EXPERT), D_MODEL ** -0.5),
        "w_down_e": nrm(ks[18], (L, N_EXPERTS, D_EXPERT, D_MODEL), D_EXPERT ** -0.5 * BETA),
        "w_gate_s": nrm(ks[19], (L, D_MODEL, D_SHARED), D_MODEL ** -0.5),
        "w_up_s": nrm(ks[20], (L, D_MODEL, D_SHARED), D_MODEL ** -0.5),
        "w_down_s": nrm(ks[21], (L, D_SHARED, D_MODEL), D_SHARED ** -0.5 * BETA),
        "w_pg": nrm(ks[22], (L, D_MODEL, D_MODEL), D_MODEL ** -0.5),
        "b_pg": nrm(ks[23], (L, D_MODEL), 0.02),
        "w_p": nrm(ks[24], (L, P_DIM, D_MODEL), P_DIM ** -0.5 * BETA),
        "ln2_g": 1.0 + nrm(ks[25], (L, D_MODEL), 0.02),
        "ln2_b": nrm(ks[26], (L, D_MODEL), 0.02),
    }


def reference(x, p, w_in, b_in, sg_ln_g, sg_ln_b, w_s, b_s, mh_g, w_pa, w_pb, w_out,
              ln1_g, ln1_b, w_router, b_router, w_gate_e, w_up_e, w_down_e,
              w_gate_s, w_up_s, w_down_s, w_pg, b_pg, w_p, ln2_g, ln2_b):
    for l in range(DEPTH):
        mix = token_mixer(x, w_in[l], b_in[l], sg_ln_g[l], sg_ln_b[l], w_s[l], b_s[l],
                          mh_g[l], w_pa[l], w_pb[l], w_out[l])
        x = layer_norm(ALPHA * x + mix, ln1_g[l], ln1_b[l])
        ffn = moe(x, w_router[l], b_router[l], w_gate_e[l], w_up_e[l], w_down_e[l],
                  w_gate_s[l], w_up_s[l], w_down_s[l])
        ple = jax.nn.sigmoid(x @ w_pg[l] + b_pg[l]) * (p[l] @ w_p[l])
        x = layer_norm(ALPHA * x + ffn + ple, ln2_g[l], ln2_b[l])
    return x
```

```cpp
#include <hip/hip_runtime.h>
#include <cstdio>
#include <cstdint>

#ifndef MK_LAUNCH_PER_PHASE
#define MK_LAUNCH_PER_PHASE 0
#endif
#ifndef SIM_FP8
#define SIM_FP8 0
#endif
#ifndef TREP
#define TREP 0u
#endif
#ifndef PH_MASK
#define PH_MASK 0xFFFFFFFFu
#endif
#ifndef MK_DEBUG
#define MK_DEBUG 0
#endif

#define GAS __attribute__((address_space(1)))
#define LAS __attribute__((address_space(3)))
typedef unsigned short bf16;
typedef short bf16x8 __attribute__((ext_vector_type(8)));
typedef short s16x4 __attribute__((ext_vector_type(4)));
typedef float f32x4 __attribute__((ext_vector_type(4)));
typedef float f32x2 __attribute__((ext_vector_type(2)));
typedef unsigned u32x4 __attribute__((ext_vector_type(4)));
typedef unsigned u32x2 __attribute__((ext_vector_type(2)));
typedef short v4i16_t __attribute__((ext_vector_type(4)));

constexpr int D = 1024, NB = 8, SEQ = 8192, M = NB * SEQ, DEPTH = 4;
constexpr int DIN = 7176, ZW = 7168;
constexpr int Z8W = 5376;
constexpr int ZU = 0, ZVM = 1024, ZV = 2048, ZQ = 3072, ZK = 3584, ZO = 4096, ZGA = 5120, ZGB = 6144;
constexpr int ZT1 = ZQ;
constexpr int ZY = ZV;
constexpr int NH = 4, DQK = 128, DV = 256, LCH = 64, NCH = SEQ / LCH;
constexpr int NE = 64, TOPK = 8, DEXP = 256, PD = 256;
constexpr float ALPHA = 1.681792830507429f;
constexpr float LN_EPS = 1e-5f, RMS_EPS = 1e-6f, ROUTE_SCALE = 2.5f;
constexpr float QSCALE = 0.08838834764831845f;
constexpr int HALF_TOK = M / 2;
constexpr int MAXT_HALF = 1088;
constexpr int NSH_TILES = M / 256;

constexpr size_t MiB = 1u << 20;
constexpr size_t WS_CTL = 0, CTL_ZERO_BYTES = 1 * MiB;
constexpr size_t WS_BIAS1 = 1 * MiB;
constexpr size_t WS_WSB = 1 * MiB + 65536;
constexpr size_t WS_VPART = 1457 * MiB;
constexpr size_t WS_IF = 3 * MiB;
constexpr size_t WS_BC = 5 * MiB;
constexpr size_t WS_BL = 6 * MiB, WS_GM = 6 * MiB + 16384, WS_MS = 6 * MiB + 32768;
constexpr size_t WS_NK = 7 * MiB;
constexpr size_t WS_TOKE = 9 * MiB, WS_TOKW = 11 * MiB, WS_POS = 13 * MiB;
constexpr size_t WS_HIST = 15 * MiB, WS_TILEE = 15 * MiB + 65536, WS_CNT = 15 * MiB + 131072;
constexpr size_t WS_STOK = 16 * MiB, WS_SW = 19 * MiB;
constexpr size_t WS_DBG = 22 * MiB;
constexpr size_t WS_WIN = 24 * MiB;
constexpr size_t WS_W4 = 38 * MiB;
constexpr size_t WS_UPT = 46 * MiB;
constexpr size_t WS_DNT = 145 * MiB;
constexpr size_t WS_WPT = 144 * MiB;
constexpr size_t WS_PBH = 1282 * MiB;
constexpr size_t WS_XB = 79 * MiB;
constexpr size_t WS_XR = 177 * MiB;
constexpr size_t WS_Z = 305 * MiB;
constexpr int ZGP = 2176;
constexpr size_t WS_ZG = 645 * MiB;
constexpr size_t WS_STATE = 1201 * MiB;
constexpr size_t WS_HID = 305 * MiB;
constexpr size_t WS_GBUF = 610 * MiB;
constexpr size_t WS_OUTS = 738 * MiB;
constexpr size_t WS_END = 1465 * MiB;
static_assert(WS_HID + (size_t)(M + 2 * MAXT_HALF * 256) * 512 <= WS_GBUF && WS_OUTS + (size_t)2 * MAXT_HALF * 256 * 1024 <= WS_PBH && WS_PBH + (size_t)M * 1024 <= WS_STATE + 256 * MiB && WS_STATE + 256 * MiB <= WS_VPART, "ws map");

constexpr int CW_BAR = 4096;
constexpr int CW_DBG = 16384;

constexpr int LDS_BYTES = 163840;
constexpr int LDS_GIDX = 131072;
constexpr int LDS_TILE = 133120;
constexpr int LDS_MISC = LDS_BYTES - 256;
constexpr int LDS_PTRS = LDS_BYTES - 512;

#define LDS_WAIT() asm volatile("s_waitcnt lgkmcnt(0)" ::: "memory")
#define VM_WAIT() asm volatile("s_waitcnt vmcnt(0)" ::: "memory")
typedef __bf16 bf16x2_t __attribute__((ext_vector_type(2)));
__device__ __forceinline__ unsigned cvt_pk_bf16(float lo, float hi) { const f32x2 v = {lo, hi}; const bf16x2_t b = __builtin_convertvector(v, bf16x2_t); return __builtin_bit_cast(unsigned, b); }
__device__ __forceinline__ float bf2f(unsigned b) { return __uint_as_float(b << 16); }
__device__ __forceinline__ float bflo(unsigned w) { return __uint_as_float(w << 16); }
__device__ __forceinline__ float bfhi(unsigned w) { return __uint_as_float(w & 0xffff0000u); }
__device__ __forceinline__ bf16 f2bf(float f) { return (bf16)(cvt_pk_bf16(f, f) & 0xffffu); }
__device__ __forceinline__ float q8(float x, float s, float inv_s) { const int v = __builtin_amdgcn_cvt_pk_fp8_f32(x * s, 0.f, 0, false); return __builtin_amdgcn_cvt_f32_fp8(v, 0) * inv_s; }
__device__ __forceinline__ unsigned pk4_fp8x16(float a, float b, float c, float d) {
    float k = 448.f; asm volatile("" : "+s"(k));
    a = __builtin_amdgcn_fmed3f(a * 16.f, -k, k); b = __builtin_amdgcn_fmed3f(b * 16.f, -k, k); c = __builtin_amdgcn_fmed3f(c * 16.f, -k, k); d = __builtin_amdgcn_fmed3f(d * 16.f, -k, k);
    int w = __builtin_amdgcn_cvt_pk_fp8_f32(a, b, 0, false); w = __builtin_amdgcn_cvt_pk_fp8_f32(c, d, w, true); return (unsigned)w; }
__device__ __forceinline__ unsigned pk4_fp8x4(float a, float b, float c, float d) {
    float k = 448.f; asm volatile("" : "+s"(k));
    a = __builtin_amdgcn_fmed3f(a * 4.f, -k, k); b = __builtin_amdgcn_fmed3f(b * 4.f, -k, k); c = __builtin_amdgcn_fmed3f(c * 4.f, -k, k); d = __builtin_amdgcn_fmed3f(d * 4.f, -k, k);
    int w = __builtin_amdgcn_cvt_pk_fp8_f32(a, b, 0, false); w = __builtin_amdgcn_cvt_pk_fp8_f32(c, d, w, true); return (unsigned)w; }
__device__ __forceinline__ f32x4 un4_fp8x4(unsigned w) { const f32x2 lo = __builtin_amdgcn_cvt_pk_f32_fp8((int)w, false), hi = __builtin_amdgcn_cvt_pk_f32_fp8((int)w, true); return (f32x4){lo[0] * 0.25f, lo[1] * 0.25f, hi[0] * 0.25f, hi[1] * 0.25f}; }
__device__ __forceinline__ void un16_fp8x16(const u32x4 e, float (&f)[16]) {
#pragma unroll
    for (int q = 0; q < 4; ++q) { const f32x2 lo = __builtin_amdgcn_cvt_pk_f32_fp8((int)e[q], false), hi = __builtin_amdgcn_cvt_pk_f32_fp8((int)e[q], true);
        f[4 * q] = lo[0] * 0.0625f; f[4 * q + 1] = lo[1] * 0.0625f; f[4 * q + 2] = hi[0] * 0.0625f; f[4 * q + 3] = hi[1] * 0.0625f; }
}
__device__ __forceinline__ void un16_fp8raw(const u32x4 e, float (&f)[16]) {
#pragma unroll
    for (int q = 0; q < 4; ++q) { const f32x2 lo = __builtin_amdgcn_cvt_pk_f32_fp8((int)e[q], false), hi = __builtin_amdgcn_cvt_pk_f32_fp8((int)e[q], true);
        f[4 * q] = lo[0]; f[4 * q + 1] = lo[1]; f[4 * q + 2] = hi[0]; f[4 * q + 3] = hi[1]; }
}
__device__ __forceinline__ void bf16x16_to_lds(LAS unsigned char* p, const float (&f)[16]) {
    u32x4 a, b; a.x = cvt_pk_bf16(f[0], f[1]); a.y = cvt_pk_bf16(f[2], f[3]); a.z = cvt_pk_bf16(f[4], f[5]); a.w = cvt_pk_bf16(f[6], f[7]);
    b.x = cvt_pk_bf16(f[8], f[9]); b.y = cvt_pk_bf16(f[10], f[11]); b.z = cvt_pk_bf16(f[12], f[13]); b.w = cvt_pk_bf16(f[14], f[15]);
    *(LAS u32x4*)p = a; *(LAS u32x4*)(p + 16) = b;
}
template <int CTRL> __device__ __forceinline__ float dppf(float v) { return __builtin_bit_cast(float, __builtin_amdgcn_update_dpp(0, __builtin_bit_cast(int, v), CTRL, 0xF, 0xF, true)); }
__device__ __forceinline__ float shfl_idx(float v, int src) { return __builtin_bit_cast(float, __builtin_amdgcn_ds_bpermute(src << 2, __builtin_bit_cast(int, v))); }
__device__ __forceinline__ float rdlane(float v, int l) { return __builtin_bit_cast(float, __builtin_amdgcn_readlane(__builtin_bit_cast(int, v), l)); }
__device__ __forceinline__ float grp8_sum(float v) { v += dppf<0xB1>(v); v += dppf<0x4E>(v); v += dppf<0x141>(v); return v; }
__device__ __forceinline__ float grp8_max(float v) { v = fmaxf(v, dppf<0xB1>(v)); v = fmaxf(v, dppf<0x4E>(v)); v = fmaxf(v, dppf<0x141>(v)); return v; }
__device__ __forceinline__ float wave_sum(float v) { v = grp8_sum(v); v += dppf<0x140>(v); return (rdlane(v, 0) + rdlane(v, 16)) + (rdlane(v, 32) + rdlane(v, 48)); }
__device__ __forceinline__ float wave_max(float v) { v = grp8_max(v); v = fmaxf(v, dppf<0x140>(v)); return fmaxf(fmaxf(rdlane(v, 0), rdlane(v, 16)), fmaxf(rdlane(v, 32), rdlane(v, 48))); }
__device__ __forceinline__ float kf(float x) { asm volatile("" : "+s"(x)); return x; }
__device__ __forceinline__ float fast_exp(float x) { return __builtin_amdgcn_exp2f(x * kf(1.4426950408889634f)); }
__device__ __forceinline__ float fast_sigmoid(float x) { return __builtin_amdgcn_rcpf(1.0f + __builtin_amdgcn_exp2f(-1.4426950408889634f * x)); }
__device__ __forceinline__ f32x2 gelu_pk(f32x2 v) {
    const f32x2 av = __builtin_elementwise_abs(v), d = av * 0.2316418882f + 1.0f;
    f32x2 t; t.x = __builtin_amdgcn_rcpf(d.x); t.y = __builtin_amdgcn_rcpf(d.y);
    f32x2 q = t * 0.5307027145f + (-0.7265760135f); q = q * t + 0.7107068705f; q = q * t + (-0.142248368f); q = q * t + 0.127414796f; q = q * t;
    const f32x2 s = (v * v) * (-0.72134752044f);
    f32x2 e; e.x = __builtin_amdgcn_exp2f(s.x); e.y = __builtin_amdgcn_exp2f(s.y);
    const f32x2 m = v * (q * e), r = v - m;
    f32x2 o; o.x = v.x < 0.f ? m.x : r.x; o.y = v.y < 0.f ? m.y : r.y; return o;
}
typedef float f32x8 __attribute__((ext_vector_type(8)));
__device__ __forceinline__ f32x8 gelu8(f32x8 v) {
    const f32x8 av = __builtin_elementwise_abs(v), d = av * 0.2316418882f + 1.0f;
    f32x8 t, e;
#pragma unroll
    for (int i = 0; i < 8; ++i) t[i] = __builtin_amdgcn_rcpf(d[i]);
    f32x8 q = t * 0.5307027145f + (-0.7265760135f); q = q * t + 0.7107068705f; q = q * t + (-0.142248368f); q = q * t + 0.127414796f; q = q * t;
    const f32x8 s = (v * v) * (-0.72134752044f);
#pragma unroll
    for (int i = 0; i < 8; ++i) e[i] = __builtin_amdgcn_exp2f(s[i]);
    const f32x8 m = v * (q * e), r = v - m;
    f32x8 o;
#pragma unroll
    for (int i = 0; i < 8; ++i) o[i] = v[i] < 0.f ? m[i] : r[i];
    return o;
}
__device__ __forceinline__ bf16x8 frag_row(const LAS unsigned char* t, int pitch, int r0, int k0, int lane) {
    return *(const LAS bf16x8*)(t + (r0 + (lane & 15)) * pitch + (k0 + 8 * (lane >> 4)) * 2);
}
__device__ __forceinline__ bf16x8 frag_tr(const LAS unsigned char* t, int pitch, int k0, int n0, int lane) {
    const int i = lane & 15, g = lane >> 4, q = i >> 2, p = i & 3;
    const LAS unsigned char* a = t + (k0 + 8 * g + q) * pitch + (n0 + 4 * p) * 2;
    const s16x4 lo = __builtin_bit_cast(s16x4, __builtin_amdgcn_ds_read_tr16_b64_v4i16((LAS v4i16_t*)a));
    const s16x4 hi = __builtin_bit_cast(s16x4, __builtin_amdgcn_ds_read_tr16_b64_v4i16((LAS v4i16_t*)(a + 4 * pitch)));
    return (bf16x8){lo[0], lo[1], lo[2], lo[3], hi[0], hi[1], hi[2], hi[3]};
}
#define MFMA16(a, b, c) __builtin_amdgcn_mfma_f32_16x16x32_bf16((a), (b), (c), 0, 0, 0)
__device__ __forceinline__ long frag8(const LAS unsigned char* t, int pitch, int r0, int k0, int lane) { return *(const LAS long*)(t + (r0 + (lane & 15)) * pitch + k0 + 8 * (lane >> 4)); }
#define MFMA8(a, b, c) __builtin_amdgcn_mfma_f32_16x16x32_fp8_fp8((a), (b), (c), 0, 0, 0)

constexpr int LDS_WTAB = 163840 - 768;
extern __shared__ __attribute__((aligned(16))) unsigned char lds_raw[];
__device__ __forceinline__ unsigned hw_wave_key() { return (unsigned)__builtin_amdgcn_s_getreg(((6 - 1) << 11) | 4) & 63u; }
__device__ __forceinline__ int fresh_tid() {
    const int wv = __builtin_amdgcn_readfirstlane(*(volatile LAS int*)((LAS unsigned char*)lds_raw + LDS_WTAB + 4 * hw_wave_key()));
    unsigned ones = ~0u; asm volatile("" : "+s"(ones));
    int t = (wv << 6) | (int)__builtin_amdgcn_mbcnt_hi(ones, __builtin_amdgcn_mbcnt_lo(ones, 0u)); asm volatile("" : "+v"(t)); return t; }
#define XB_TMO      128
#define XB_XCNT(j)  (256  + 64 * (j))
#define XB_XSUB(j)  (1280 + 64 * (j))
#define XB_XGEN(j)  (2304 + 64 * (j))
#define XB_TOP      3328
#define XB_TOPGEN   3392
#define XCD_BAR_WORDS 3456
#define XB_SPIN_CAP (1u << 22)
__device__ __forceinline__ unsigned xb_ld(unsigned* p)              { return __hip_atomic_load(p, __ATOMIC_RELAXED, __HIP_MEMORY_SCOPE_AGENT); }
__device__ __forceinline__ unsigned xb_add(unsigned* p, unsigned v) { asm volatile("" : "+v"(v));
    return __hip_atomic_fetch_add(p, v, __ATOMIC_RELAXED, __HIP_MEMORY_SCOPE_AGENT); }
__device__ __forceinline__ unsigned xb_xcc_id() { return (unsigned)__builtin_amdgcn_s_getreg((3 << 11) | 20) & 0xFu; }
#define XB_SPIN(cond, bar) do { unsigned _sp = 0; while (cond) { __builtin_amdgcn_s_sleep(1); \
    if ((++_sp & 255u) == 0u) { if (xb_ld(&(bar)[XB_TMO])) break; if (_sp > XB_SPIN_CAP) { atomicAdd(&(bar)[XB_TMO], 1u); break; } } } } while (0)
struct XcdBarrier { unsigned* bar; unsigned x; volatile LAS unsigned* st; };
__device__ __forceinline__ XcdBarrier xcd_barrier_post(unsigned* bar, volatile LAS unsigned* st) {
    XcdBarrier b; b.bar = bar; b.x = xb_xcc_id(); b.st = st;
    if (fresh_tid() == 0) (void)xb_add(&bar[XB_XCNT(b.x)], 1u);
    return b;
}
__device__ __forceinline__ void xcd_barrier_complete(unsigned* bar, unsigned x, unsigned& nloc, unsigned& nx) {
    const unsigned G = gridDim.x * gridDim.y * gridDim.z;
    unsigned sum, cnt, mine, sp = 0u;
    for (;;) {
        sum = 0u; cnt = 0u; mine = 0u;
#pragma unroll
        for (unsigned j = 0; j < 16; ++j) { const unsigned c = xb_ld(&bar[XB_XCNT(j)]); sum += c; cnt += (c > 0u) ? 1u : 0u; mine = (j == x) ? c : mine; }
        if (sum == G) break;
        __builtin_amdgcn_s_sleep(1);
        if ((++sp & 255u) == 0u) { if (xb_ld(&bar[XB_TMO])) break; if (sp > XB_SPIN_CAP) { atomicAdd(&bar[XB_TMO], 1u); break; } }
    }
    nloc = mine > 0u ? mine : 1u; nx = cnt > 0u ? cnt : 1u;
}
__device__ __forceinline__ void xcd_barrier(const XcdBarrier& b) {
    asm volatile("s_waitcnt vmcnt(0)" ::: "memory");
    __syncthreads();
    if (fresh_tid() == 0) {
        unsigned* bar = b.bar;
        __builtin_amdgcn_s_waitcnt(0);
        unsigned nloc = b.st[0], nx = b.st[1];
        if (nloc == 0u) { xcd_barrier_complete(bar, b.x, nloc, nx); b.st[0] = nloc; b.st[1] = nx; }
        const unsigned old = xb_add(&bar[XB_XSUB(b.x)], 1u);
        const unsigned gen = old / nloc;
        if (old + 1u == (gen + 1u) * nloc) {
            __builtin_amdgcn_fence(__ATOMIC_RELEASE, "agent");
            asm volatile("s_waitcnt vmcnt(0)" ::: "memory");
            const unsigned og = xb_add(&bar[XB_TOP], 1u);
            const unsigned tg = og / nx;
            if (og + 1u == (tg + 1u) * nx) xb_add(&bar[XB_TOPGEN], 1u);
            else XB_SPIN(xb_ld(&bar[XB_TOPGEN]) == tg, bar);
            __builtin_amdgcn_fence(__ATOMIC_ACQUIRE, "agent");
            xb_add(&bar[XB_XGEN(b.x)], 1u);
            asm volatile("s_waitcnt vmcnt(0)" ::: "memory");
        } else {
            XB_SPIN(xb_ld(&bar[XB_XGEN(b.x)]) == gen, bar);
            __builtin_amdgcn_fence(__ATOMIC_ACQUIRE, "agent");
            asm volatile("s_waitcnt vmcnt(0)" ::: "memory");
        }
    }
    __syncthreads();
}

#ifndef G8_SP2
#define G8_SP2 true
#endif
namespace g8 {
constexpr int BM = 256, BK = 64, HALF = 128, HTB = HALF * BK * 2, STAGE_BYTES = 8 * HTB;
__device__ __forceinline__ int lds_byte(int r, int c) { const int st = (r >> 4) * 2 + (c >> 5), rr = r & 15, cc = c & 31, ob = rr * 64 + cc * 2; return st * 1024 + (ob ^ (((ob >> 9) & 1) << 5)); }
__device__ __forceinline__ void stage_rc(int b, int& R, int& C) { const int st = b / 1024, sb = b % 1024, swz = sb ^ (((sb >> 9) & 1) << 5); R = (st >> 1) * 16 + swz / 64; C = (st & 1) * 32 + (swz % 64) / 2; }
__device__ __forceinline__ int perm32(int rho) { const int n = rho >> 4, i = rho & 15; return 8 * (i >> 2) + 4 * n + (i & 3); }

__device__ __forceinline__ const char* uni_ptr(const char* p) {
    const unsigned long long v = (unsigned long long)p; const unsigned lo = __builtin_amdgcn_readfirstlane((unsigned)v), hi = __builtin_amdgcn_readfirstlane((unsigned)(v >> 32)); return (const char*)(const GAS char*)(((unsigned long long)hi << 32) | lo); }
struct Unit { int pm, pn; const char* a; const char* b; int grow; };

template <bool B> struct BoolC { static constexpr bool value = B; };
template <class T, class = void> struct pre_of { static constexpr bool value = false; };
template <class T> struct pre_of<T, decltype((void)T::PRE)> { static constexpr bool value = T::PRE; };
template <class T, class = void> struct perm2_of { static constexpr bool value = false; };
template <class T> struct perm2_of<T, decltype((void)T::PERM2)> { static constexpr bool value = T::PERM2; };
struct MidNone { static constexpr bool ON = false; template <class A, class U> __device__ __forceinline__ void operator()(A&, const U&, int, int, int, int) const {} };
typedef int v8i32_t __attribute__((ext_vector_type(8)));
typedef int v4i32_t __attribute__((ext_vector_type(4)));
template <class Epi, class Sched, bool GATHER, class Mid = MidNone, bool SP2 = G8_SP2, bool FP8 = false>
__device__ __forceinline__ void gemm_phase(LAS unsigned char* lds, const int lda, const int ldb, const int K, const Sched& S, const Epi& E, const int* gidx, const Mid& Md = Mid()) {
    const int tid = fresh_tid(), wid = __builtin_amdgcn_readfirstlane(tid >> 6), lane = tid & 63, wr = wid >> 2, wc = wid & 3, fr = lane & 15, fq = lane >> 4;
    const int nt = K / BK;
    int Rr[2], Cc[2]; unsigned voffA[2], voffB[2][2];
#pragma unroll
    for (int i = 0; i < 2; ++i) { stage_rc(tid * 16 + i * 8192, Rr[i], Cc[i]); voffA[i] = (unsigned)(Rr[i] * lda + Cc[i]) * 2u;
#pragma unroll
        for (int h = 0; h < 2; ++h) { int Rb;
            if constexpr (perm2_of<Epi>::value) Rb = 64 * (Rr[i] >> 5) + 16 * (((Rr[i] & 31) >> 2) & 3) + 8 * h + 4 * ((Rr[i] & 31) >> 4) + (Rr[i] & 3);
            else Rb = h * HALF + (Epi::PERM ? ((Rr[i] & ~31) + perm32(Rr[i] & 31)) : Rr[i]);
            voffB[h][i] = (unsigned)(Rb * ldb + Cc[i]) * 2u; } }
    const unsigned hstepA = (unsigned)HALF * (unsigned)lda * 2u;
    const size_t kstep = (size_t)(BK * 2);
    const unsigned ldsw = (unsigned)wid * 1024u;
    const int aoff = lds_byte(wr * 64 + fr, fq * 8), boff = lds_byte(wc * 32 + fr, fq * 8);
#define G8_SA(b, h) (((b) * 2 + (h)) * HTB)
#define G8_SB(b, h) ((4 + (b) * 2 + (h)) * HTB)
#define G8_STAGE_B(bufoff, gbase, h) do { _Pragma("unroll") for (int _i = 0; _i < 2; ++_i) \
        __builtin_amdgcn_global_load_lds((const unsigned*)((const char*)(gbase) + voffB[h][_i]), (LAS unsigned*)(lds + (bufoff) + ldsw + _i * 8192), 16, 0, 0); } while (0)
#define G8_STAGE_A(bufoff, gbase, h, slot) do { _Pragma("unroll") for (int _i = 0; _i < 2; ++_i) { \
        unsigned _o; if constexpr (GATHER) _o = (unsigned)(*(const LAS int*)(lds + LDS_GIDX + (slot) * 1024 + ((h) * HALF + Rr[_i]) * 4) * lda + Cc[_i]) * 2u; else _o = voffA[_i] + (unsigned)(h) * hstepA; \
        __builtin_amdgcn_global_load_lds((const unsigned*)((const char*)(gbase) + _o), (LAS unsigned*)(lds + (bufoff) + ldsw + _i * 8192), 16, 0, 0); } } while (0)
#define G8_LD32(p) __builtin_shufflevector(*(const LAS v4i32_t*)(p), *(const LAS v4i32_t*)((p) + 1024), 0, 1, 2, 3, 4, 5, 6, 7)
#define G8_LDA(dst, b, h) do { if constexpr (FP8) { _Pragma("unroll") for (int m = 0; m < 4; ++m) dst##8[m] = G8_LD32(lds + G8_SA(b, h) + aoff + m * 2048); } \
        else { _Pragma("unroll") for (int m = 0; m < 4; ++m) _Pragma("unroll") for (int k = 0; k < 2; ++k) dst[m][k] = *(const LAS bf16x8*)(lds + G8_SA(b, h) + aoff + m * 2048 + k * 1024); } } while (0)
#define G8_LDB(dst, b, h) do { if constexpr (FP8) { _Pragma("unroll") for (int n = 0; n < 2; ++n) dst##8[n] = G8_LD32(lds + G8_SB(b, h) + boff + n * 2048); } \
        else { _Pragma("unroll") for (int n = 0; n < 2; ++n) _Pragma("unroll") for (int k = 0; k < 2; ++k) dst[n][k] = *(const LAS bf16x8*)(lds + G8_SB(b, h) + boff + n * 2048 + k * 1024); } } while (0)
#define G8_MMA(ai, bj, At, Bt) do { __builtin_amdgcn_s_setprio(1); \
        if constexpr (FP8) { _Pragma("unroll") for (int m = 0; m < 4; ++m) _Pragma("unroll") for (int n = 0; n < 2; ++n) \
            asm volatile("v_mfma_scale_f32_16x16x128_f8f6f4 %0, %1, %2, %0, %3, %4 op_sel_hi:[0,0,0]" : "+v"(acc[ai][bj][m][n]) : "v"(Bt##8[n]), "v"(At##8[m]), "v"(sc_w), "v"(sc_x)); } \
        else { _Pragma("unroll") for (int m = 0; m < 4; ++m) _Pragma("unroll") for (int n = 0; n < 2; ++n) _Pragma("unroll") for (int k = 0; k < 2; ++k) \
            acc[ai][bj][m][n] = __builtin_amdgcn_mfma_f32_16x16x32_bf16(Bt[n][k], At[m][k], acc[ai][bj][m][n], 0, 0, 0); } \
        __builtin_amdgcn_s_setprio(0); } while (0)
#define G8_MMA0(ai, bj, At, Bt) do { __builtin_amdgcn_s_setprio(1); \
        if constexpr (FP8) { _Pragma("unroll") for (int m = 0; m < 4; ++m) _Pragma("unroll") for (int n = 0; n < 2; ++n) \
            asm volatile("v_mfma_scale_f32_16x16x128_f8f6f4 %0, %1, %2, 0, %3, %4 op_sel_hi:[0,0,0]" : "+v"(acc[ai][bj][m][n]) : "v"(Bt##8[n]), "v"(At##8[m]), "v"(sc_w), "v"(sc_x)); } \
        else { _Pragma("unroll") for (int m = 0; m < 4; ++m) _Pragma("unroll") for (int n = 0; n < 2; ++n) _Pragma("unroll") for (int k = 0; k < 2; ++k) \
            acc[ai][bj][m][n] = __builtin_amdgcn_mfma_f32_16x16x32_bf16(Bt[n][k], At[m][k], acc[ai][bj][m][n], 0, 0, 0); } \
        __builtin_amdgcn_s_setprio(0); } while (0)
#define G8_MMAF(first, ai, bj, At, Bt) do { if constexpr (FP8 && (first)) G8_MMA0(ai, bj, At, Bt); else G8_MMA(ai, bj, At, Bt); } while (0)
#define G8_WAIT_V(n) asm volatile("s_waitcnt vmcnt(" #n ")" ::: "memory")
#define G8_WAIT_L(n) asm volatile("s_waitcnt lgkmcnt(" #n ")" ::: "memory")
#define G8_WAIT_VR do { if (fresh) { if constexpr (pre_of<Epi>::value) { if (prev16) G8_WAIT_V(24); else G8_WAIT_V(16); } else if constexpr (Epi::NVM == 16) G8_WAIT_V(24); else if constexpr (Epi::NVM == 32) G8_WAIT_V(40); else if constexpr (Epi::NVM == 8) G8_WAIT_V(16); else G8_WAIT_V(8); } else G8_WAIT_V(8); } while (0)
#define G8_BAR __builtin_amdgcn_s_barrier()
#define G8_SCHED __builtin_amdgcn_sched_barrier(0)
    Unit cur, nxt; int ui = 0; bool prev16 = false; (void)prev16;
    if (!S.next(0, cur)) return;
    f32x4 acc[2][2][4][2];
    {
#pragma unroll
    for (int a = 0; a < 2; ++a)
#pragma unroll
        for (int b = 0; b < 2; ++b)
#pragma unroll
            for (int m = 0; m < 4; ++m)
#pragma unroll
                for (int n = 0; n < 2; ++n) acc[a][b][m][n] = (f32x4){0.f, 0.f, 0.f, 0.f};
    }
    bf16x8 At[4][2], B0[2][2], B1[2][2]; v8i32_t At8[4], B08[2], B18[2];
    int sc_w = 0x77777777, sc_x = 0x7B7B7B7B; if constexpr (FP8) asm volatile("" : "+v"(sc_w), "+v"(sc_x));
    const char* cA = uni_ptr(cur.a); const char* cB = uni_ptr(cur.b);
    if constexpr (GATHER) {
        if (tid < 256) *(LAS int*)(lds + LDS_GIDX + tid * 4) = gidx[cur.grow + tid];
        __syncthreads();
    }
    if constexpr (SP2) {
        G8_STAGE_B(G8_SB(0, 0), cB, 0); G8_STAGE_B(G8_SB(0, 1), cB, 1); G8_STAGE_A(G8_SA(0, 0), cA, 0, 0); G8_STAGE_A(G8_SA(0, 1), cA, 1, 0);
        if (wr == 1) G8_BAR;
        G8_WAIT_V(2); G8_BAR;
        G8_STAGE_B(G8_SB(1, 0), cB + kstep, 0); G8_STAGE_A(G8_SA(1, 0), cA + kstep, 0, 0); G8_STAGE_B(G8_SB(1, 1), cB + kstep, 1);
        G8_WAIT_V(6); G8_BAR;
    } else {
    G8_STAGE_B(G8_SB(0, 0), cB, 0); G8_STAGE_A(G8_SA(0, 0), cA, 0, 0); G8_STAGE_B(G8_SB(0, 1), cB, 1); G8_STAGE_A(G8_SA(0, 1), cA, 1, 0);
    if (wr == 1) G8_BAR;
    G8_WAIT_V(4); G8_BAR;
    G8_STAGE_B(G8_SB(1, 0), cB + kstep, 0); G8_STAGE_A(G8_SA(1, 0), cA + kstep, 0, 0); G8_STAGE_B(G8_SB(1, 1), cB + kstep, 1);
    G8_WAIT_V(6); G8_BAR;
    }
#pragma unroll 1
    for (;;) {
        const bool has_next = S.next(ui + 1, nxt);
        const char* nA = has_next ? uni_ptr(nxt.a) : cA; const char* nB = has_next ? uni_ptr(nxt.b) : cB;
        if constexpr (GATHER) {
            if (has_next && wid == 0)
                __builtin_amdgcn_global_load_lds((const unsigned*)(gidx + nxt.grow) + lane * 4, (LAS unsigned*)(lds + LDS_GIDX + ((ui + 1) & 1) * 1024), 16, 0, 0);
        }
        auto trip = [&](const int t, auto first_c) __attribute__((always_inline)) {
            constexpr bool FIRST = decltype(first_c)::value;
            const bool last = (t == nt - 2);
            const char* a1 = cA + (size_t)(t + 1) * kstep;
            const char* a2 = last ? nA : cA + (size_t)(t + 2) * kstep; const char* b2 = last ? nB : cB + (size_t)(t + 2) * kstep;
            const char* a3 = a2 + kstep; const char* b3 = b2 + kstep;
            const int sl1 = ui & 1, sl2 = (last && has_next) ? ((ui + 1) & 1) : (ui & 1);
            const bool fresh = (FIRST || (!FP8 && t == 0)) && (ui > 0);
            if constexpr (Mid::ON) { if (t == (nt >> 1)) { G8_SCHED; if constexpr (FP8) asm volatile("s_nop 15\n\ts_nop 15" ::: "memory"); Md(acc, cur, wr, wc, fr, fq); if constexpr (FP8) asm volatile("s_nop 7" ::: "memory"); G8_SCHED; } }
            if constexpr (SP2) {
            if constexpr (GATHER) { if (!fresh) G8_STAGE_A(G8_SA(1, 1), a1, 1, sl1); } G8_LDB(B0, 0, 0); G8_LDB(B1, 0, 1); G8_SCHED; G8_LDA(At, 0, 0); if constexpr (!GATHER) { if (!fresh) G8_STAGE_A(G8_SA(1, 1), a1, 1, sl1); }
            G8_WAIT_VR; G8_WAIT_L(0); G8_BAR; G8_MMAF(FIRST, 0, 0, At, B0); G8_MMAF(FIRST, 0, 1, At, B1); G8_BAR; G8_SCHED;
            G8_LDA(At, 0, 1); G8_STAGE_B(G8_SB(0, 0), b2, 0); G8_STAGE_B(G8_SB(0, 1), b2, 1); G8_STAGE_A(G8_SA(0, 0), a2, 0, sl2);
            G8_WAIT_VR; G8_WAIT_L(0); G8_BAR; G8_MMAF(FIRST, 1, 0, At, B0); G8_MMAF(FIRST, 1, 1, At, B1); G8_BAR; G8_SCHED;
            if constexpr (GATHER) { G8_STAGE_A(G8_SA(0, 1), a2, 1, sl2); } G8_LDB(B0, 1, 0); G8_LDB(B1, 1, 1); G8_SCHED; G8_LDA(At, 1, 0); if constexpr (!GATHER) { G8_STAGE_A(G8_SA(0, 1), a2, 1, sl2); }
            G8_WAIT_VR; G8_WAIT_L(0); G8_BAR; G8_MMA(0, 0, At, B0); G8_MMA(0, 1, At, B1); G8_BAR; G8_SCHED;
            G8_LDA(At, 1, 1); G8_STAGE_B(G8_SB(1, 0), b3, 0); G8_STAGE_B(G8_SB(1, 1), b3, 1); G8_STAGE_A(G8_SA(1, 0), a3, 0, sl2);
            G8_WAIT_V(8); G8_WAIT_L(0); G8_BAR; G8_MMA(1, 0, At, B0); G8_MMA(1, 1, At, B1); G8_BAR; G8_SCHED;
            if (last && has_next) G8_STAGE_A(G8_SA(1, 1), a3, 1, sl2);
            } else {
            if constexpr (GATHER) { G8_STAGE_A(G8_SA(1, 1), a1, 1, sl1); } G8_LDB(B0, 0, 0); G8_SCHED; G8_LDA(At, 0, 0); if constexpr (!GATHER) { G8_STAGE_A(G8_SA(1, 1), a1, 1, sl1); }
            G8_WAIT_L(8); G8_BAR; G8_WAIT_L(0); G8_MMA(0, 0, At, B0); G8_BAR; G8_SCHED;
            G8_LDB(B1, 0, 1); G8_STAGE_B(G8_SB(0, 0), b2, 0);
            G8_BAR; G8_WAIT_L(0); G8_MMA(0, 1, At, B1); G8_BAR;
            if constexpr (GATHER) { G8_STAGE_A(G8_SA(0, 0), a2, 0, sl2); } G8_LDA(At, 0, 1); if constexpr (!GATHER) { G8_STAGE_A(G8_SA(0, 0), a2, 0, sl2); }
            G8_BAR; G8_WAIT_L(0); G8_MMA(1, 0, At, B0); G8_BAR; G8_SCHED;
            G8_STAGE_B(G8_SB(0, 1), b2, 1);
            G8_WAIT_V(6); G8_BAR; G8_MMA(1, 1, At, B1); G8_BAR;
            if constexpr (GATHER) { G8_STAGE_A(G8_SA(0, 1), a2, 1, sl2); } G8_LDB(B0, 1, 0); G8_SCHED; G8_LDA(At, 1, 0); if constexpr (!GATHER) { G8_STAGE_A(G8_SA(0, 1), a2, 1, sl2); }
            G8_WAIT_L(8); G8_BAR; G8_WAIT_L(0); G8_MMA(0, 0, At, B0); G8_BAR; G8_SCHED;
            G8_LDB(B1, 1, 1); G8_STAGE_B(G8_SB(1, 0), b3, 0);
            G8_BAR; G8_WAIT_L(0); G8_MMA(0, 1, At, B1); G8_BAR;
            if constexpr (GATHER) { G8_STAGE_A(G8_SA(1, 0), a3, 0, sl2); } G8_LDA(At, 1, 1); if constexpr (!GATHER) { G8_STAGE_A(G8_SA(1, 0), a3, 0, sl2); }
            G8_BAR; G8_WAIT_L(0); G8_MMA(1, 0, At, B0); G8_BAR; G8_SCHED;
            G8_STAGE_B(G8_SB(1, 1), b3, 1);
            G8_WAIT_V(6); G8_BAR; G8_MMA(1, 1, At, B1); G8_BAR;
            }
                };
        if constexpr (FP8) { trip(0, BoolC<true>());
#pragma unroll 1
            for (int t = 2; t < nt; t += 2) trip(t, BoolC<false>()); }
        else {
#pragma unroll 1
            for (int t = 0; t < nt; t += 2) trip(t, BoolC<false>()); }
        if (wr == 0) G8_BAR;
        if constexpr (FP8) asm volatile("s_nop 15\n\ts_nop 15" ::: "memory");
        E(acc, cur, wr, wc, fr, fq);
        if (!has_next) break;
#pragma unroll
        for (int a = 0; a < 2; ++a)
#pragma unroll
            for (int b = 0; b < 2; ++b)
#pragma unroll
                for (int m = 0; m < 4; ++m)
#pragma unroll
                    for (int n = 0; n < 2; ++n) {
                        if constexpr (!SP2 || !FP8) acc[a][b][m][n] = (f32x4){0.f, 0.f, 0.f, 0.f};
                        else asm volatile("" : "=v"(acc[a][b][m][n]));
                    }
        if constexpr (pre_of<Epi>::value) prev16 = E.nvm16(cur);
        cur = nxt; cA = nA; cB = nB; ++ui;
        if (wr == 1) G8_BAR;
    }
    G8_WAIT_V(0);
    G8_BAR;
#undef G8_SA
#undef G8_SB
#undef G8_STAGE_A
#undef G8_STAGE_B
#undef G8_LDA
#undef G8_LDB
#undef G8_MMA
#undef G8_MMA0
#undef G8_MMAF
#undef G8_LD32
#undef G8_WAIT_V
#undef G8_WAIT_VR
#undef G8_WAIT_L
#undef G8_BAR
#undef G8_SCHED
}

template <int NM, int NN>
struct SchedDenseT {
    static constexpr int nM = NM, nN = NN, nwg = NM * NN;
    int G, c; const char* A; const char* B; size_t atile, btile;
    __device__ __forceinline__ void init(int M_, int N_, int G_, int c_, const void* A_, size_t lda_elems, const void* B_, size_t ldb_elems) {
        (void)M_; (void)N_; G = G_; c = c_; A = (const char*)A_; B = (const char*)B_; atile = 256 * lda_elems * 2; btile = 256 * ldb_elems * 2; }
    __device__ __forceinline__ bool next(int i, Unit& u) const {
        const long L = (long)i * G + c; if (L >= nwg) return false;
        int wgid = (int)L; { constexpr int q = nwg / 8, r = nwg % 8; const int xcd = wgid % 8, off = wgid / 8; wgid = (xcd < r ? xcd * (q + 1) : r * (q + 1) + (xcd - r) * q) + off; }
        constexpr int nig = 8 * nN; const int gid = wgid / nig, fm = gid * 8, gsz = (nM - fm) < 8 ? (nM - fm) : 8;
        if constexpr (NM % 8 == 0) { u.pm = fm + ((wgid % nig) % 8); u.pn = (wgid % nig) / 8; } else { u.pm = fm + ((wgid % nig) % gsz); u.pn = (wgid % nig) / gsz; }
        u.a = A + (size_t)u.pm * atile; u.b = B + (size_t)u.pn * btile; u.grow = 0; return true;
    }
};
struct SchedUp {
    const LAS int* tileE; int ntiles, G, c; const char* A; const char* B;
    __device__ __forceinline__ bool next(int i, Unit& u) const {
        const long L = (long)i * G + c; if (L >= 2L * ntiles) return false;
        const int tile = (int)(L >> 1); u.pn = (int)(L & 1); u.pm = tile; u.grow = tile * 256;
        const int e = tile < NSH_TILES ? 64 : tileE[tile - NSH_TILES];
        u.a = A; u.b = B + ((size_t)e * 512 + (size_t)u.pn * 256) * 1024; return true;
    }
};
struct SchedDown {
    const LAS int* tileE; int nt, toff, G, c; const char* A; const char* B;
    __device__ __forceinline__ bool next(int i, Unit& u) const {
        const long L = (long)i * G + c; if (L >= 4L * nt) return false;
        const int tile = (int)(L >> 2); u.pn = (int)(L & 3); u.pm = tile; u.grow = 0;
        const int e = tileE[toff + tile];
        u.a = A + (size_t)(256 * (toff + tile)) * DEXP; u.b = B + ((size_t)e * 1024 + (size_t)u.pn * 256) * DEXP; return true;
    }
};

struct EpiBiasAct {
    static constexpr bool PERM = true; static constexpr int NVM = 16;
    bf16* O; int ldc; const float* bias; unsigned long long modes; float* vpart;
    __device__ __forceinline__ void operator()(const f32x4 (&acc)[2][2][4][2], const Unit& u, int wr, int wc, int fr, int fq) const {
        asm volatile("" : "+v"(fr), "+v"(fq));
        const int row0 = u.pm * 256 + wr * 64 + fr, col0 = u.pn * 256 + wc * 32 + 8 * fq;
        f32x4 bv[2][2];
#pragma unroll
        for (int bj = 0; bj < 2; ++bj)
#pragma unroll
            for (int n = 0; n < 2; ++n) bv[bj][n] = *(const f32x4*)(bias + col0 + bj * 128 + 4 * n);
#pragma unroll
        for (int ai = 0; ai < 2; ++ai)
#pragma unroll
            for (int m = 0; m < 4; ++m) { bf16* rowp = O + (size_t)(row0 + ai * 128 + m * 16) * ldc + col0;
#pragma unroll
                for (int bj = 0; bj < 2; ++bj) { f32x4 v0 = acc[ai][bj][m][0] + bv[bj][0], v1 = acc[ai][bj][m][1] + bv[bj][1];
#pragma unroll
                    for (int j = 0; j < 4; ++j) { v0[j] = fast_sigmoid(v0[j]); v1[j] = fast_sigmoid(v1[j]); }
                    u32x4 w; w.x = cvt_pk_bf16(v0[0], v0[1]); w.y = cvt_pk_bf16(v0[2], v0[3]); w.z = cvt_pk_bf16(v1[0], v1[1]); w.w = cvt_pk_bf16(v1[2], v1[3]);
                    *(u32x4*)(rowp + bj * 128) = w; } }
    }
};
struct EpiZ {
    static constexpr bool PERM = true, PERM2 = true, PRE = true; static constexpr int NVM = 8;
    unsigned char* Z8; bf16* ZG; const float* bias; float* vpart; bool plain;
    __device__ __forceinline__ bool nvm16(const Unit& u) const { return u.pn >= 20 || (!plain && u.pn >= 8 && u.pn < 12); }
    __device__ __forceinline__ void operator()(const f32x4 (&acc)[2][2][4][2], const Unit& u, int wr, int wc, int fr, int fq) const {
        asm volatile("" : "+v"(fr), "+v"(fq));
        const int row0 = u.pm * 256 + wr * 64 + fr, cw = wc * 64 + 16 * fq;
        f32x4 bv[2][2];
#pragma unroll
        for (int bj = 0; bj < 2; ++bj)
#pragma unroll
            for (int n = 0; n < 2; ++n) bv[bj][n] = *(const f32x4*)(bias + u.pn * 256 + cw + 8 * bj + 4 * n);
        if (u.pn >= 20) {
            const int cg = 128 * (u.pn - 20) + wc * 32 + 8 * fq;
#pragma unroll
            for (int ai = 0; ai < 2; ++ai)
#pragma unroll
                for (int m = 0; m < 4; ++m) { bf16* rowp = ZG + (size_t)(row0 + ai * 128 + m * 16) * ZGP;
                    float rr[8], sb[8];
#pragma unroll
                    for (int n = 0; n < 2; ++n)
#pragma unroll
                        for (int j = 0; j < 4; ++j) { const float ea = __builtin_amdgcn_exp2f(-1.4426950408889634f * (acc[ai][0][m][n][j] + bv[0][n][j])), eb = __builtin_amdgcn_exp2f(-1.4426950408889634f * (acc[ai][1][m][n][j] + bv[1][n][j]));
                            sb[4 * n + j] = __builtin_amdgcn_rcpf(1.0f + eb); rr[4 * n + j] = (1.0f + eb) * __builtin_amdgcn_rcpf(1.0f + ea); }
                    u32x4 w; w.x = cvt_pk_bf16(rr[0], rr[1]); w.y = cvt_pk_bf16(rr[2], rr[3]); w.z = cvt_pk_bf16(rr[4], rr[5]); w.w = cvt_pk_bf16(rr[6], rr[7]);
                    *(u32x4*)(rowp + cg) = w;
                    w.x = cvt_pk_bf16(sb[0], sb[1]); w.y = cvt_pk_bf16(sb[2], sb[3]); w.z = cvt_pk_bf16(sb[4], sb[5]); w.w = cvt_pk_bf16(sb[6], sb[7]);
                    *(u32x4*)(rowp + 1024 + cg) = w; }
            return;
        }
        if (plain || (u.pn >= 4 && u.pn < 8) || (u.pn >= 12 && u.pn < 16)) body<0, false>(acc, u, row0, cw, wc, fq, bv);
        else if (u.pn < 4) body<1, false>(acc, u, row0, cw, wc, fq, bv);
        else if (u.pn < 12) body<1, true>(acc, u, row0, cw, wc, fq, bv);
        else body<2, false>(acc, u, row0, cw, wc, fq, bv);
    }
    template <int MODE, bool STAT>
    __device__ __forceinline__ void body(const f32x4 (&acc)[2][2][4][2], const Unit& u, int row0, int cw, int wc, int fq, const f32x4 (&bv)[2][2]) const {
        float* const sink = (float*)((char*)vpart - (WS_VPART - WS_DBG)) + 2 * (16 * fq + (row0 & 15));
#pragma unroll
        for (int ai = 0; ai < 2; ++ai)
#pragma unroll
            for (int m = 0; m < 4; ++m) { u32x4 o; float ps1 = 0.f, ps2 = 0.f;
#pragma unroll
                for (int bj = 0; bj < 2; ++bj) { f32x4 v0 = acc[ai][bj][m][0] + bv[bj][0], v1 = acc[ai][bj][m][1] + bv[bj][1];
                    if constexpr (MODE == 1) { const f32x8 g = gelu8((f32x8){v0[0], v0[1], v0[2], v0[3], v1[0], v1[1], v1[2], v1[3]}); v0 = (f32x4){g[0], g[1], g[2], g[3]}; v1 = (f32x4){g[4], g[5], g[6], g[7]}; }
                    else if constexpr (MODE == 2) {
#pragma unroll
                        for (int j = 0; j < 4; ++j) { v0[j] = fast_sigmoid(v0[j]); v1[j] = fast_sigmoid(v1[j]); } }
                    if constexpr (STAT) { ps1 += ((v0[0] + v0[1]) + (v0[2] + v0[3])) + ((v1[0] + v1[1]) + (v1[2] + v1[3])); ps2 += ((v0[0] * v0[0] + v0[1] * v0[1]) + (v0[2] * v0[2] + v0[3] * v0[3])) + ((v1[0] * v1[0] + v1[1] * v1[1]) + (v1[2] * v1[2] + v1[3] * v1[3])); }
                    o[2 * bj] = pk4_fp8x16(v0[0], v0[1], v0[2], v0[3]); o[2 * bj + 1] = pk4_fp8x16(v1[0], v1[1], v1[2], v1[3]); }
                *(u32x4*)(Z8 + (size_t)(row0 + ai * 128 + m * 16) * Z8W + u.pn * 256 + cw) = o;
                if constexpr (STAT) {
                    { const auto r = __builtin_amdgcn_permlane32_swap(__float_as_uint(ps1), __float_as_uint(ps1), false, false); ps1 = __uint_as_float(r[0]) + __uint_as_float(r[1]); }
                    { const auto r = __builtin_amdgcn_permlane16_swap(__float_as_uint(ps1), __float_as_uint(ps1), false, false); ps1 = __uint_as_float(r[0]) + __uint_as_float(r[1]); }
                    { const auto r = __builtin_amdgcn_permlane32_swap(__float_as_uint(ps2), __float_as_uint(ps2), false, false); ps2 = __uint_as_float(r[0]) + __uint_as_float(r[1]); }
                    { const auto r = __builtin_amdgcn_permlane16_swap(__float_as_uint(ps2), __float_as_uint(ps2), false, false); ps2 = __uint_as_float(r[0]) + __uint_as_float(r[1]); }
                    float* const dst = fq == 0 ? vpart + ((size_t)(row0 + ai * 128 + m * 16) * 16 + (u.pn - 8) * 4 + wc) * 2 : sink;
                    *(f32x2*)dst = (f32x2){ps1, ps2}; } }
    }
};
struct EpiOut8 {
    static constexpr bool PERM = true, PERM2 = true; static constexpr int NVM = 8;
    unsigned char* O; int ldc;
    __device__ __forceinline__ void operator()(const f32x4 (&acc)[2][2][4][2], const Unit& u, int wr, int wc, int fr, int fq) const {
        asm volatile("" : "+v"(fr), "+v"(fq));
        const int row0 = u.pm * 256 + wr * 64 + fr, col0 = u.pn * 256 + wc * 64 + 16 * fq;
        float sc256 = 256.f; asm volatile("" : "+s"(sc256));
#pragma unroll
        for (int ai = 0; ai < 2; ++ai)
#pragma unroll
            for (int m = 0; m < 4; ++m) { u32x4 o;
#pragma unroll
                for (int bj = 0; bj < 2; ++bj)
#pragma unroll
                    for (int n = 0; n < 2; ++n) { const f32x4 v = acc[ai][bj][m][n] * sc256;
                        int a = __builtin_amdgcn_cvt_pk_fp8_f32(v[0], v[1], 0, false); a = __builtin_amdgcn_cvt_pk_fp8_f32(v[2], v[3], a, true); o[2 * bj + n] = (unsigned)a; }
                *(u32x4*)(O + (size_t)(row0 + ai * 128 + m * 16) * ldc + col0) = o; }
    }
};
struct EpiGate {
    static constexpr bool PERM = true; static constexpr int NVM = 32;
    const bf16* gate; int ldg, gcol; const bf16* add; int lda_, acol; bf16* O; int ldo, ocol; bool o8;
    __device__ __forceinline__ void operator()(const f32x4 (&acc)[2][2][4][2], const Unit& u, int wr, int wc, int fr, int fq) const {
        asm volatile("" : "+v"(fr), "+v"(fq));
        const int row0 = u.pm * 256 + wr * 64 + fr, col0 = u.pn * 256 + wc * 32 + 8 * fq;
        u32x4 g[2][4][2];
#pragma unroll
        for (int ai = 0; ai < 2; ++ai)
#pragma unroll
            for (int m = 0; m < 4; ++m) { const size_t r = (size_t)(row0 + ai * 128 + m * 16);
#pragma unroll
                for (int bj = 0; bj < 2; ++bj) g[ai][m][bj] = __builtin_nontemporal_load((const u32x4*)(gate + r * ldg + gcol + col0 + bj * 128)); }
#pragma unroll
        for (int ai = 0; ai < 2; ++ai)
#pragma unroll
            for (int m = 0; m < 4; ++m) { const size_t r = (size_t)(row0 + ai * 128 + m * 16);
#pragma unroll
                for (int bj = 0; bj < 2; ++bj) { const int c = col0 + bj * 128; const u32x4 gg = g[ai][m][bj];
                    f32x4 v0 = acc[ai][bj][m][0], v1 = acc[ai][bj][m][1];
                    v0[0] *= bflo(gg.x); v0[1] *= bfhi(gg.x); v0[2] *= bflo(gg.y); v0[3] *= bfhi(gg.y);
                    v1[0] *= bflo(gg.z); v1[1] *= bfhi(gg.z); v1[2] *= bflo(gg.w); v1[3] *= bfhi(gg.w);
                    if (o8) *(u32x2*)((unsigned char*)(O + r * ldo + ocol) + c) = (u32x2){pk4_fp8x16(v0[0], v0[1], v0[2], v0[3]), pk4_fp8x16(v1[0], v1[1], v1[2], v1[3])};
                    else { u32x4 w; w.x = cvt_pk_bf16(v0[0], v0[1]); w.y = cvt_pk_bf16(v0[2], v0[3]); w.z = cvt_pk_bf16(v1[0], v1[1]); w.w = cvt_pk_bf16(v1[2], v1[3]);
                        *(u32x4*)(O + r * ldo + ocol + c) = w; } } }
    }
};
struct EpiResid {
    static constexpr bool PERM = true; static constexpr int NVM = 32;
    const float* xf; bf16* XR;
    __device__ __forceinline__ void operator()(const f32x4 (&acc)[2][2][4][2], const Unit& u, int wr, int wc, int fr, int fq) const {
        asm volatile("" : "+v"(fr), "+v"(fq));
        const int row0 = u.pm * 256 + wr * 64 + fr, col0 = u.pn * 256 + wc * 32 + 8 * fq;
        float alpha = ALPHA; asm volatile("" : "+s"(alpha));
        if (!xf) {
            u32x4 q[2][4][2];
#pragma unroll
            for (int ai = 0; ai < 2; ++ai)
#pragma unroll
                for (int m = 0; m < 4; ++m)
#pragma unroll
                    for (int bj = 0; bj < 2; ++bj) q[ai][m][bj] = *(const u32x4*)(XR + (size_t)(row0 + ai * 128 + m * 16) * D + col0 + bj * 128);
#pragma unroll
            for (int ai = 0; ai < 2; ++ai)
#pragma unroll
                for (int m = 0; m < 4; ++m)
#pragma unroll
                    for (int bj = 0; bj < 2; ++bj) { const u32x4 qq = q[ai][m][bj];
                        const f32x4 r0 = (f32x4){bflo(qq.x), bfhi(qq.x), bflo(qq.y), bfhi(qq.y)} * alpha + acc[ai][bj][m][0], r1 = (f32x4){bflo(qq.z), bfhi(qq.z), bflo(qq.w), bfhi(qq.w)} * alpha + acc[ai][bj][m][1];
                        u32x4 w; w.x = cvt_pk_bf16(r0[0], r0[1]); w.y = cvt_pk_bf16(r0[2], r0[3]); w.z = cvt_pk_bf16(r1[0], r1[1]); w.w = cvt_pk_bf16(r1[2], r1[3]);
                        *(u32x4*)(XR + (size_t)(row0 + ai * 128 + m * 16) * D + col0 + bj * 128) = w; }
            return;
        }
#pragma unroll
        for (int ai = 0; ai < 2; ++ai)
#pragma unroll
            for (int mh = 0; mh < 2; ++mh) {
                f32x4 x[2][2][2];
#pragma unroll
                for (int m2 = 0; m2 < 2; ++m2) { const size_t off = (size_t)(row0 + ai * 128 + (2 * mh + m2) * 16) * D + col0;
#pragma unroll
                    for (int bj = 0; bj < 2; ++bj) {
                        if (xf) { x[m2][bj][0] = *(const f32x4*)(xf + off + bj * 128); x[m2][bj][1] = *(const f32x4*)(xf + off + bj * 128 + 4); }
                        else { const u32x4 q = *(const u32x4*)(XR + off + bj * 128); x[m2][bj][0] = (f32x4){bflo(q.x), bfhi(q.x), bflo(q.y), bfhi(q.y)}; x[m2][bj][1] = (f32x4){bflo(q.z), bfhi(q.z), bflo(q.w), bfhi(q.w)}; } } }
#pragma unroll
                for (int m2 = 0; m2 < 2; ++m2) { const size_t off = (size_t)(row0 + ai * 128 + (2 * mh + m2) * 16) * D + col0;
#pragma unroll
                    for (int bj = 0; bj < 2; ++bj) { const f32x4 r0 = x[m2][bj][0] * alpha + acc[ai][bj][2 * mh + m2][0], r1 = x[m2][bj][1] * alpha + acc[ai][bj][2 * mh + m2][1];
                        u32x4 w; w.x = cvt_pk_bf16(r0[0], r0[1]); w.y = cvt_pk_bf16(r0[2], r0[3]); w.z = cvt_pk_bf16(r1[0], r1[1]); w.w = cvt_pk_bf16(r1[2], r1[3]);
                        *(u32x4*)(XR + off + bj * 128) = w; } }
                asm volatile("" ::: "memory");
            }
    }
};
struct EpiMoeUp {
    static constexpr bool PERM = true; static constexpr int NVM = 16;
    bf16* HID; const float* SW; bf16* PBH;
    __device__ __forceinline__ void operator()(const f32x4 (&acc)[2][2][4][2], const Unit& u, int wr, int wc, int fr, int fq) const {
        asm volatile("" : "+v"(fr), "+v"(fq));
        const int rl0 = wr * 64 + fr, col0 = u.pn * 128 + wc * 32 + 8 * fq;
        float wv[2][4];
#pragma unroll
        for (int ai = 0; ai < 2; ++ai)
#pragma unroll
            for (int m = 0; m < 4; ++m) wv[ai][m] = SW[(size_t)u.grow + rl0 + ai * 128 + m * 16];
        if (u.pm < NSH_TILES) body<true>(acc, u, rl0, col0, wv); else body<false>(acc, u, rl0, col0, wv);
    }
    template <bool SH>
    __device__ __forceinline__ void body(const f32x4 (&acc)[2][2][4][2], const Unit& u, int rl0, int col0, const float (&wv)[2][4]) const {
#pragma unroll
        for (int ai = 0; ai < 2; ++ai)
#pragma unroll
            for (int m = 0; m < 4; ++m) { const size_t r = (size_t)u.grow + rl0 + ai * 128 + m * 16; const float w = wv[ai][m];
                float h[8];
#pragma unroll
                for (int n = 0; n < 2; ++n)
#pragma unroll
                    for (int j = 0; j < 4; ++j) { const float g = acc[ai][0][m][n][j], up = acc[ai][1][m][n][j]; h[4 * n + j] = g * fast_sigmoid(g) * up * w; }
                if constexpr (SH) *(u32x2*)((unsigned char*)PBH + r * 512 + 256 + col0) = (u32x2){pk4_fp8x16(h[0], h[1], h[2], h[3]), pk4_fp8x16(h[4], h[5], h[6], h[7])};
                else *(u32x2*)((unsigned char*)HID + (r - M) * DEXP + col0) = (u32x2){pk4_fp8x16(h[0], h[1], h[2], h[3]), pk4_fp8x16(h[4], h[5], h[6], h[7])}; }
    }
};
struct MidMulP {
    static constexpr bool ON = true;
    const bf16* Rp; int ld, cr;
    __device__ __forceinline__ void operator()(f32x4 (&acc)[2][2][4][2], const Unit& u, int wr, int wc, int fr, int fq) const {
        asm volatile("" : "+v"(fr), "+v"(fq));
        const char* base = (const char*)Rp + ((size_t)u.pm * 256 * ld + (size_t)u.pn * 256 + cr) * 2;
        const unsigned lo = (unsigned)((wr * 64 + fr) * ld + wc * 32 + 8 * fq) * 2u;
#pragma unroll
        for (int ai = 0; ai < 2; ++ai) {
            u32x4 g[4][2];
#pragma unroll
            for (int m = 0; m < 4; ++m) { const unsigned ro = lo + (unsigned)((ai * 128 + m * 16) * ld) * 2u;
#pragma unroll
                for (int bj = 0; bj < 2; ++bj) g[m][bj] = __builtin_nontemporal_load((const u32x4*)(base + ro + (unsigned)(bj * 128) * 2u)); }
#pragma unroll
            for (int m = 0; m < 4; ++m)
#pragma unroll
                for (int bj = 0; bj < 2; ++bj) { const u32x4 a = g[m][bj];
                    acc[ai][bj][m][0][0] *= bflo(a.x); acc[ai][bj][m][0][1] *= bfhi(a.x); acc[ai][bj][m][0][2] *= bflo(a.y); acc[ai][bj][m][0][3] *= bfhi(a.y);
                    acc[ai][bj][m][1][0] *= bflo(a.z); acc[ai][bj][m][1][1] *= bfhi(a.z); acc[ai][bj][m][1][2] *= bflo(a.w); acc[ai][bj][m][1][3] *= bfhi(a.w); }
            asm volatile("" ::: "memory");
        }
    }
};
struct MidMul {
    static constexpr bool ON = true;
    const bf16* G;
    __device__ __forceinline__ void operator()(f32x4 (&acc)[2][2][4][2], const Unit& u, int wr, int wc, int fr, int fq) const {
        asm volatile("" : "+v"(fr), "+v"(fq));
        const char* base = (const char*)G + ((size_t)u.pm * 256 * D + (size_t)u.pn * 256) * 2;
        const unsigned lo = (unsigned)((wr * 64 + fr) * D + wc * 32 + 4 * fq) * 2u;
#pragma unroll
        for (int ai = 0; ai < 2; ++ai)
#pragma unroll
            for (int mh = 0; mh < 2; ++mh) {
                u32x2 g[2][2][2];
#pragma unroll
                for (int m2 = 0; m2 < 2; ++m2) { const unsigned ro = lo + (unsigned)((ai * 128 + (2 * mh + m2) * 16) * D) * 2u;
#pragma unroll
                    for (int bj = 0; bj < 2; ++bj)
#pragma unroll
                        for (int n = 0; n < 2; ++n) g[m2][bj][n] = *(const u32x2*)(base + ro + (unsigned)(bj * 128 + n * 16) * 2u); }
#pragma unroll
                for (int m2 = 0; m2 < 2; ++m2)
#pragma unroll
                    for (int bj = 0; bj < 2; ++bj)
#pragma unroll
                        for (int n = 0; n < 2; ++n) { const u32x2 a = g[m2][bj][n]; const int m = 2 * mh + m2; acc[ai][bj][m][n][0] *= bflo(a.x); acc[ai][bj][m][n][1] *= bfhi(a.x); acc[ai][bj][m][n][2] *= bflo(a.y); acc[ai][bj][m][n][3] *= bfhi(a.y); }
                asm volatile("" ::: "memory");
            }
    }
};
}

struct KArgs { const float* in[27]; float* out; unsigned char* ws; int ph_lo, ph_hi, dbg, pad; };
enum { I_X = 0, I_P, I_WIN, I_BIN, I_SGG, I_SGB, I_WS, I_BS, I_MHG, I_WPA, I_WPB, I_WOUT, I_LN1G, I_LN1B, I_WR, I_BR, I_WGE, I_WUE, I_WDE, I_WGS, I_WUS, I_WDS, I_WPG, I_BPG, I_WP, I_LN2G, I_LN2B };
constexpr int NPH = 12;

struct Ctx {
    LAS unsigned char* lds; int vcu, G;
    float* out; unsigned char* ws;
};
#define WSP(T, off) ((T*)(C.ws + (off)))
#define INP(k) ((const float*)g8::uni_ptr((const char*)(*(const LAS unsigned long long*)(C.lds + LDS_PTRS + 8 * (k)))))
template <class T> __device__ __forceinline__ T* opq_ptr(T* p) { const unsigned long long v = (unsigned long long)p; unsigned lo = __builtin_amdgcn_readfirstlane((unsigned)v), hi = __builtin_amdgcn_readfirstlane((unsigned)(v >> 32));
    asm volatile("" : "+s"(lo), "+s"(hi)); return (T*)(GAS T*)(((unsigned long long)hi << 32) | lo); }
__device__ __forceinline__ int opq_int(int v) { int r = __builtin_amdgcn_readfirstlane(v); asm volatile("" : "+s"(r)); return r; }
#define CTX_LOCAL(Csrc) Ctx C = (Csrc); C.ws = opq_ptr(C.ws); C.out = opq_ptr(C.out); C.vcu = opq_int(C.vcu); C.G = opq_int(C.G)
#define PHASE_IDS() const int tid = fresh_tid(), lane = tid & 63, w = __builtin_amdgcn_readfirstlane(tid >> 6); (void)lane; (void)w

__device__ __forceinline__ void tr_item(const float* src, int ld, bf16* dst, int K, float scale, LAS float* scr, int lane, bool quant = false) {
    float tv[32];
    const char* sb = g8::uni_ptr((const char*)src); const unsigned o0 = (unsigned)((lane >> 5) * ld + (lane & 31)) * 4u;
#pragma unroll
    for (int i = 0; i < 32; ++i) tv[i] = *(const float*)(sb + o0 + (unsigned)(2 * i * ld) * 4u);
#pragma unroll
    for (int i = 0; i < 32; ++i) scr[(2 * i + (lane >> 5)) * 33 + (lane & 31)] = quant ? q8(tv[i] * scale, kf(256.f), kf(1.f / 256.f)) : tv[i] * scale;
    LDS_WAIT(); asm volatile("" ::: "memory");
    const int c = lane & 7;
#pragma unroll
    for (int j = 0; j < 4; ++j) { const int n = (lane >> 3) + 8 * j; const LAS float* s = scr + (8 * c) * 33 + n;
        u32x4 o; o.x = cvt_pk_bf16(s[0 * 33], s[1 * 33]); o.y = cvt_pk_bf16(s[2 * 33], s[3 * 33]);
        o.z = cvt_pk_bf16(s[4 * 33], s[5 * 33]); o.w = cvt_pk_bf16(s[6 * 33], s[7 * 33]);
        *(u32x4*)(dst + (size_t)n * K + 8 * c) = o; }
    LDS_WAIT(); asm volatile("" ::: "memory");
}
__device__ __forceinline__ void tr_item8(const float* src, int ld, unsigned char* dst, int K, float scale, LAS float* scr, int lane, int lanecol = -1) {
    const char* sb = g8::uni_ptr((const char*)src); const unsigned o0 = (unsigned)((lane >> 5) * ld + (lanecol >= 0 ? lanecol : (lane & 31))) * 4u;
#pragma unroll
    for (int hk = 0; hk < 2; ++hk) { float tv[32];
#pragma unroll
        for (int i = 0; i < 32; ++i) tv[i] = __builtin_nontemporal_load((const float*)(sb + o0 + (unsigned)((64 * hk + 2 * i) * ld) * 4u));
#pragma unroll
        for (int i = 0; i < 32; ++i) scr[(64 * hk + 2 * i + (lane >> 5)) * 33 + (lane & 31)] = tv[i] * (scale * kf(256.0f)); }
    LDS_WAIT(); asm volatile("" ::: "memory");
    const int c = lane & 7;
#pragma unroll
    for (int j = 0; j < 4; ++j) { const int n = (lane >> 3) + 8 * j; const LAS float* s = scr + (16 * c) * 33 + n;
        u32x4 o;
#pragma unroll
        for (int q = 0; q < 4; ++q) { int w = __builtin_amdgcn_cvt_pk_fp8_f32(s[(4 * q) * 33], s[(4 * q + 1) * 33], 0, false); w = __builtin_amdgcn_cvt_pk_fp8_f32(s[(4 * q + 2) * 33], s[(4 * q + 3) * 33], w, true); o[q] = (unsigned)w; }
        *(u32x4*)(dst + (size_t)n * K + 16 * c) = o; }
    LDS_WAIT(); asm volatile("" ::: "memory");
}
__device__ __forceinline__ int win_src_col(int dcol) {
    return dcol < 1024 ? dcol : dcol < 2048 ? 3072 + (dcol - 1024) : dcol < 3072 ? 1024 + (dcol - 2048) : dcol < 3584 ? 2048 + (dcol - 3072) : dcol < 4096 ? 2560 + (dcol - 3584)
         : dcol < 5120 ? 4096 + (dcol - 4096) : (((dcol - 5120) >> 3) & 1) ? 6152 + 128 * ((dcol - 5120) >> 8) + 32 * (((dcol - 5120) & 255) >> 6) + 8 * ((((dcol - 5120) & 255) >> 4) & 3) + ((dcol - 5120) & 7)
                                                                        : 5128 + 128 * ((dcol - 5120) >> 8) + 32 * (((dcol - 5120) & 255) >> 6) + 8 * ((((dcol - 5120) & 255) >> 4) & 3) + ((dcol - 5120) & 7);
}
__device__ __forceinline__ void emit_xb_gates(const f32x4 (&v)[4], int m, bf16* XB, float* IFp, const LAS float* wif, const float* bif, int lane) {
    float g[8];
#pragma unroll
    for (int q = 0; q < 8; ++q) g[q] = 0.f;
#pragma unroll
    for (int j = 0; j < 4; ++j) {
        { int w8 = __builtin_amdgcn_cvt_pk_fp8_f32(v[j][0] * 16.f, v[j][1] * 16.f, 0, false); w8 = __builtin_amdgcn_cvt_pk_fp8_f32(v[j][2] * 16.f, v[j][3] * 16.f, w8, true);
          *(int*)((unsigned char*)XB + (size_t)m * D + 256 * j + 4 * lane) = w8; }
#pragma unroll
        for (int e = 0; e < 4; ++e) { const int k = 256 * j + 4 * lane + e; const f32x4 w0 = *(const LAS f32x4*)(wif + k * 8), w1 = *(const LAS f32x4*)(wif + k * 8 + 4); const float x = v[j][e];
            g[0] += x * w0[0]; g[1] += x * w0[1]; g[2] += x * w0[2]; g[3] += x * w0[3]; g[4] += x * w1[0]; g[5] += x * w1[1]; g[6] += x * w1[2]; g[7] += x * w1[3]; }
    }
#pragma unroll
    for (int q = 0; q < 8; ++q) g[q] = wave_sum(g[q]);
    if (lane == 0) { *(f32x4*)(IFp + (size_t)m * 8) = (f32x4){g[0] + bif[0], g[1] + bif[1], g[2] + bif[2], g[3] + bif[3]}; *(f32x4*)(IFp + (size_t)m * 8 + 4) = (f32x4){g[4] + bif[4], g[5] + bif[5], g[6] + bif[6], g[7] + bif[7]}; }
}
__device__ __forceinline__ void load_wif(const Ctx& C0, int l, LAS float* wif) {
    CTX_LOCAL(C0);
    const float* win = INP(I_WIN) + (size_t)l * D * DIN;
    for (int i = fresh_tid(); i < 1024 * 8; i += 512) wif[i] = win[(size_t)(i >> 3) * DIN + 5120 + (i & 7)];
    __syncthreads();
}
__device__ __forceinline__ void phase_convert(const Ctx& C0, int l, bool with_x0) {
    CTX_LOCAL(C0);
    PHASE_IDS();
    const int gw = C.vcu * 8 + w, NGW = C.G * 8;
    LAS float* scr = (LAS float*)(C.lds + w * 16896);
    const float* win = INP(I_WIN) + (size_t)l * D * DIN;
    bf16* WinT = WSP(bf16, WS_WIN); bf16* W4 = WSP(bf16, WS_W4); bf16* UpT = WSP(bf16, WS_UPT); bf16* DnT = WSP(bf16, WS_DNT); bf16* WpT = WSP(bf16, WS_WPT);
    constexpr int N0 = 1792, N1 = 768 + 256, N2 = 65 * 128, N3 = 64 * 64 + 64, N4 = 64, NIT = N0 + N1 + N2 + N3 + N4;
    LAS float* scr8 = scr;
    for (int it = gw; it < NIT; it += NGW) {
        int r = it;
        if (r < N0) { const int kb = r / 224, nb = r % 224, dcol = 32 * nb; const int sc = win_src_col(dcol); const float sq = (dcol >= ZQ && dcol < ZK) ? kf(QSCALE) : 1.0f;
            tr_item8(win + (size_t)(128 * kb) * DIN, DIN, (unsigned char*)WinT + (size_t)dcol * D + 128 * kb, D, sq, scr8, lane, win_src_col(dcol + (lane & 31))); (void)sc; continue; }
        r -= N0;
        if (r < N1) {
            if (r < 512) { const int which = r >> 8, rr = r & 255, kb = rr >> 5, nb = rr & 31;
                tr_item8((which == 0 ? INP(I_WPA) : INP(I_WPB)) + (size_t)l * D * D + (size_t)(128 * kb) * D + 32 * nb, D, (unsigned char*)W4 + (size_t)(32 * nb) * 2048 + which * 1024 + 128 * kb, 2048, 1.0f, scr, lane); }
            else if (r < 768) { const int rr = r - 512, kb = rr >> 5, nb = rr & 31;
                tr_item8(INP(I_WOUT) + (size_t)l * D * D + (size_t)(128 * kb) * D + 32 * nb, D, (unsigned char*)(W4 + (size_t)2 * D * D) + (size_t)(32 * nb) * D + 128 * kb, D, 1.0f, scr, lane); }
            else { const int rr = r - 768, kb = rr >> 5, nb = rr & 31;
                tr_item8(INP(I_WPG) + (size_t)l * D * D + (size_t)(128 * kb) * D + 32 * nb, D, (unsigned char*)(W4 + (size_t)3 * D * D) + (size_t)(32 * nb) * D + 128 * kb, D, 1.0f, scr, lane); }
            continue; }
        r -= N1;
        if (r < N2) { const int e = r >> 7, rr = r & 127, isup = rr >> 6, r2 = rr & 63, kb = r2 >> 3, cb = r2 & 7;
            const float* src = e < 64 ? ((isup ? INP(I_WUE) : INP(I_WGE)) + ((size_t)l * 64 + e) * D * DEXP) : ((isup ? INP(I_WUS) : INP(I_WGS)) + (size_t)l * D * DEXP);
            const int drow = (cb >> 2) * 256 + isup * 128 + (cb & 3) * 32;
            tr_item8(src + (size_t)(128 * kb) * DEXP + 32 * cb, DEXP, (unsigned char*)UpT + ((size_t)e * 512 + drow) * D + 128 * kb, D, 1.0f, scr, lane); continue; }
        r -= N2;
        if (r < N3) {
            if (r < 64 * 64) { const int e = r >> 6, rr = r & 63, kb = rr >> 5, nb = rr & 31;
                tr_item8(INP(I_WDE) + ((size_t)l * 64 + e) * DEXP * D + (size_t)(128 * kb) * D + 32 * nb, D, (unsigned char*)DnT + (size_t)e * D * DEXP + (size_t)(32 * nb) * DEXP + 128 * kb, DEXP, 1.0f, scr, lane); }
            else { const int rr = r - 64 * 64, kb = rr >> 5, nb = rr & 31;
                tr_item8(INP(I_WDS) + (size_t)l * DEXP * D + (size_t)(128 * kb) * D + 32 * nb, D, (unsigned char*)WpT + (size_t)(32 * nb) * 512 + 256 + 128 * kb, 512, 1.0f, scr, lane); }
            continue; }
        r -= N3;
        { const int kb = r >> 5, nb = r & 31; const float* src = INP(I_WP) + (size_t)l * PD * D;
            tr_item8(src + (size_t)(128 * kb) * D + 32 * nb, D, (unsigned char*)WpT + (size_t)(32 * nb) * 512 + 128 * kb, 512, 1.0f, scr, lane); }
    }
    const int gt = C.vcu * 512 + tid, NGT = C.G * 512;
    {
        float* b1 = WSP(float, WS_BIAS1); const float* bin = INP(I_BIN) + (size_t)l * DIN;
        for (int j = gt; j < ZW; j += NGT) b1[j] = bin[win_src_col(j)] * ((j >= ZQ && j < ZK) ? kf(QSCALE) : 1.0f);
        bf16* wsb = WSP(bf16, WS_WSB); const float* wsf = INP(I_WS) + (size_t)l * 8 * 128 * 128;
        for (int j = gt; j < 8 * 128 * 128; j += NGT) { const int t = (j >> 7) & 127, s = j & 127; wsb[j] = ((s >> 6) <= (t >> 6)) ? f2bf(wsf[j]) : (bf16)0; }
    }
    if (with_x0) {
        __syncthreads();
        LAS float* wif = (LAS float*)C.lds;
        load_wif(C, 0, wif);
        const float* bif = INP(I_BIN) + 5120;
        for (int m = gw; m < M; m += NGW) { f32x4 v[4];
#pragma unroll
            for (int j = 0; j < 4; ++j) v[j] = *(const f32x4*)(INP(I_X) + (size_t)m * D + 256 * j + 4 * lane);
            emit_xb_gates(v, m, WSP(bf16, WS_XB), WSP(float, WS_IF), wif, bif, lane); }
    }
}

__device__ __forceinline__ void convert_pb(const Ctx& C0, int l) {
    CTX_LOCAL(C0);
    const int gt = C.vcu * 512 + fresh_tid(), NGT = C.G * 512;
    const f32x4* p4 = (const f32x4*)(INP(I_P) + (size_t)l * M * PD); unsigned char* o = WSP(unsigned char, WS_PBH);
    for (int j = gt; j < M * PD / 16; j += NGT) { const f32x4 a = __builtin_nontemporal_load(p4 + 4 * j), b = __builtin_nontemporal_load(p4 + 4 * j + 1), c = __builtin_nontemporal_load(p4 + 4 * j + 2), d = __builtin_nontemporal_load(p4 + 4 * j + 3);
        *(u32x4*)(o + (size_t)(j >> 4) * 512 + (j & 15) * 16) = (u32x4){pk4_fp8x16(a[0], a[1], a[2], a[3]), pk4_fp8x16(b[0], b[1], b[2], b[3]), pk4_fp8x16(c[0], c[1], c[2], c[3]), pk4_fp8x16(d[0], d[1], d[2], d[3])}; }
}
__device__ __forceinline__ void phase_gates(const Ctx& C0) {
    CTX_LOCAL(C0);
    PHASE_IDS();
    const int gw = C.vcu * 8 + w, NGW = C.G * 8;
    const float* IFp = WSP(float, WS_IF); float* BC = WSP(float, WS_BC); float* BL = WSP(float, WS_BL); float* GM = WSP(float, WS_GM);
    for (int task = gw; task < 32 * NCH; task += NGW) {
        const int bh = task >> 7, c = task & 127, b = bh >> 2, h = bh & 3; const size_t m = (size_t)b * SEQ + 64 * c + lane;
        const float ip = IFp[m * 8 + h], fp = IFp[m * 8 + 4 + h];
        const float lf = fminf(fp, 0.f) - __builtin_amdgcn_logf(1.0f + __builtin_amdgcn_exp2f(-fabsf(fp) * kf(1.4426950408889634f))) * kf(0.6931471805599453f);
        float v = lf;
#pragma unroll
        for (int o = 1; o < 64; o <<= 1) { const float t = shfl_idx(v, lane - o); if (lane >= o) v += t; }
        const float blast = rdlane(v, 63);
        const float gmax = wave_max(blast - v + ip);
        BC[m * 4 + h] = v;
        if (lane == 0) { BL[task] = blast; GM[task] = gmax; }
    }
}
__device__ __forceinline__ void mstate(const float* BL, const float* GM, int bh, int c, int lane, float& mc, float& mn) {
    const float bl0 = BL[bh * 128 + lane], bl1 = BL[bh * 128 + 64 + lane], gm0 = GM[bh * 128 + lane], gm1 = GM[bh * 128 + 64 + lane];
    float m = 0.f, prev = 0.f;
    for (int cc = 0; cc <= c; ++cc) {
        const float bl = __shfl(cc < 64 ? bl0 : bl1, cc & 63), gm = __shfl(cc < 64 ? gm0 : gm1, cc & 63);
        prev = m; m = fmaxf(bl + m, gm);
    }
    mc = prev; mn = m;
}

__device__ __forceinline__ void phase_sgu(const Ctx& C0, int l) {
    CTX_LOCAL(C0);
    PHASE_IDS();
    const unsigned char* Z8 = WSP(unsigned char, WS_Z); const float* VP = WSP(float, WS_VPART); unsigned char* AB8 = (unsigned char*)C.out;
    constexpr int PW = 272;
    LAS unsigned char* Wt = C.lds; LAS unsigned char* Vn = C.lds + 128 * PW; LAS float* Dt = (LAS float*)(C.lds + 2 * 128 * PW);
    LAS f32x2* Sst = (LAS f32x2*)(C.lds + 2 * 128 * PW + 128 * 132 * 4);
#define SGU_STATS(mrow, slot) do { if (tid < 128) { const f32x4* p_ = (const f32x4*)(VP + ((mrow) + tid) * 32); float s1_ = 0.f, s2_ = 0.f; \
        _Pragma("unroll") for (int k_ = 0; k_ < 8; ++k_) { const f32x4 q_ = p_[k_]; s1_ += q_[0] + q_[2]; s2_ += q_[1] + q_[3]; } \
        const float mean_ = s1_ * (1.0f / 1024.0f), var_ = fmaxf(s2_ * (1.0f / 1024.0f) - mean_ * mean_, 0.f); Sst[(slot) * 128 + tid] = (f32x2){mean_, __builtin_amdgcn_rsqf(var_ + kf(LN_EPS))}; } } while (0)
    const int ch = tid & 7, r0 = tid >> 3;
    const int chw = tid & 15, rw = tid >> 4;
    int gcur = -1; f32x4 gg[4], bb[4]; float bt[2];
    u32x4 pv[2]; int it = 0;
    int u = C.vcu;
    if (u < 4096) { const size_t m0 = (size_t)(u >> 3) * 128; const int g = u & 7;
#pragma unroll
        for (int i = 0; i < 2; ++i) pv[i] = *(const u32x4*)(Z8 + (m0 + r0 + 64 * i) * Z8W + ZV + 128 * g + 16 * ch);
        SGU_STATS(m0, 0); }
    __syncthreads();
    for (; u < 4096; u += C.G, ++it) {
        const int g = u & 7; const size_t m0 = (size_t)(u >> 3) * 128;
        if (g != gcur) {
            if (gcur >= 0) __syncthreads();
            gcur = g;
            const bf16* wsb = WSP(bf16, WS_WSB) + (size_t)g * 128 * 128;
#pragma unroll
            for (int i = 0; i < 4; ++i) *(LAS u32x4*)(Wt + (rw + 32 * i) * PW + chw * 16) = *(const u32x4*)(wsb + (rw + 32 * i) * 128 + chw * 8);
            const float* lng = INP(I_SGG) + (size_t)l * 1024 + 128 * g; const float* lnb = INP(I_SGB) + (size_t)l * 1024 + 128 * g; const float* bs = INP(I_BS) + (size_t)l * 1024 + 128 * g;
#pragma unroll
            for (int q = 0; q < 4; ++q) { gg[q] = *(const f32x4*)(lng + 16 * ch + 4 * q); bb[q] = *(const f32x4*)(lnb + 16 * ch + 4 * q); }
#pragma unroll
            for (int i = 0; i < 2; ++i) bt[i] = bs[r0 + 64 * i];
        }
#pragma unroll
        for (int i = 0; i < 2; ++i) { const f32x2 st = Sst[(it & 1) * 128 + r0 + 64 * i]; float x[16]; un16_fp8x16(pv[i], x);
#pragma unroll
            for (int q = 0; q < 4; ++q)
#pragma unroll
                for (int j = 0; j < 4; ++j) x[4 * q + j] = (x[4 * q + j] - st.x) * st.y * gg[q][j] + bb[q][j];
            bf16x16_to_lds(Vn + (r0 + 64 * i) * PW + ch * 32, x); }
        __syncthreads();
        const int un = u + C.G;
        if (un < 4096) { const size_t mn = (size_t)(un >> 3) * 128; const int gn = un & 7;
#pragma unroll
            for (int i = 0; i < 2; ++i) pv[i] = *(const u32x4*)(Z8 + (mn + r0 + 64 * i) * Z8W + ZV + 128 * gn + 16 * ch);
            SGU_STATS(mn, (it + 1) & 1); }
        u32x4 pu[2];
#pragma unroll
        for (int i = 0; i < 2; ++i) pu[i] = *(const u32x4*)(Z8 + (m0 + r0 + 64 * i) * Z8W + ZU + 128 * g + 16 * ch);
        f32x4 acc[8];
#pragma unroll
        for (int j = 0; j < 8; ++j) acc[j] = (f32x4){0.f, 0.f, 0.f, 0.f};
#pragma unroll
        for (int ks = 0; ks < 4; ++ks) { const bf16x8 a = frag_row(Wt, PW, 16 * w, 32 * ks, lane);
#pragma unroll
            for (int j = 0; j < 8; ++j) acc[j] = MFMA16(a, frag_tr(Vn, PW, 32 * ks, 16 * j, lane), acc[j]); }
#pragma unroll
        for (int j = 0; j < 8; ++j)
#pragma unroll
            for (int r = 0; r < 4; ++r) Dt[(16 * w + 4 * (lane >> 4) + r) * 132 + 16 * j + (lane & 15)] = acc[j][r];
        __syncthreads();
#pragma unroll
        for (int i = 0; i < 2; ++i) { const int t = r0 + 64 * i; const float bq = bt[i]; float uu[16]; un16_fp8x16(pu[i], uu); u32x4 o;
#pragma unroll
            for (int q = 0; q < 4; ++q) { const f32x4 d = *(const LAS f32x4*)(Dt + t * 132 + 16 * ch + 4 * q);
                o[q] = pk4_fp8x16(uu[4 * q] * (d[0] + bq), uu[4 * q + 1] * (d[1] + bq), uu[4 * q + 2] * (d[2] + bq), uu[4 * q + 3] * (d[3] + bq)); }
            *(u32x4*)(AB8 + (m0 + t) * 2048 + 128 * g + 16 * ch) = o; }
    }
    __syncthreads();
#undef SGU_STATS
}

__device__ __forceinline__ void phase_kv(const Ctx& C0) {
    CTX_LOCAL(C0);
    PHASE_IDS();
    const unsigned char* Z8 = WSP(unsigned char, WS_Z); const float* IFp = WSP(float, WS_IF); const float* BC = WSP(float, WS_BC); const float* BL = WSP(float, WS_BL); const float* GM = WSP(float, WS_GM);
    constexpr int PV = 528, PK = 272, PO = 144;
    LAS unsigned char* Vs = C.lds; LAS unsigned char* Ks = C.lds + 64 * PV; LAS unsigned char* Ot = C.lds + 64 * PV + 64 * PK;
    const int sv = tid >> 4, chv = tid & 15, sk = tid >> 3, chk = tid & 7;
    u32x4 pv[2], pk; float pbc, pif;
    int u = C.vcu;
    if (u < 4096) { const int bh = u >> 7, c = u & 127, b = bh >> 2, h = bh & 3; const size_t m0 = (size_t)b * SEQ + 64 * c;
#pragma unroll
        for (int i = 0; i < 2; ++i) pv[i] = *(const u32x4*)(Z8 + (m0 + sv + 32 * i) * Z8W + ZVM + 256 * h + 16 * chv);
        pk = *(const u32x4*)(Z8 + (m0 + sk) * Z8W + ZK + 128 * h + 16 * chk); pbc = BC[(m0 + sk) * 4 + h]; pif = IFp[(m0 + sk) * 8 + h]; }
    for (; u < 4096; u += C.G) {
        const int bh = u >> 7, c = u & 127;
        unsigned char* ST = WSP(unsigned char, WS_STATE) + (size_t)u * 32768; float* NK = WSP(float, WS_NK) + (size_t)u * 128;
        float mc, mn; mstate(BL, GM, bh, c, lane, mc, mn);
        const float blast = BL[u];
#pragma unroll
        for (int i = 0; i < 2; ++i) { float x[16]; un16_fp8x16(pv[i], x); bf16x16_to_lds(Vs + (sv + 32 * i) * PV + chv * 32, x); }
        { const float wgt = expf(blast - pbc + pif - mn); float x[16]; un16_fp8x16(pk, x);
#pragma unroll
          for (int j = 0; j < 16; ++j) x[j] *= wgt;
          bf16x16_to_lds(Ks + sk * PK + chk * 32, x); }
        __syncthreads();
        const int un = u + C.G;
        if (un < 4096) { const int bhn = un >> 7, cn = un & 127, bn = bhn >> 2, hn = bhn & 3; const size_t mn0 = (size_t)bn * SEQ + 64 * cn;
#pragma unroll
            for (int i = 0; i < 2; ++i) pv[i] = *(const u32x4*)(Z8 + (mn0 + sv + 32 * i) * Z8W + ZVM + 256 * hn + 16 * chv);
            pk = *(const u32x4*)(Z8 + (mn0 + sk) * Z8W + ZK + 128 * hn + 16 * chk); pbc = BC[(mn0 + sk) * 4 + hn]; pif = IFp[(mn0 + sk) * 8 + hn]; }
        if (tid < 128) { float sm = 0.f;
#pragma unroll
            for (int r = 0; r < 64; ++r) sm += bf2f(*(const LAS bf16*)(Ks + r * PK + tid * 2));
            NK[tid] = sm; }
        f32x4 acc[2][8];
#pragma unroll
        for (int i = 0; i < 2; ++i)
#pragma unroll
            for (int j = 0; j < 8; ++j) acc[i][j] = (f32x4){0.f, 0.f, 0.f, 0.f};
#pragma unroll
        for (int ks = 0; ks < 2; ++ks) {
            bf16x8 bfr[8];
#pragma unroll
            for (int j = 0; j < 8; ++j) bfr[j] = frag_tr(Ks, PK, 32 * ks, 16 * j, lane);
#pragma unroll
            for (int i = 0; i < 2; ++i) { const bf16x8 a = frag_tr(Vs, PV, 32 * ks, 32 * w + 16 * i, lane);
#pragma unroll
                for (int j = 0; j < 8; ++j) acc[i][j] = MFMA16(a, bfr[j], acc[i][j]); }
        }
#pragma unroll
        for (int i = 0; i < 2; ++i)
#pragma unroll
            for (int j = 0; j < 8; ++j) { const unsigned pw = pk4_fp8x4(acc[i][j][0], acc[i][j][1], acc[i][j][2], acc[i][j][3]);
#pragma unroll
                for (int r = 0; r < 4; ++r) *(LAS unsigned char*)(Ot + (32 * w + 16 * i + 4 * (lane >> 4) + r) * PO + 16 * j + (lane & 15)) = (unsigned char)(pw >> (8 * r)); }
        __syncthreads();
#pragma unroll
        for (int i = 0; i < 4; ++i) { const int idx = tid + 512 * i, v = idx >> 3, chq = idx & 7;
            *(u32x4*)(ST + v * 128 + 16 * chq) = *(const LAS u32x4*)(Ot + v * PO + chq * 16); }
    }
    __syncthreads();
}

__device__ __forceinline__ void phase_kvchain(const Ctx& C0) {
    CTX_LOCAL(C0);
    PHASE_IDS();
    const unsigned char* Z8 = WSP(unsigned char, WS_Z); const float* IFp = WSP(float, WS_IF); const float* BC = WSP(float, WS_BC);
    constexpr int PK = 272, PVS = 80, BUF = 64 * PK + 64 * PVS;
    const int sk = tid >> 3, chk = tid & 7;
    const int svr = (tid >> 1) & 63, svh = tid & 1;
    const int vi = w & 1, dj = 2 * (w >> 1);
    unsigned one2 = 0x41804180u; asm volatile("" : "+v"(one2));
    const bf16x8 ones = __builtin_bit_cast(bf16x8, (u32x4){one2, one2, one2, one2});
    __syncthreads();
    for (int item = C.vcu; item < 256; item += C.G) {
        const int bh = item >> 3, vs = item & 7, b = bh >> 2, h = bh & 3;
        const float* BL = WSP(float, WS_BL) + bh * 128; const float* GM = WSP(float, WS_GM) + bh * 128; float* MS = WSP(float, WS_MS) + bh * 129;
        unsigned char* ST = WSP(unsigned char, WS_STATE) + (size_t)bh * 128 * 32768 + (size_t)(32 * vs + 16 * vi + (lane & 15)) * 128 + 16 * dj + 4 * (lane >> 4);
        float* NK = WSP(float, WS_NK) + (size_t)bh * 128 * 128 + 16 * dj + 4 * (lane >> 4);
        const unsigned char* zk = Z8 + ((size_t)b * SEQ + sk) * Z8W + ZK + 128 * h + 16 * chk;
        const unsigned char* zv = Z8 + ((size_t)b * SEQ + svr) * Z8W + ZVM + 256 * h + 32 * vs + 16 * svh;
        const float* bcp = BC + ((size_t)b * SEQ + sk) * 4 + h; const float* ifp = IFp + ((size_t)b * SEQ + sk) * 8 + h;
        const float bl0 = BL[lane], bl1 = BL[64 + lane], gm0 = GM[lane], gm1 = GM[64 + lane];
        u32x4 rk[2], rv[2]; float rbc[2], rif[2]; rv[0] = rv[1] = (u32x4){0u, 0u, 0u, 0u};
        float mrun = 0.f, dcur = 0.f, dnxt = 0.f;
        f32x4 Cst[2] = {(f32x4){0.f, 0.f, 0.f, 0.f}, (f32x4){0.f, 0.f, 0.f, 0.f}}, Nst[2] = {(f32x4){0.f, 0.f, 0.f, 0.f}, (f32x4){0.f, 0.f, 0.f, 0.f}};
#define KVC_LOAD(R, c_) do { const size_t o_ = (size_t)(c_) * 64; rk[R] = *(const u32x4*)(zk + o_ * Z8W); if (tid < 128) rv[R] = *(const u32x4*)(zv + o_ * Z8W); rbc[R] = bcp[o_ * 4]; rif[R] = ifp[o_ * 8]; } while (0)
#define KVC_PREP(R, c_, decv) do { const int ci_ = (c_); const float bl_ = rdlane(ci_ < 64 ? bl0 : bl1, ci_ & 63), gm_ = rdlane(ci_ < 64 ? gm0 : gm1, ci_ & 63); \
            const float mn_ = fmaxf(bl_ + mrun, gm_); decv = fast_exp(bl_ + mrun - mn_); if (vs == 0 && tid == 0) MS[ci_] = mrun; mrun = mn_; \
            LAS unsigned char* kb_ = C.lds + (ci_ & 1) * BUF; \
            { const float wgt_ = fast_exp(bl_ - rbc[R] + rif[R] - mn_) * (1.0f / 256.0f); float x_[16]; un16_fp8raw(rk[R], x_); _Pragma("unroll") for (int j_ = 0; j_ < 16; ++j_) x_[j_] *= wgt_; bf16x16_to_lds(kb_ + sk * PK + chk * 32, x_); } \
            if (tid < 128) { float x_[16]; un16_fp8raw(rv[R], x_); bf16x16_to_lds(kb_ + 64 * PK + svr * PVS + svh * 32, x_); } } while (0)
#define KVC_STEP(cc_, R) do { const int cc = (cc_); \
            if (cc + 1 < 128) { KVC_PREP(R, cc + 1, dnxt); if (cc + 3 < 128) KVC_LOAD(R, cc + 3); } \
            const LAS unsigned char* kb = C.lds + (cc & 1) * BUF; const LAS unsigned char* vb = kb + 64 * PK; \
            f32x4 kv_[2] = {(f32x4){0.f, 0.f, 0.f, 0.f}, (f32x4){0.f, 0.f, 0.f, 0.f}}, nn_[2] = {(f32x4){0.f, 0.f, 0.f, 0.f}, (f32x4){0.f, 0.f, 0.f, 0.f}}; \
            _Pragma("unroll") for (int ks = 0; ks < 2; ++ks) { const bf16x8 bv = frag_tr(vb, PVS, 32 * ks, 16 * vi, lane); \
                _Pragma("unroll") for (int j = 0; j < 2; ++j) { const bf16x8 ak = frag_tr(kb, PK, 32 * ks, 16 * (dj + j), lane); kv_[j] = MFMA16(ak, bv, kv_[j]); if (vi == 0) nn_[j] = MFMA16(ak, ones, nn_[j]); } } \
            _Pragma("unroll") for (int j = 0; j < 2; ++j) { Cst[j] = Cst[j] * dcur + kv_[j]; *(unsigned*)(ST + (size_t)cc * 32768 + 16 * j) = pk4_fp8x4(Cst[j][0], Cst[j][1], Cst[j][2], Cst[j][3]); } \
            if (vi == 0) { _Pragma("unroll") for (int j = 0; j < 2; ++j) { Nst[j] = Nst[j] * dcur + nn_[j]; if (vs == 0 && (lane & 15) == 0) *(f32x4*)(NK + cc * 128 + 16 * j) = Nst[j]; } } \
            __syncthreads(); dcur = dnxt; } while (0)
        KVC_LOAD(0, 0);
        KVC_PREP(0, 0, dcur);
        KVC_LOAD(1, 1); KVC_LOAD(0, 2);
        __syncthreads();
#pragma unroll 1
        for (int c = 0; c < 128; c += 2) { KVC_STEP(c, 1); KVC_STEP(c + 1, 0); }
#undef KVC_LOAD
#undef KVC_PREP
#undef KVC_STEP
    }
}

__device__ __forceinline__ void phase_scan(const Ctx& C0, bool dry = false) {
    CTX_LOCAL(C0);
    for (int gt = C.vcu * 512 + fresh_tid(); gt < 32 * 4096; gt += C.G * 512) {
    const int bh = gt >> 12, e8 = gt & 4095;
    const float* BL = WSP(float, WS_BL) + bh * 128; const float* GM = WSP(float, WS_GM) + bh * 128; float* MS = WSP(float, WS_MS) + bh * 129;
    unsigned char* ST = WSP(unsigned char, WS_STATE) + (size_t)bh * 128 * 32768 + (size_t)e8 * 8; float* NK = WSP(float, WS_NK) + (size_t)bh * 128 * 128 + e8;
    float st[8]; float m = 0.f, nst = 0.f;
#pragma unroll
    for (int j = 0; j < 8; ++j) st[j] = 0.f;
    for (int c0 = 0; c0 < 128; c0 += 16) {
        u32x2 kv[16]; float nk[16];
#pragma unroll
        for (int i = 0; i < 16; ++i) { kv[i] = *(const u32x2*)(ST + (size_t)(c0 + i) * 32768); nk[i] = e8 < 128 ? NK[(c0 + i) * 128] : 0.f; }
#pragma unroll
        for (int i = 0; i < 16; ++i) { const int c = c0 + i; const float bl = BL[c], gm = GM[c]; const float mn = fmaxf(bl + m, gm), dec = expf(bl + m - mn);
            if (e8 == 0 && !dry) MS[c] = m;
            m = mn;
            const f32x4 k0 = un4_fp8x4(kv[i].x), k1 = un4_fp8x4(kv[i].y);
            st[0] = dec * st[0] + k0[0]; st[1] = dec * st[1] + k0[1]; st[2] = dec * st[2] + k0[2]; st[3] = dec * st[3] + k0[3];
            st[4] = dec * st[4] + k1[0]; st[5] = dec * st[5] + k1[1]; st[6] = dec * st[6] + k1[2]; st[7] = dec * st[7] + k1[3];
            const u32x2 o = (u32x2){pk4_fp8x4(st[0], st[1], st[2], st[3]), pk4_fp8x4(st[4], st[5], st[6], st[7])};
            if (dry) *(u32x2*)(WSP(unsigned char, WS_XB) + (size_t)bh * 1048576 + (size_t)(c & 31) * 32768 + (size_t)e8 * 8) = o; else *(u32x2*)(ST + (size_t)c * 32768) = o;
            if (e8 < 128) { nst = dec * nst + nk[i]; if (!dry) NK[c * 128] = nst; } }
    }
    }
}

__device__ __forceinline__ void phase_mlstm(const Ctx& C0, int l) {
    CTX_LOCAL(C0);
    PHASE_IDS();
    const unsigned char* Z8 = WSP(unsigned char, WS_Z); const float* IFp = WSP(float, WS_IF); const float* BC = WSP(float, WS_BC); const float* MS = WSP(float, WS_MS); unsigned char* AB8 = (unsigned char*)C.out;
    constexpr int PQ = 144, PV = 528, PC = 144, PP = 144;
    constexpr int OQ = 0, OK_ = 64 * PQ, OC = OK_ + 64 * PQ, OV = OC + 256 * PC, OP = OV + 64 * PV, OS = OP + 64 * PP;
    LAS unsigned char* Qs = C.lds + OQ; LAS unsigned char* Ks = C.lds + OK_; LAS unsigned char* Vs = C.lds + OV; LAS unsigned char* Cs = C.lds + OC; LAS unsigned char* Ps = C.lds + OP;
    LAS float* sA = (LAS float*)(C.lds + OS); LAS float* sPM = sA + 64; LAS float* sWI = sA + 128; LAS float* sEN = sA + 192; LAS float* sDN = sA + 256; LAS float* sN = sA + 320;
    constexpr int PH = 528;
    LAS unsigned char* Hs = C.lds + OS + 6144;
    LAS float* sG = (LAS float*)(C.lds + OS + 2048);
    { const float* mg_ = INP(I_MHG) + (size_t)l * 1024; for (int i = tid; i < 1024; i += 512) sG[i] = mg_[i]; }
    const int sq = tid >> 3, chq = tid & 7, sv = tid >> 4, chv = tid & 15;
    const int sc = tid >> 3, chc = tid & 7;
    u32x4 pq, pk, pv[2], pc[4]; float pn = 0.f, pbc = 0.f, pip = 0.f, pmc = 0.f;
#define MLSTM_PREFETCH(uu) do { const int bh_ = (uu) >> 7, c_ = (uu) & 127, b_ = bh_ >> 2, h_ = bh_ & 3; const size_t m_ = (size_t)b_ * SEQ + 64 * c_; \
        const unsigned char* st_ = WSP(unsigned char, WS_STATE) + (size_t)((uu) - 1) * 32768; \
        pq = *(const u32x4*)(Z8 + (m_ + sq) * Z8W + ZQ + 128 * h_ + 16 * chq); pk = *(const u32x4*)(Z8 + (m_ + sq) * Z8W + ZK + 128 * h_ + 16 * chq); \
        _Pragma("unroll") for (int i = 0; i < 2; ++i) pv[i] = *(const u32x4*)(Z8 + (m_ + sv + 32 * i) * Z8W + ZVM + 256 * h_ + 16 * chv); \
        _Pragma("unroll") for (int i = 0; i < 4; ++i) { pc[i] = (u32x4){0u, 0u, 0u, 0u}; if (c_ > 0) pc[i] = *(const u32x4*)(st_ + (sc + 64 * i) * 128 + 16 * chc); } \
        pn = (c_ > 0 && tid < 128) ? WSP(float, WS_NK)[(size_t)((uu) - 1) * 128 + (tid & 127)] : 0.f; \
        pbc = BC[(m_ + lane) * 4 + h_]; pip = IFp[(m_ + lane) * 8 + h_]; pmc = MS[bh_ * 129 + c_]; } while (0)
#define MLSTM_FILL() do { const float mc_ = pmc; \
        *(LAS u32x4*)(Qs + sq * PQ + chq * 16) = pq; *(LAS u32x4*)(Ks + sq * PQ + chq * 16) = pk; \
        _Pragma("unroll") for (int i = 0; i < 2; ++i) { float x[16]; un16_fp8x16(pv[i], x); bf16x16_to_lds(Vs + (sv + 32 * i) * PV + chv * 32, x); } \
        _Pragma("unroll") for (int i = 0; i < 4; ++i) *(LAS u32x4*)(Cs + (sc + 64 * i) * PC + chc * 16) = pc[i]; \
        if (tid < 128) sN[tid] = pn; \
        if (w == 0) { const float a = pip - pbc; float pm = a; \
            _Pragma("unroll") for (int o = 1; o < 64; o <<= 1) { const float t = shfl_idx(pm, lane - o); if (lane >= o) pm = fmaxf(pm, t); } \
            pm = fmaxf(pm, mc_); sA[lane] = a; sPM[lane] = pm; sWI[lane] = fast_exp(mc_ - pm); sEN[lane] = fast_exp(-pbc - pm); } } while (0)
    int u = C.vcu;
    if (u < 4096) { MLSTM_PREFETCH(u); MLSTM_FILL(); if (u + C.G < 4096) MLSTM_PREFETCH(u + C.G); }
    __syncthreads();
    for (; u < 4096; u += C.G) {
        const int bh = u >> 7, c = u & 127, b = bh >> 2, h = bh & 3; const size_t m0 = (size_t)b * SEQ + 64 * c; (void)c;
        const LAS float* mhg = sG + 256 * h;
        const int tf = tid >> 3, part = tid & 7;
        u32x4 po[2];
#pragma unroll
        for (int k8 = 0; k8 < 2; ++k8) po[k8] = *(const u32x4*)(Z8 + (m0 + tf) * Z8W + ZO + 256 * h + part * 32 + 16 * k8);
        {
            const int ti = w >> 1; f32x4 sa[2] = {(f32x4){0.f, 0.f, 0.f, 0.f}, (f32x4){0.f, 0.f, 0.f, 0.f}};
#pragma unroll
            for (int ks = 0; ks < 4; ++ks) { const long a = frag8(Qs, PQ, 16 * ti, 32 * ks, lane);
#pragma unroll
                for (int j = 0; j < 2; ++j) sa[j] = MFMA8(a, frag8(Ks, PQ, 16 * (2 * (w & 1) + j), 32 * ks, lane), sa[j]); }
#pragma unroll
            for (int j = 0; j < 2; ++j) { const int sc = 16 * (2 * (w & 1) + j) + (lane & 15); const float as = sA[sc];
#pragma unroll
                for (int r = 0; r < 4; ++r) { const int t = 16 * ti + 4 * (lane >> 4) + r; const float p = sc <= t ? sa[j][r] * (fast_exp(as - sPM[t]) * (1.0f / 256.0f)) : 0.f;
                    *(LAS bf16*)(Ps + t * PP + sc * 2) = f2bf(p); } }
        }
        __syncthreads();
        {
            const int t = tf;
            const u32x4 pr = *(const LAS u32x4*)(Ps + t * PP + part * 16);
            float ps = (bflo(pr.x) + bfhi(pr.x)) + (bflo(pr.y) + bfhi(pr.y)) + (bflo(pr.z) + bfhi(pr.z)) + (bflo(pr.w) + bfhi(pr.w));
            float qn = 0.f;
            { float qv[16]; un16_fp8x16(*(const LAS u32x4*)(Qs + t * PQ + part * 16), qv); const LAS float* nn = sN + part * 16;
#pragma unroll
              for (int i = 0; i < 16; ++i) qn += qv[i] * nn[i]; }
            ps = grp8_sum(ps);
            qn = grp8_sum(qn);
            if (part == 0) sDN[t] = fmaxf(fabsf(ps + sWI[t] * qn), sEN[t]);
        }
        f32x4 ac[4][2];
#pragma unroll
        for (int i = 0; i < 4; ++i)
#pragma unroll
            for (int j = 0; j < 2; ++j) ac[i][j] = (f32x4){0.f, 0.f, 0.f, 0.f};
#pragma unroll
        for (int ks = 0; ks < 4; ++ks) { long bc_[2];
#pragma unroll
            for (int j = 0; j < 2; ++j) bc_[j] = frag8(Cs, PC, 32 * w + 16 * j, 32 * ks, lane);
#pragma unroll
            for (int i = 0; i < 4; ++i) { const long a = frag8(Qs, PQ, 16 * i, 32 * ks, lane);
#pragma unroll
                for (int j = 0; j < 2; ++j) ac[i][j] = MFMA8(a, bc_[j], ac[i][j]); } }
#pragma unroll
        for (int i = 0; i < 4; ++i)
#pragma unroll
            for (int r = 0; r < 4; ++r) { const float wi = sWI[16 * i + 4 * (lane >> 4) + r] * (1.0f / 64.0f);
#pragma unroll
                for (int j = 0; j < 2; ++j) ac[i][j][r] *= wi; }
#pragma unroll
        for (int ks = 0; ks < 2; ++ks) { bf16x8 bv[2];
#pragma unroll
            for (int j = 0; j < 2; ++j) bv[j] = frag_tr(Vs, PV, 32 * ks, 32 * w + 16 * j, lane);
#pragma unroll
            for (int i = 0; i < 4; ++i) { const bf16x8 a = frag_row(Ps, PP, 16 * i, 32 * ks, lane);
#pragma unroll
                for (int j = 0; j < 2; ++j) ac[i][j] = MFMA16(a, bv[j], ac[i][j]); } }
#pragma unroll
        for (int i = 0; i < 4; ++i)
#pragma unroll
            for (int r = 0; r < 4; ++r) { const int t = 16 * i + 4 * (lane >> 4) + r;
#pragma unroll
                for (int j = 0; j < 2; ++j) *(LAS bf16*)(Hs + t * PH + (32 * w + 16 * j + (lane & 15)) * 2) = f2bf(ac[i][j][r]); }
        __syncthreads();
        {
            f32x4 hv[8]; float ss = 0.f; const float rd = __builtin_amdgcn_rcpf(sDN[tf]);
#pragma unroll
            for (int k8 = 0; k8 < 4; ++k8) { const u32x4 hq = *(const LAS u32x4*)(Hs + tf * PH + part * 64 + 16 * k8);
                hv[2 * k8] = (f32x4){bflo(hq.x), bfhi(hq.x), bflo(hq.y), bfhi(hq.y)} * rd; hv[2 * k8 + 1] = (f32x4){bflo(hq.z), bfhi(hq.z), bflo(hq.w), bfhi(hq.w)} * rd; }
#pragma unroll
            for (int k4 = 0; k4 < 8; ++k4) ss += hv[k4][0] * hv[k4][0] + hv[k4][1] * hv[k4][1] + hv[k4][2] * hv[k4][2] + hv[k4][3] * hv[k4][3];
            ss = grp8_sum(ss);
            const float rinv = __builtin_amdgcn_rsqf(ss * (1.0f / 256.0f) + kf(RMS_EPS));
#pragma unroll
            for (int k16 = 0; k16 < 2; ++k16) { const int v0 = part * 32 + 16 * k16; float og[16]; un16_fp8x16(po[k16], og); u32x4 o;
#pragma unroll
                for (int q = 0; q < 4; ++q) { const f32x4 gq = *(const LAS f32x4*)(mhg + v0 + 4 * q); const f32x4 xq = hv[4 * k16 + q];
                    o[q] = pk4_fp8x16(og[4 * q] * xq[0] * rinv * gq[0], og[4 * q + 1] * xq[1] * rinv * gq[1], og[4 * q + 2] * xq[2] * rinv * gq[2], og[4 * q + 3] * xq[3] * rinv * gq[3]); }
                *(u32x4*)(AB8 + (m0 + tf) * 2048 + 1024 + 256 * h + v0) = o; }
        }
        if (u + C.G < 4096) { MLSTM_FILL(); if (u + 2 * C.G < 4096) MLSTM_PREFETCH(u + 2 * C.G); }
        __syncthreads();
    }
#undef MLSTM_FILL
#undef MLSTM_PREFETCH
}

__device__ __forceinline__ void phase_ln1_router(const Ctx& C0, int l, bool dry = false) {
    CTX_LOCAL(C0);
    PHASE_IDS();
    bf16* X = WSP(bf16, WS_XR); bf16* XO = dry ? WSP(bf16, WS_GBUF) : X; bf16* XB = WSP(bf16, WS_XB); int* TOKE = WSP(int, WS_TOKE); float* TOKW = WSP(float, WS_TOKW); int* HIST = WSP(int, WS_HIST);
    const float* g1 = INP(I_LN1G) + (size_t)l * D; const float* b1 = INP(I_LN1B) + (size_t)l * D; const float* wr = INP(I_WR) + (size_t)l * D * NE; const float* br = INP(I_BR) + (size_t)l * NE;
    LAS float* Xt = (LAS float*)C.lds;
    LAS float* PART = (LAS float*)(C.lds + 16 * 1028 * 4);
    LAS int* hist = (LAS int*)(C.lds + 16 * 1028 * 4 + 8 * 16 * 64 * 4);
    LAS float* gb = (LAS float*)(C.lds + 16 * 1028 * 4 + 8 * 16 * 64 * 4 + 256);
    for (int i = tid; i < 1024; i += 512) { gb[i] = g1[i]; gb[1024 + i] = b1[i]; }
    __syncthreads();
    const float brl = br[lane];
    bf16x8 bh[4][4], bl[4][4];
#pragma unroll
    for (int ks = 0; ks < 4; ++ks)
#pragma unroll
        for (int et = 0; et < 4; ++et) { float f[8];
#pragma unroll
            for (int j = 0; j < 8; ++j) f[j] = wr[(size_t)(128 * w + 32 * ks + 8 * (lane >> 4) + j) * NE + 16 * et + (lane & 15)];
            u32x4 hh, ll;
#pragma unroll
            for (int q = 0; q < 4; ++q) { const unsigned hp = cvt_pk_bf16(f[2 * q], f[2 * q + 1]); hh[q] = hp; ll[q] = cvt_pk_bf16(f[2 * q] - bflo(hp), f[2 * q + 1] - bfhi(hp)); }
            bh[ks][et] = __builtin_bit_cast(bf16x8, hh); bl[ks][et] = __builtin_bit_cast(bf16x8, ll); }
    for (int blk = C.vcu; blk < M / 256; blk += C.G) {
        if (tid < 64) hist[tid] = 0;
        __syncthreads();
        u32x2 pre[2][4];
#pragma unroll
        for (int rr = 0; rr < 2; ++rr)
#pragma unroll
            for (int j = 0; j < 4; ++j) pre[rr][j] = *(const u32x2*)(X + ((size_t)blk * 256 + 2 * w + rr) * D + 256 * j + 4 * lane);
        for (int bt = 0; bt < 16; ++bt) {
            const size_t mb = (size_t)blk * 256 + bt * 16;
#pragma unroll
            for (int rr = 0; rr < 2; ++rr) { const int row = 2 * w + rr; const size_t m = mb + row; f32x4 v[4]; float s = 0.f;
#pragma unroll
                for (int j = 0; j < 4; ++j) { const u32x2 q = pre[rr][j]; v[j] = (f32x4){bflo(q.x), bfhi(q.x), bflo(q.y), bfhi(q.y)}; s += (v[j][0] + v[j][1]) + (v[j][2] + v[j][3]); }
                const float mean = wave_sum(s) * (1.0f / D); float q = 0.f;
#pragma unroll
                for (int j = 0; j < 4; ++j) { v[j] = v[j] - mean; q += (v[j][0] * v[j][0] + v[j][1] * v[j][1]) + (v[j][2] * v[j][2] + v[j][3] * v[j][3]); }
                const float rstd = __builtin_amdgcn_rsqf(wave_sum(q) * (1.0f / D) + kf(LN_EPS));
#pragma unroll
                for (int j = 0; j < 4; ++j) { const f32x4 y = v[j] * rstd * *(const LAS f32x4*)(gb + 256 * j + 4 * lane) + *(const LAS f32x4*)(gb + 1024 + 256 * j + 4 * lane);
                    { u32x2 o; o.x = cvt_pk_bf16(y[0], y[1]); o.y = cvt_pk_bf16(y[2], y[3]); *(u32x2*)(XO + m * D + 256 * j + 4 * lane) = o; } *(LAS f32x4*)(Xt + row * 1028 + 256 * j + 4 * lane) = y;
                    int w8 = __builtin_amdgcn_cvt_pk_fp8_f32(y[0] * 16.f, y[1] * 16.f, 0, false); w8 = __builtin_amdgcn_cvt_pk_fp8_f32(y[2] * 16.f, y[3] * 16.f, w8, true);
                    *(int*)((unsigned char*)XB + m * D + 256 * j + 4 * lane) = w8; } }
            __syncthreads();
            if (bt + 1 < 16) {
#pragma unroll
                for (int rr = 0; rr < 2; ++rr)
#pragma unroll
                    for (int j = 0; j < 4; ++j) pre[rr][j] = *(const u32x2*)(X + (mb + 16 + 2 * w + rr) * D + 256 * j + 4 * lane); }
            {
                f32x4 acc[4] = {(f32x4){0.f, 0.f, 0.f, 0.f}, (f32x4){0.f, 0.f, 0.f, 0.f}, (f32x4){0.f, 0.f, 0.f, 0.f}, (f32x4){0.f, 0.f, 0.f, 0.f}};
                const LAS float* xa = Xt + (lane & 15) * 1028 + 128 * w + 8 * (lane >> 4);
#pragma unroll
                for (int ks = 0; ks < 4; ++ks) { const f32x4 x0 = *(const LAS f32x4*)(xa + 32 * ks), x1 = *(const LAS f32x4*)(xa + 32 * ks + 4);
                    u32x4 hh, ll;
                    hh[0] = cvt_pk_bf16(x0[0], x0[1]); hh[1] = cvt_pk_bf16(x0[2], x0[3]); hh[2] = cvt_pk_bf16(x1[0], x1[1]); hh[3] = cvt_pk_bf16(x1[2], x1[3]);
                    ll[0] = cvt_pk_bf16(x0[0] - bflo(hh[0]), x0[1] - bfhi(hh[0])); ll[1] = cvt_pk_bf16(x0[2] - bflo(hh[1]), x0[3] - bfhi(hh[1]));
                    ll[2] = cvt_pk_bf16(x1[0] - bflo(hh[2]), x1[1] - bfhi(hh[2])); ll[3] = cvt_pk_bf16(x1[2] - bflo(hh[3]), x1[3] - bfhi(hh[3]));
                    const bf16x8 ah = __builtin_bit_cast(bf16x8, hh), al = __builtin_bit_cast(bf16x8, ll);
#pragma unroll
                    for (int et = 0; et < 4; ++et) { acc[et] = MFMA16(ah, bh[ks][et], acc[et]); acc[et] = MFMA16(ah, bl[ks][et], acc[et]); acc[et] = MFMA16(al, bh[ks][et], acc[et]); } }
#pragma unroll
                for (int et = 0; et < 4; ++et)
#pragma unroll
                    for (int r = 0; r < 4; ++r) PART[(w * 16 + 4 * (lane >> 4) + r) * 64 + 16 * et + (lane & 15)] = acc[et][r];
            }
            __syncthreads();
            {
                const float ninf = kf(-INFINITY); const int grp = lane >> 3;
                float score[2], sel[2], gs[2], cur[2], ssum[2]; int rank[2];
#pragma unroll
                for (int rr = 0; rr < 2; ++rr) { const int row = 2 * w + rr; float lg = 0.f;
#pragma unroll
                    for (int p = 0; p < 8; ++p) lg += PART[(p * 16 + row) * 64 + lane];
                    score[rr] = fast_sigmoid(lg); sel[rr] = score[rr] + brl; }
                float m1[2], s2[2];
#pragma unroll
                for (int rr = 0; rr < 2; ++rr) m1[rr] = grp8_max(sel[rr]);
#pragma unroll
                for (int rr = 0; rr < 2; ++rr) { const unsigned long long bm = __ballot(sel[rr] == m1[rr]); const unsigned gb = (unsigned)(bm >> (8 * grp)) & 0xffu; const int first = __builtin_ctz(gb);
                    s2[rr] = ((lane & 7) == first) ? ninf : sel[rr]; }
#pragma unroll
                for (int rr = 0; rr < 2; ++rr) gs[rr] = m1[rr] + grp8_max(s2[rr]);
#pragma unroll
                for (int rr = 0; rr < 2; ++rr) { int gc = 0;
#pragma unroll
                    for (int g2 = 0; g2 < 8; ++g2) { const float o = rdlane(gs[rr], 8 * g2); gc += (o > gs[rr] || (o == gs[rr] && g2 < grp)) ? 1 : 0; }
                    cur[rr] = gc < 4 ? sel[rr] : ninf; rank[rr] = TOPK; }
#pragma unroll
                for (int r = 0; r < TOPK; ++r) { float mx[2];
#pragma unroll
                    for (int rr = 0; rr < 2; ++rr) mx[rr] = wave_max(cur[rr]);
#pragma unroll
                    for (int rr = 0; rr < 2; ++rr) { const int idx = (int)__builtin_ctzll(__ballot(cur[rr] == mx[rr])); const bool hit = lane == idx; rank[rr] = hit ? r : rank[rr]; cur[rr] = hit ? ninf : cur[rr]; } }
#pragma unroll
                for (int rr = 0; rr < 2; ++rr) ssum[rr] = wave_sum(rank[rr] < TOPK ? score[rr] : 0.f);
#pragma unroll
                for (int rr = 0; rr < 2; ++rr) { const size_t m = mb + 2 * w + rr;
                    if (rank[rr] < TOPK) { TOKE[m * 8 + rank[rr]] = lane; TOKW[m * 8 + rank[rr]] = score[rr] * __builtin_amdgcn_rcpf(ssum[rr]) * ROUTE_SCALE; __hip_atomic_fetch_add(&hist[lane], 1, __ATOMIC_RELAXED, __HIP_MEMORY_SCOPE_WORKGROUP); } }
            }
        }
        __syncthreads();
        if (tid < 64) HIST[blk * 64 + tid] = hist[tid];
        __syncthreads();
    }
}

__device__ __forceinline__ void phase_sort(const Ctx& C0) {
    CTX_LOCAL(C0);
    PHASE_IDS();
    const int* HIST = WSP(int, WS_HIST); const int* TOKE = WSP(int, WS_TOKE); const float* TOKW = WSP(float, WS_TOKW);
    int* POS = WSP(int, WS_POS); int* STOK = WSP(int, WS_STOK); float* SW = WSP(float, WS_SW); int* TILEE = WSP(int, WS_TILEE); int* CNT = WSP(int, WS_CNT);
    LAS int* psum = (LAS int*)C.lds;
    LAS int* cntH = psum + 512;
    LAS int* ntile = cntH + 128;
    LAS int* rstart = ntile + 128;
    LAS int* ntl = rstart + 128;
    LAS int* cur = ntl + 16;
    LAS int* wcnt = cur + 64;
    { const int e = tid & 63, part = tid >> 6; int s = 0;
        for (int b2 = 32 * part; b2 < 32 * part + 32; ++b2) s += HIST[b2 * 64 + e];
        psum[part * 64 + e] = s; }
    __syncthreads();
    if (tid < 128) { const int hf = tid >> 6, e = tid & 63; const int cnt = psum[(4 * hf) * 64 + e] + psum[(4 * hf + 1) * 64 + e] + psum[(4 * hf + 2) * 64 + e] + psum[(4 * hf + 3) * 64 + e];
        cntH[tid] = cnt; ntile[tid] = (cnt + 255) >> 8; }
    __syncthreads();
    if (tid < 2) { int rs = 0; for (int e = 0; e < 64; ++e) { rstart[tid * 64 + e] = rs; rs += ntile[tid * 64 + e] * 256; } ntl[tid] = rs >> 8; }
    __syncthreads();
    const int NTL0 = ntl[0], NTL1 = ntl[1];
    if (C.vcu == 0) {
        if (tid == 0) { CNT[0] = NTL0; CNT[1] = NTL1; }
        if (tid < 128) { const int hf = tid >> 6, e = tid & 63; const int t0 = (hf ? NTL0 : 0) + (rstart[tid] >> 8), n = ntile[tid];
            for (int t = 0; t < n; ++t) TILEE[t0 + t] = e;
            const int base = M + (hf ? 256 * NTL0 : 0) + rstart[tid];
            int zi = 0; asm volatile("" : "+v"(zi));
#pragma unroll 1
            for (int r = cntH[tid]; r < n * 256; ++r) { STOK[base + r] = zi; SW[base + r] = __int_as_float(zi); } }
    }
    for (int blk = C.vcu; blk < M / 256; blk += C.G) {
        const int hf = blk >> 7;
        { const int e = tid & 63, part = tid >> 6; int s = 0; const int lo = 128 * hf + 16 * part; int hi = lo + 16; if (hi > blk) hi = blk;
            for (int b2 = lo; b2 < hi; ++b2) s += HIST[b2 * 64 + e];
            psum[part * 64 + e] = s; }
        __syncthreads();
        if (tid < 64) { int s = M + (hf ? 256 * NTL0 : 0) + rstart[hf * 64 + tid];
#pragma unroll
            for (int p = 0; p < 8; ++p) s += psum[p * 64 + tid];
            cur[tid] = s; }
        __syncthreads();
        for (int q = 0; q < 4; ++q) {
            const int pair = tid + 512 * q; const size_t idx = (size_t)blk * 2048 + pair; const int e = TOKE[idx];
            int rnk = 0, mycnt = 0;
            for (int ee = 0; ee < 64; ++ee) { const unsigned long long mk = __ballot(e == ee);
                if (e == ee) rnk = __popcll(mk & ((1ull << lane) - 1ull));
                if (lane == ee) mycnt = __popcll(mk); }
            wcnt[w * 64 + lane] = mycnt;
            __syncthreads();
            int pos = cur[e] + rnk;
            for (int w2 = 0; w2 < w; ++w2) pos += wcnt[w2 * 64 + e];
            STOK[pos] = (int)(idx >> 3); SW[pos] = TOKW[idx]; POS[idx] = pos;
            __syncthreads();
            if (tid < 64) { int a = 0;
#pragma unroll
                for (int w2 = 0; w2 < 8; ++w2) a += wcnt[w2 * 64 + tid];
                cur[tid] += a; }
            __syncthreads();
        }
        if (tid < 256) { const int r = blk * 256 + tid; STOK[r] = r; SW[r] = 1.0f; }
        __syncthreads();
    }
}

__device__ __forceinline__ void load_wif_wide(const Ctx& C0, int l, LAS float* wif) {
    CTX_LOCAL(C0);
    const float* win = INP(I_WIN) + (size_t)l * D * DIN;
    for (int i = fresh_tid(); i < 1024 * 8; i += 512) { const int k = i >> 3, g = i & 7; wif[(((k & 15) * 2 + (g >> 2)) * 64 + (k >> 4)) * 4 + (g & 3)] = win[(size_t)k * DIN + 5120 + g]; }
    __syncthreads();
}
__device__ __forceinline__ void phase_ln2(const Ctx& C0, int l, bool dry = false) {
    CTX_LOCAL(C0);
    PHASE_IDS();
    const int gw = C.vcu * 8 + w, NGW = C.G * 8;
    bf16* X = WSP(bf16, WS_XR); bf16* XO = dry ? WSP(bf16, WS_GBUF) : X; float* OUT = C.out; const int* POS = WSP(int, WS_POS); const unsigned char* OUTS = WSP(unsigned char, WS_OUTS);
    unsigned char* XB = WSP(unsigned char, WS_XB); float* IFp = WSP(float, WS_IF);
    const float* g2 = INP(I_LN2G) + (size_t)l * D; const float* b2 = INP(I_LN2B) + (size_t)l * D;
    const int obase = M;
    LAS float* wif = (LAS float*)C.lds;
    const bool nxt = l + 1 < DEPTH;
    if (nxt) load_wif_wide(C, l + 1, wif);
    const float bifl = (INP(I_BIN) + (size_t)(nxt ? l + 1 : l) * DIN + 5120)[(lane >> 1) & 7];
    f32x4 gv[4], bv[4];
#pragma unroll
    for (int q = 0; q < 4; ++q) { gv[q] = *(const f32x4*)(g2 + 16 * lane + 4 * q); bv[q] = *(const f32x4*)(b2 + 16 * lane + 4 * q); }
    const bool b3 = (lane & 8) != 0, b2_ = (lane & 4) != 0, b1 = (lane & 2) != 0;
    int npos[8]; u32x4 ov[8]; u32x4 xq[2];
    if (gw < M) {
#pragma unroll
        for (int k = 0; k < 8; ++k) npos[k] = POS[(size_t)gw * 8 + k] - obase;
#pragma unroll
        for (int k = 0; k < 8; ++k) ov[k] = __builtin_nontemporal_load((const u32x4*)(OUTS + (size_t)npos[k] * D + 16 * lane));
#pragma unroll
        for (int h2 = 0; h2 < 2; ++h2) xq[h2] = *(const u32x4*)(X + (size_t)gw * D + 16 * lane + 8 * h2);
        { const int mn = (gw + NGW < M) ? gw + NGW : gw;
#pragma unroll
          for (int k = 0; k < 8; ++k) npos[k] = POS[(size_t)mn * 8 + k] - obase; }
    }
    for (int m = gw; m < M; m += NGW) {
        f32x4 v[4]; u32x4 ovn[8]; u32x4 xqn[2];
        const int mnx = (m + NGW < M) ? m + NGW : m;
#pragma unroll
        for (int k = 0; k < 8; ++k) ovn[k] = __builtin_nontemporal_load((const u32x4*)(OUTS + (size_t)npos[k] * D + 16 * lane));
#pragma unroll
        for (int h2 = 0; h2 < 2; ++h2) xqn[h2] = *(const u32x4*)(X + (size_t)mnx * D + 16 * lane + 8 * h2);
        { const int mn2 = (m + 2 * NGW < M) ? m + 2 * NGW : mnx;
#pragma unroll
          for (int k = 0; k < 8; ++k) npos[k] = POS[(size_t)mn2 * 8 + k] - obase; }
#pragma unroll
        for (int h2 = 0; h2 < 2; ++h2) { const u32x4 q = xq[h2]; v[2 * h2] = (f32x4){bflo(q.x), bfhi(q.x), bflo(q.y), bfhi(q.y)}; v[2 * h2 + 1] = (f32x4){bflo(q.z), bfhi(q.z), bflo(q.w), bfhi(q.w)}; }
#pragma unroll
        for (int q = 0; q < 4; ++q) { f32x4 a = (f32x4){0.f, 0.f, 0.f, 0.f};
#pragma unroll
            for (int k = 0; k < 8; ++k) { const int w8 = (int)ov[k][q]; a[0] += __builtin_amdgcn_cvt_f32_fp8(w8, 0); a[1] += __builtin_amdgcn_cvt_f32_fp8(w8, 1); a[2] += __builtin_amdgcn_cvt_f32_fp8(w8, 2); a[3] += __builtin_amdgcn_cvt_f32_fp8(w8, 3); }
            v[q] = v[q] + a * (1.0f / 256.0f); }
        float s = 0.f;
#pragma unroll
        for (int q = 0; q < 4; ++q) s += (v[q][0] + v[q][1]) + (v[q][2] + v[q][3]);
        const float mean = wave_sum(s) * (1.0f / D); float qq = 0.f;
#pragma unroll
        for (int q = 0; q < 4; ++q) { v[q] = v[q] - mean; qq += (v[q][0] * v[q][0] + v[q][1] * v[q][1]) + (v[q][2] * v[q][2] + v[q][3] * v[q][3]); }
        const float rstd = __builtin_amdgcn_rsqf(wave_sum(qq) * (1.0f / D) + kf(LN_EPS));
#pragma unroll
        for (int q = 0; q < 4; ++q) v[q] = v[q] * rstd * gv[q] + bv[q];
        if (nxt) {
#pragma unroll
            for (int h2 = 0; h2 < 2; ++h2) { u32x4 o; o.x = cvt_pk_bf16(v[2 * h2][0], v[2 * h2][1]); o.y = cvt_pk_bf16(v[2 * h2][2], v[2 * h2][3]); o.z = cvt_pk_bf16(v[2 * h2 + 1][0], v[2 * h2 + 1][1]); o.w = cvt_pk_bf16(v[2 * h2 + 1][2], v[2 * h2 + 1][3]);
                *(u32x4*)(XO + (size_t)m * D + 16 * lane + 8 * h2) = o; }
            { u32x4 o;
#pragma unroll
              for (int q = 0; q < 4; ++q) { int w8 = __builtin_amdgcn_cvt_pk_fp8_f32(v[q][0] * 16.f, v[q][1] * 16.f, 0, false); w8 = __builtin_amdgcn_cvt_pk_fp8_f32(v[q][2] * 16.f, v[q][3] * 16.f, w8, true); o[q] = (unsigned)w8; }
              *(u32x4*)(XB + (size_t)m * D + 16 * lane) = o; }
            float g[8];
#pragma unroll
            for (int i = 0; i < 8; ++i) g[i] = 0.f;
#pragma unroll
            for (int q = 0; q < 4; ++q)
#pragma unroll
                for (int e = 0; e < 4; ++e) { const int kk = 4 * q + e; const f32x4 w0 = *(const LAS f32x4*)(wif + ((kk * 2) * 64 + lane) * 4), w1 = *(const LAS f32x4*)(wif + ((kk * 2 + 1) * 64 + lane) * 4); const float x = v[q][e];
                    g[0] += x * w0[0]; g[1] += x * w0[1]; g[2] += x * w0[2]; g[3] += x * w0[3]; g[4] += x * w1[0]; g[5] += x * w1[1]; g[6] += x * w1[2]; g[7] += x * w1[3]; }
            float h4[4], p2[2], r;
#pragma unroll
            for (int i = 0; i < 4; ++i) h4[i] = (b3 ? g[i + 4] : g[i]) + dppf<0x140>(b3 ? g[i] : g[i + 4]);
#pragma unroll
            for (int i = 0; i < 2; ++i) p2[i] = (b2_ ? h4[i + 2] : h4[i]) + dppf<0x141>(b2_ ? h4[i] : h4[i + 2]);
            r = (b1 ? p2[1] : p2[0]) + dppf<0x4E>(b1 ? p2[0] : p2[1]);
            r += dppf<0xB1>(r);
            { const auto t = __builtin_amdgcn_permlane32_swap(__float_as_uint(r), __float_as_uint(r), false, false); r = __uint_as_float(t[0]) + __uint_as_float(t[1]); }
            { const auto t = __builtin_amdgcn_permlane16_swap(__float_as_uint(r), __float_as_uint(r), false, false); r = __uint_as_float(t[0]) + __uint_as_float(t[1]); }
            if (lane < 16 && (lane & 1) == 0) IFp[(size_t)m * 8 + (lane >> 1)] = r + bifl;
        } else {
#pragma unroll
            for (int q = 0; q < 4; ++q) *(f32x4*)(OUT + (size_t)m * D + 16 * lane + 4 * q) = v[q];
        }
#pragma unroll
        for (int k = 0; k < 8; ++k) ov[k] = ovn[k];
#pragma unroll
        for (int h2 = 0; h2 < 2; ++h2) xq[h2] = xqn[h2];
    }
}

__device__ __forceinline__ void load_tile_table(const Ctx& C0, int n) {
    CTX_LOCAL(C0);
    const int* TILEE = WSP(int, WS_TILEE); LAS int* t = (LAS int*)(C.lds + LDS_TILE);
    for (int i = fresh_tid(); i < n; i += 512) t[i] = TILEE[i];
    __syncthreads();
}

__global__ void __launch_bounds__(512, 2) mk_fwd(KArgs args) {
    Ctx CK; CK.lds = (LAS unsigned char*)lds_raw;
    if ((threadIdx.x & 63) == 0) *(volatile LAS int*)(CK.lds + LDS_WTAB + 4 * hw_wave_key()) = (int)(threadIdx.x >> 6);
    CK.G = gridDim.x; { const int bx = blockIdx.x; CK.vcu = (CK.G % 8 == 0) ? (bx % 8) * (CK.G / 8) + bx / 8 : bx; }
    CK.out = args.out; CK.ws = args.ws;
    volatile LAS unsigned* MISC = (volatile LAS unsigned*)(CK.lds + LDS_MISC);
    if (threadIdx.x < 64) MISC[threadIdx.x] = 0u;
    if (threadIdx.x == 0) {
#pragma unroll
        for (int k = 0; k < 27; ++k) *(LAS unsigned long long*)(CK.lds + LDS_PTRS + 8 * k) = (unsigned long long)args.in[k];
    }
    __syncthreads();
    const bool use_bar = (args.ph_hi - args.ph_lo) > 1;
    if (use_bar && threadIdx.x == 0) (void)xb_add((unsigned*)(args.ws + WS_CTL) + CW_BAR + XB_XCNT(xb_xcc_id()), 1u);
    const int lo = args.ph_lo, hi = args.ph_hi;

    for (int l = 0; l < DEPTH; ++l) {
        const int p0 = l * NPH;
        if (p0 + NPH <= lo || p0 >= hi) continue;
#define IN(k) (((PH_MASK >> (k)) & 1u) && opq_int(lo) <= p0 + (k) && p0 + (k) < hi)
#define REP(k) (((TREP >> (k)) & 1u) != 0u)
#define SEAM(k) do { if (IN(k) && (p0 + (k) + 1 < hi)) { XcdBarrier bar_; unsigned zo_ = 0u; asm volatile("" : "+v"(zo_)); bar_.bar = (unsigned*)(opq_ptr(CK.ws) + WS_CTL + zo_) + CW_BAR;     bar_.x = (unsigned)__builtin_amdgcn_readfirstlane((int)xb_xcc_id()); \
        bar_.st = (volatile LAS unsigned*)(CK.lds + LDS_MISC) + 8; xcd_barrier(bar_); } } while (0)
        if (l == 0) { if (IN(0)) { if (REP(0)) { phase_convert(CK, 0, true); __syncthreads(); } phase_convert(CK, 0, true); } SEAM(0); }
        if (IN(1)) {
            CTX_LOCAL(CK); bf16* Z = WSP(bf16, WS_Z); bf16* XB = WSP(bf16, WS_XB); const int bx = opq_int((int)blockIdx.x);
            phase_gates(CK);
            if (REP(1)) {
                g8::SchedDenseT<M / 256, ZW / 256> S; S.init(M, ZW, C.G, bx, XB, D / 2, WSP(bf16, WS_WIN), D / 2);
                g8::EpiZ E{WSP(unsigned char, WS_Z), WSP(bf16, WS_ZG), WSP(float, WS_BIAS1), WSP(float, WS_VPART), REP(22)};
                g8::gemm_phase<g8::EpiZ, g8::SchedDenseT<M / 256, ZW / 256>, false, g8::MidNone, G8_SP2, true>(C.lds, D / 2, D / 2, D / 2, S, E, nullptr);
                __syncthreads();
            }
            g8::SchedDenseT<M / 256, ZW / 256> S; S.init(M, ZW, C.G, bx, XB, D / 2, WSP(bf16, WS_WIN), D / 2);
            g8::EpiZ E{WSP(unsigned char, WS_Z), WSP(bf16, WS_ZG), WSP(float, WS_BIAS1), WSP(float, WS_VPART), false};
            g8::gemm_phase<g8::EpiZ, g8::SchedDenseT<M / 256, ZW / 256>, false, g8::MidNone, G8_SP2, true>(C.lds, D / 2, D / 2, D / 2, S, E, nullptr);
        } SEAM(1);
        if (IN(2)) {
            if (REP(16)) phase_sgu(CK, l);
            phase_sgu(CK, l);
            if (REP(17)) phase_kvchain(CK);
            phase_kvchain(CK);
        } SEAM(2);
        if (IN(4)) { if (REP(4)) phase_mlstm(CK, l); phase_mlstm(CK, l); } SEAM(4);
        if (IN(5)) {
            CTX_LOCAL(CK); bf16* Z = WSP(bf16, WS_Z); const int bx = opq_int((int)blockIdx.x);
            if (REP(5)) {
                g8::SchedDenseT<M / 256, D / 256> S; S.init(M, D, C.G, bx, C.out, 1024, WSP(bf16, WS_W4), 1024);
                g8::EpiGate E{WSP(bf16, WS_ZG), ZGP, 1024, nullptr, 0, 0, (bf16*)WSP(unsigned char, WS_Z), Z8W / 2, ZY / 2, true};
                g8::MidMulP Md{WSP(bf16, WS_ZG), ZGP, 0};
                g8::gemm_phase<g8::EpiGate, g8::SchedDenseT<M / 256, D / 256>, false, g8::MidMulP, G8_SP2, true>(C.lds, 1024, 1024, 1024, S, E, nullptr, Md);
                __syncthreads();
            }
            g8::SchedDenseT<M / 256, D / 256> S; S.init(M, D, C.G, bx, C.out, 1024, WSP(bf16, WS_W4), 1024);
            g8::EpiGate E{WSP(bf16, WS_ZG), ZGP, 1024, nullptr, 0, 0, (bf16*)WSP(unsigned char, WS_Z), Z8W / 2, ZY / 2, true};
            g8::MidMulP Md{WSP(bf16, WS_ZG), ZGP, 0};
            g8::gemm_phase<g8::EpiGate, g8::SchedDenseT<M / 256, D / 256>, false, g8::MidMulP, G8_SP2, true>(C.lds, 1024, 1024, 1024, S, E, nullptr, Md);
        } SEAM(5);
        if (IN(6)) {
            CTX_LOCAL(CK); bf16* Z = WSP(bf16, WS_Z); const int bx = opq_int((int)blockIdx.x);
            g8::SchedDenseT<M / 256, D / 256> S; S.init(M, D, C.G, bx, WSP(unsigned char, WS_Z) + ZY, Z8W / 2, WSP(bf16, WS_W4) + (size_t)2 * D * D, D / 2);
            g8::EpiResid E{l == 0 ? INP(I_X) : (const float*)nullptr, WSP(bf16, WS_XR)};
            g8::gemm_phase<g8::EpiResid, g8::SchedDenseT<M / 256, D / 256>, false, g8::MidNone, G8_SP2, true>(C.lds, Z8W / 2, D / 2, D / 2, S, E, nullptr);
        } SEAM(6);
        if (IN(7)) { if (REP(7)) phase_ln1_router(CK, l, true); phase_ln1_router(CK, l); } SEAM(7);
        if (IN(8)) { if (REP(8)) { phase_sort(CK); convert_pb(CK, l); __syncthreads(); } phase_sort(CK); convert_pb(CK, l); } SEAM(8);
        if (IN(9)) {
            CTX_LOCAL(CK); bf16* XB = WSP(bf16, WS_XB); const int bx = opq_int((int)blockIdx.x);
            const int* CNT = WSP(int, WS_CNT); const int nexp = CNT[0] + CNT[1];
            if (REP(9)) {
                load_tile_table(C, nexp);
                g8::SchedUp S{(const LAS int*)(C.lds + LDS_TILE), NSH_TILES + nexp, C.G, C.vcu, (const char*)XB, (const char*)WSP(bf16, WS_UPT)};
                g8::EpiMoeUp E{WSP(bf16, WS_HID), WSP(float, WS_SW), WSP(bf16, WS_PBH)};
                g8::gemm_phase<g8::EpiMoeUp, g8::SchedUp, true, g8::MidNone, G8_SP2, true>(C.lds, D / 2, D / 2, D / 2, S, E, WSP(int, WS_STOK));
                g8::SchedDenseT<M / 256, D / 256> S2; S2.init(M, D, C.G, bx, XB, D / 2, WSP(bf16, WS_W4) + (size_t)3 * D * D, D / 2);
                g8::EpiBiasAct E2{WSP(bf16, WS_GBUF), D, INP(I_BPG) + (size_t)l * D, 0xAAull, nullptr};
                g8::gemm_phase<g8::EpiBiasAct, g8::SchedDenseT<M / 256, D / 256>, false, g8::MidNone, G8_SP2, true>(C.lds, D / 2, D / 2, D / 2, S2, E2, nullptr);
                __syncthreads();
            }
            load_tile_table(C, nexp);
            g8::SchedUp S{(const LAS int*)(C.lds + LDS_TILE), NSH_TILES + nexp, C.G, C.vcu, (const char*)XB, (const char*)WSP(bf16, WS_UPT)};
            g8::EpiMoeUp E{WSP(bf16, WS_HID), WSP(float, WS_SW), WSP(bf16, WS_PBH)};
            g8::gemm_phase<g8::EpiMoeUp, g8::SchedUp, true, g8::MidNone, G8_SP2, true>(C.lds, D / 2, D / 2, D / 2, S, E, WSP(int, WS_STOK));
            g8::SchedDenseT<M / 256, D / 256> S2; S2.init(M, D, C.G, bx, XB, D / 2, WSP(bf16, WS_W4) + (size_t)3 * D * D, D / 2);
            g8::EpiBiasAct E2{WSP(bf16, WS_GBUF), D, INP(I_BPG) + (size_t)l * D, 0xAAull, nullptr};
            g8::gemm_phase<g8::EpiBiasAct, g8::SchedDenseT<M / 256, D / 256>, false, g8::MidNone, G8_SP2, true>(C.lds, D / 2, D / 2, D / 2, S2, E2, nullptr);
        } SEAM(9);
        if (IN(10)) {
            CTX_LOCAL(CK); const int bx = opq_int((int)blockIdx.x);
            {
                g8::SchedDenseT<M / 256, D / 256> S; S.init(M, D, C.G, bx, WSP(bf16, WS_PBH), 256, WSP(bf16, WS_WPT), 256);
                g8::EpiResid E{(const float*)nullptr, WSP(bf16, WS_XR)};
                g8::MidMulP Md{WSP(bf16, WS_GBUF), D, 0};
                g8::gemm_phase<g8::EpiResid, g8::SchedDenseT<M / 256, D / 256>, false, g8::MidMulP, G8_SP2, true>(C.lds, 256, 256, 256, S, E, nullptr, Md);
            }
            const int* CNT = WSP(int, WS_CNT); const int n0 = CNT[0], n1 = CNT[1];
            if (REP(12)) {
                load_tile_table(C, n0 + n1);
                g8::SchedDown S{(const LAS int*)(C.lds + LDS_TILE), n0 + n1, 0, C.G, C.vcu, (const char*)WSP(bf16, WS_HID), (const char*)WSP(bf16, WS_DNT)};
                g8::EpiOut8 E{WSP(unsigned char, WS_OUTS), D};
                g8::gemm_phase<g8::EpiOut8, g8::SchedDown, false, g8::MidNone, G8_SP2, true>(C.lds, DEXP / 2, DEXP / 2, DEXP / 2, S, E, nullptr);
                __syncthreads();
            }
            load_tile_table(C, n0 + n1);
            g8::SchedDown S{(const LAS int*)(C.lds + LDS_TILE), n0 + n1, 0, C.G, C.vcu, (const char*)WSP(bf16, WS_HID), (const char*)WSP(bf16, WS_DNT)};
            g8::EpiOut8 E{WSP(unsigned char, WS_OUTS), D};
            g8::gemm_phase<g8::EpiOut8, g8::SchedDown, false, g8::MidNone, G8_SP2, true>(C.lds, DEXP / 2, DEXP / 2, DEXP / 2, S, E, nullptr);
        } SEAM(10);
        if (IN(11)) { if (REP(11)) { phase_ln2(CK, l, true); __syncthreads(); } phase_ln2(CK, l); if (l + 1 < DEPTH) { __syncthreads(); phase_convert(CK, l + 1, false); if (REP(20)) { __syncthreads(); phase_convert(CK, l + 1, false); } } } SEAM(11);
#undef IN
#undef SEAM
    }
}

__global__ void k_fill(float* out, int n, float v) { for (int i = blockIdx.x * blockDim.x + threadIdx.x; i < n; i += gridDim.x * blockDim.x) out[i] = v; }

#if MK_DEBUG
__global__ void k_hash(const unsigned* p, size_t nwords, unsigned long long* out, unsigned poison) {
    unsigned long long s = 0;
    for (size_t i = (size_t)blockIdx.x * blockDim.x + threadIdx.x; i < nwords; i += (size_t)gridDim.x * blockDim.x) { const unsigned w = p[i]; if (w != poison) s += (unsigned long long)w * (2ull * i + 1ull); }
    for (int o = 32; o >= 1; o >>= 1) s += __shfl_xor(s, o);
    if ((threadIdx.x & 63) == 0) atomicAdd(out, s);
}
__global__ void k_dbg_final(const unsigned long long* ha, const unsigned long long* hb, int nph, float* code) {
    if (threadIdx.x == 0 && blockIdx.x == 0) { int first = -1, cnt = 0;
        for (int i = 0; i < nph; ++i) if (ha[i] != hb[i]) { if (first < 0) first = i; ++cnt; }
        float v;
        if (first < 0) v = 5000.f;
        else { v = (float)(10 + first % 90); if (first >= 90) v *= 100.f; if (cnt > 1) v *= 1.0f; }
        code[0] = sqrtf(v - 1.0f); }
}
__global__ void k_fill_from(float* out, int n, const float* v) { const float x = v[0]; for (int i = blockIdx.x * blockDim.x + threadIdx.x; i < n; i += gridDim.x * blockDim.x) out[i] = x; }
static void dbg_run(KArgs a, int grid, hipStream_t stream) {
    const int NPHASES = DEPTH * NPH;
    unsigned long long* H = (unsigned long long*)(a.ws + WS_CTL) + CW_DBG / 2;
    float* code = (float*)(a.ws + WS_CTL) + CW_DBG + 1024;
    for (int run = 0; run < 2; ++run) {
        const int pb = run ? 0x55 : 0xAA; const unsigned pw = run ? 0x55555555u : 0xAAAAAAAAu;
        (void)hipMemsetAsync((char*)a.ws + CTL_ZERO_BYTES, pb, WS_END - CTL_ZERO_BYTES, stream);
        (void)hipMemsetAsync((char*)a.out, pb, (size_t)M * D * 4, stream);
        for (int ph = 0; ph < NPHASES; ++ph) {
            const int nsub = (ph % NPH == 3) ? 2 : 1;
            for (int sub = 0; sub < nsub; ++sub) {
                a.ph_lo = ph; a.ph_hi = ph + 1; a.dbg = nsub == 2 ? sub + 1 : 0; mk_fwd<<<grid, 512, LDS_BYTES, stream>>>(a);
                unsigned long long* h = H + run * 160 + 2 * ph + sub;
                k_hash<<<2048, 256, 0, stream>>>((const unsigned*)(a.ws + CTL_ZERO_BYTES), (WS_END - CTL_ZERO_BYTES) / 4, h, pw);
                k_hash<<<2048, 256, 0, stream>>>((const unsigned*)a.out, (size_t)M * D, h, pw);
            }
        }
    }
    k_dbg_final<<<1, 64, 0, stream>>>(H, H + 160, 160, code);
    k_fill_from<<<1024, 256, 0, stream>>>(a.out, M * D, code);
}
#endif

extern "C" void kernel_launch(void* const* d_in, const int* in_sizes, int n_in, void* d_out, int out_size, void* d_ws, size_t ws_size, hipStream_t stream) {
    static int grid = 0;
    if (grid == 0) {
        if (n_in != 27 || out_size != M * D || ws_size < WS_END) {
            fprintf(stderr, "kernel_launch: unexpected shapes / workspace (n_in %d, out %d, ws %zu < %zu)\n", n_in, out_size, ws_size, (size_t)WS_END);
            grid = -1;
        } else {
            int dev = 0, cus = 0, per_cu = 0;
            hipGetDevice(&dev); hipDeviceGetAttribute(&cus, hipDeviceAttributeMultiprocessorCount, dev);
            hipFuncSetAttribute((const void*)mk_fwd, hipFuncAttributeMaxDynamicSharedMemorySize, LDS_BYTES);
            hipOccupancyMaxActiveBlocksPerMultiprocessor(&per_cu, (const void*)mk_fwd, 512, LDS_BYTES);
            (void)hipGetLastError();
            grid = cus;
        }
    }
    if (grid < 0) { k_fill<<<1024, 256, 0, stream>>>((float*)d_out, out_size, ws_size < WS_END ? 3.0e8f : 2.0e8f); return; }
    hipMemsetAsync((char*)d_ws + WS_CTL, 0, CTL_ZERO_BYTES, stream);
    KArgs a{};
    for (int i = 0; i < 27; ++i) a.in[i] = (const float*)d_in[i];
    a.out = (float*)d_out; a.ws = (unsigned char*)d_ws; a.dbg = 0; a.pad = 0;
    const int NPHASES = DEPTH * NPH;
#if MK_DEBUG
    dbg_run(a, grid, stream);
#elif MK_LAUNCH_PER_PHASE
    for (int ph = 0; ph < NPHASES; ++ph) { a.ph_lo = ph; a.ph_hi = ph + 1; mk_fwd<<<grid, 512, LDS_BYTES, stream>>>(a); }
#else
    a.ph_lo = 0; a.ph_hi = NPHASES;
    mk_fwd<<<grid, 512, LDS_BYTES, stream>>>(a);
#endif
}
```

```cpp
#include <hip/hip_runtime.h>
#include <cstdio>
#include <cstdint>

#ifndef MK_LAUNCH_PER_PHASE
#define MK_LAUNCH_PER_PHASE 0
#endif
#ifndef SIM_FP8
#define SIM_FP8 0
#endif
#ifndef TREP
#define TREP 0u
#endif
#ifndef PH_MASK
#define PH_MASK 0xFFFFFFFFu
#endif
#ifndef MK_DEBUG
#define MK_DEBUG 0
#endif

#define GAS __attribute__((address_space(1)))
#define LAS __attribute__((address_space(3)))
typedef unsigned short bf16;
typedef short bf16x8 __attribute__((ext_vector_type(8)));
typedef short s16x4 __attribute__((ext_vector_type(4)));
typedef float f32x4 __attribute__((ext_vector_type(4)));
typedef float f32x2 __attribute__((ext_vector_type(2)));
typedef unsigned u32x4 __attribute__((ext_vector_type(4)));
typedef unsigned u32x2 __attribute__((ext_vector_type(2)));
typedef short v4i16_t __attribute__((ext_vector_type(4)));

constexpr int D = 1024, NB = 8, SEQ = 8192, M = NB * SEQ, DEPTH = 4;
constexpr int DIN = 7176, ZW = 7168;
constexpr int Z8W = 5376;
constexpr int ZU = 0, ZVM = 1024, ZV = 2048, ZQ = 3072, ZK = 3584, ZO = 4096, ZGA = 5120, ZGB = 6144;
constexpr int ZT1 = ZQ;
constexpr int ZY = ZV;
constexpr int NH = 4, DQK = 128, DV = 256, LCH = 64, NCH = SEQ / LCH;
constexpr int NE = 64, TOPK = 8, DEXP = 256, PD = 256;
constexpr float ALPHA = 1.681792830507429f;
constexpr float LN_EPS = 1e-5f, RMS_EPS = 1e-6f, ROUTE_SCALE = 2.5f;
constexpr float QSCALE = 0.08838834764831845f;
constexpr int HALF_TOK = M / 2;
constexpr int MAXT_HALF = 1088;
constexpr int NSH_TILES = M / 256;

constexpr size_t MiB = 1u << 20;
constexpr size_t WS_CTL = 0, CTL_ZERO_BYTES = 1 * MiB;
constexpr size_t WS_BIAS1 = 1 * MiB;
constexpr size_t WS_WSB = 1 * MiB + 65536;
constexpr size_t WS_VPART = 1457 * MiB;
constexpr size_t WS_IF = 3 * MiB;
constexpr size_t WS_BC = 5 * MiB;
constexpr size_t WS_BL = 6 * MiB, WS_GM = 6 * MiB + 16384, WS_MS = 6 * MiB + 32768;
constexpr size_t WS_NK = 7 * MiB;
constexpr size_t WS_TOKE = 9 * MiB, WS_TOKW = 11 * MiB, WS_POS = 13 * MiB;
constexpr size_t WS_HIST = 15 * MiB, WS_TILEE = 15 * MiB + 65536, WS_CNT = 15 * MiB + 131072;
constexpr size_t WS_STOK = 16 * MiB, WS_SW = 19 * MiB;
constexpr size_t WS_DBG = 22 * MiB;
constexpr size_t WS_WIN = 24 * MiB;
constexpr size_t WS_W4 = 38 * MiB;
constexpr size_t WS_UPT = 46 * MiB;
constexpr size_t WS_DNT = 145 * MiB;
constexpr size_t WS_WPT = 144 * MiB;
constexpr size_t WS_PBH = 1282 * MiB;
constexpr size_t WS_XB = 79 * MiB;
constexpr size_t WS_XR = 177 * MiB;
constexpr size_t WS_Z = 305 * MiB;
constexpr int ZGP = 2176;
constexpr size_t WS_ZG = 645 * MiB;
constexpr size_t WS_STATE = 1201 * MiB;
constexpr size_t WS_HID = 305 * MiB;
constexpr size_t WS_GBUF = 610 * MiB;
constexpr size_t WS_OUTS = 738 * MiB;
constexpr size_t WS_END = 1465 * MiB;
static_assert(WS_HID + (size_t)(M + 2 * MAXT_HALF * 256) * 512 <= WS_GBUF && WS_OUTS + (size_t)2 * MAXT_HALF * 256 * 1024 <= WS_PBH && WS_PBH + (size_t)M * 1024 <= WS_STATE + 256 * MiB && WS_STATE + 256 * MiB <= WS_VPART, "ws map");

constexpr int CW_BAR = 4096;
constexpr int CW_DBG = 16384;

constexpr int LDS_BYTES = 163840;
constexpr int LDS_GIDX = 131072;
constexpr int LDS_TILE = 133120;
constexpr int LDS_MISC = LDS_BYTES - 256;
constexpr int LDS_PTRS = LDS_BYTES - 512;

#define LDS_WAIT() asm volatile("s_waitcnt lgkmcnt(0)" ::: "memory")
#define VM_WAIT() asm volatile("s_waitcnt vmcnt(0)" ::: "memory")
typedef __bf16 bf16x2_t __attribute__((ext_vector_type(2)));
__device__ __forceinline__ unsigned cvt_pk_bf16(float lo, float hi) { const f32x2 v = {lo, hi}; const bf16x2_t b = __builtin_convertvector(v, bf16x2_t); return __builtin_bit_cast(unsigned, b); }
__device__ __forceinline__ float bf2f(unsigned b) { return __uint_as_float(b << 16); }
__device__ __forceinline__ float bflo(unsigned w) { return __uint_as_float(w << 16); }
__device__ __forceinline__ float bfhi(unsigned w) { return __uint_as_float(w & 0xffff0000u); }
__device__ __forceinline__ bf16 f2bf(float f) { return (bf16)(cvt_pk_bf16(f, f) & 0xffffu); }
__device__ __forceinline__ float q8(float x, float s, float inv_s) { const int v = __builtin_amdgcn_cvt_pk_fp8_f32(x * s, 0.f, 0, false); return __builtin_amdgcn_cvt_f32_fp8(v, 0) * inv_s; }
__device__ __forceinline__ unsigned pk4_fp8x16(float a, float b, float c, float d) {
    float k = 448.f; asm volatile("" : "+s"(k));
    a = __builtin_amdgcn_fmed3f(a * 16.f, -k, k); b = __builtin_amdgcn_fmed3f(b * 16.f, -k, k); c = __builtin_amdgcn_fmed3f(c * 16.f, -k, k); d = __builtin_amdgcn_fmed3f(d * 16.f, -k, k);
    int w = __builtin_amdgcn_cvt_pk_fp8_f32(a, b, 0, false); w = __builtin_amdgcn_cvt_pk_fp8_f32(c, d, w, true); return (unsigned)w; }
__device__ __forceinline__ unsigned pk4_fp8x4(float a, float b, float c, float d) {
    float k = 448.f; asm volatile("" : "+s"(k));
    a = __builtin_amdgcn_fmed3f(a * 4.f, -k, k); b = __builtin_amdgcn_fmed3f(b * 4.f, -k, k); c = __builtin_amdgcn_fmed3f(c * 4.f, -k, k); d = __builtin_amdgcn_fmed3f(d * 4.f, -k, k);
    int w = __builtin_amdgcn_cvt_pk_fp8_f32(a, b, 0, false); w = __builtin_amdgcn_cvt_pk_fp8_f32(c, d, w, true); return (unsigned)w; }
__device__ __forceinline__ f32x4 un4_fp8x4(unsigned w) { const f32x2 lo = __builtin_amdgcn_cvt_pk_f32_fp8((int)w, false), hi = __builtin_amdgcn_cvt_pk_f32_fp8((int)w, true); return (f32x4){lo[0] * 0.25f, lo[1] * 0.25f, hi[0] * 0.25f, hi[1] * 0.25f}; }
__device__ __forceinline__ void un16_fp8x16(const u32x4 e, float (&f)[16]) {
#pragma unroll
    for (int q = 0; q < 4; ++q) { const f32x2 lo = __builtin_amdgcn_cvt_pk_f32_fp8((int)e[q], false), hi = __builtin_amdgcn_cvt_pk_f32_fp8((int)e[q], true);
        f[4 * q] = lo[0] * 0.0625f; f[4 * q + 1] = lo[1] * 0.0625f; f[4 * q + 2] = hi[0] * 0.0625f; f[4 * q + 3] = hi[1] * 0.0625f; }
}
__device__ __forceinline__ void un16_fp8raw(const u32x4 e, float (&f)[16]) {
#pragma unroll
    for (int q = 0; q < 4; ++q) { const f32x2 lo = __builtin_amdgcn_cvt_pk_f32_fp8((int)e[q], false), hi = __builtin_amdgcn_cvt_pk_f32_fp8((int)e[q], true);
        f[4 * q] = lo[0]; f[4 * q + 1] = lo[1]; f[4 * q + 2] = hi[0]; f[4 * q + 3] = hi[1]; }
}
__device__ __forceinline__ void bf16x16_to_lds(LAS unsigned char* p, const float (&f)[16]) {
    u32x4 a, b; a.x = cvt_pk_bf16(f[0], f[1]); a.y = cvt_pk_bf16(f[2], f[3]); a.z = cvt_pk_bf16(f[4], f[5]); a.w = cvt_pk_bf16(f[6], f[7]);
    b.x = cvt_pk_bf16(f[8], f[9]); b.y = cvt_pk_bf16(f[10], f[11]); b.z = cvt_pk_bf16(f[12], f[13]); b.w = cvt_pk_bf16(f[14], f[15]);
    *(LAS u32x4*)p = a; *(LAS u32x4*)(p + 16) = b;
}
template <int CTRL> __device__ __forceinline__ float dppf(float v) { return __builtin_bit_cast(float, __builtin_amdgcn_update_dpp(0, __builtin_bit_cast(int, v), CTRL, 0xF, 0xF, true)); }
__device__ __forceinline__ float shfl_idx(float v, int src) { return __builtin_bit_cast(float, __builtin_amdgcn_ds_bpermute(src << 2, __builtin_bit_cast(int, v))); }
__device__ __forceinline__ float rdlane(float v, int l) { return __builtin_bit_cast(float, __builtin_amdgcn_readlane(__builtin_bit_cast(int, v), l)); }
__device__ __forceinline__ float grp8_sum(float v) { v += dppf<0xB1>(v); v += dppf<0x4E>(v); v += dppf<0x141>(v); return v; }
__device__ __forceinline__ float grp8_max(float v) { v = fmaxf(v, dppf<0xB1>(v)); v = fmaxf(v, dppf<0x4E>(v)); v = fmaxf(v, dppf<0x141>(v)); return v; }
__device__ __forceinline__ float wave_sum(float v) { v = grp8_sum(v); v += dppf<0x140>(v); return (rdlane(v, 0) + rdlane(v, 16)) + (rdlane(v, 32) + rdlane(v, 48)); }
__device__ __forceinline__ float wave_max(float v) { v = grp8_max(v); v = fmaxf(v, dppf<0x140>(v)); return fmaxf(fmaxf(rdlane(v, 0), rdlane(v, 16)), fmaxf(rdlane(v, 32), rdlane(v, 48))); }
__device__ __forceinline__ float kf(float x) { asm volatile("" : "+s"(x)); return x; }
__device__ __forceinline__ float fast_exp(float x) { return __builtin_amdgcn_exp2f(x * kf(1.4426950408889634f)); }
__device__ __forceinline__ float fast_sigmoid(float x) { return __builtin_amdgcn_rcpf(1.0f + __builtin_amdgcn_exp2f(-1.4426950408889634f * x)); }
__device__ __forceinline__ f32x2 gelu_pk(f32x2 v) {
    const f32x2 av = __builtin_elementwise_abs(v), d = av * 0.2316418882f + 1.0f;
    f32x2 t; t.x = __builtin_amdgcn_rcpf(d.x); t.y = __builtin_amdgcn_rcpf(d.y);
    f32x2 q = t * 0.5307027145f + (-0.7265760135f); q = q * t + 0.7107068705f; q = q * t + (-0.142248368f); q = q * t + 0.127414796f; q = q * t;
    const f32x2 s = (v * v) * (-0.72134752044f);
    f32x2 e; e.x = __builtin_amdgcn_exp2f(s.x); e.y = __builtin_amdgcn_exp2f(s.y);
    const f32x2 m = v * (q * e), r = v - m;
    f32x2 o; o.x = v.x < 0.f ? m.x : r.x; o.y = v.y < 0.f ? m.y : r.y; return o;
}
typedef float f32x8 __attribute__((ext_vector_type(8)));
__device__ __forceinline__ f32x8 gelu8(f32x8 v) {
    const f32x8 av = __builtin_elementwise_abs(v), d = av * 0.2316418882f + 1.0f;
    f32x8 t, e;
#pragma unroll
    for (int i = 0; i < 8; ++i) t[i] = __builtin_amdgcn_rcpf(d[i]);
    f32x8 q = t * 0.5307027145f + (-0.7265760135f); q = q * t + 0.7107068705f; q = q * t + (-0.142248368f); q = q * t + 0.127414796f; q = q * t;
    const f32x8 s = (v * v) * (-0.72134752044f);
#pragma unroll
    for (int i = 0; i < 8; ++i) e[i] = __builtin_amdgcn_exp2f(s[i]);
    const f32x8 m = v * (q * e), r = v - m;
    f32x8 o;
#pragma unroll
    for (int i = 0; i < 8; ++i) o[i] = v[i] < 0.f ? m[i] : r[i];
    return o;
}
__device__ __forceinline__ bf16x8 frag_row(const LAS unsigned char* t, int pitch, int r0, int k0, int lane) {
    return *(const LAS bf16x8*)(t + (r0 + (lane & 15)) * pitch + (k0 + 8 * (lane >> 4)) * 2);
}
__device__ __forceinline__ bf16x8 frag_tr(const LAS unsigned char* t, int pitch, int k0, int n0, int lane) {
    const int i = lane & 15, g = lane >> 4, q = i >> 2, p = i & 3;
    const LAS unsigned char* a = t + (k0 + 8 * g + q) * pitch + (n0 + 4 * p) * 2;
    const s16x4 lo = __builtin_bit_cast(s16x4, __builtin_amdgcn_ds_read_tr16_b64_v4i16((LAS v4i16_t*)a));
    const s16x4 hi = __builtin_bit_cast(s16x4, __builtin_amdgcn_ds_read_tr16_b64_v4i16((LAS v4i16_t*)(a + 4 * pitch)));
    return (bf16x8){lo[0], lo[1], lo[2], lo[3], hi[0], hi[1], hi[2], hi[3]};
}
#define MFMA16(a, b, c) __builtin_amdgcn_mfma_f32_16x16x32_bf16((a), (b), (c), 0, 0, 0)
__device__ __forceinline__ long frag8(const LAS unsigned char* t, int pitch, int r0, int k0, int lane) { return *(const LAS long*)(t + (r0 + (lane & 15)) * pitch + k0 + 8 * (lane >> 4)); }
#define MFMA8(a, b, c) __builtin_amdgcn_mfma_f32_16x16x32_fp8_fp8((a), (b), (c), 0, 0, 0)

constexpr int LDS_WTAB = 163840 - 768;
extern __shared__ __attribute__((aligned(16))) unsigned char lds_raw[];
__device__ __forceinline__ unsigned hw_wave_key() { return (unsigned)__builtin_amdgcn_s_getreg(((6 - 1) << 11) | 4) & 63u; }
__device__ __forceinline__ int fresh_tid() {
    const int wv = __builtin_amdgcn_readfirstlane(*(volatile LAS int*)((LAS unsigned char*)lds_raw + LDS_WTAB + 4 * hw_wave_key()));
    unsigned ones = ~0u; asm volatile("" : "+s"(ones));
    int t = (wv << 6) | (int)__builtin_amdgcn_mbcnt_hi(ones, __builtin_amdgcn_mbcnt_lo(ones, 0u)); asm volatile("" : "+v"(t)); return t; }
#define XB_TMO      128
#define XB_XCNT(j)  (256  + 64 * (j))
#define XB_XSUB(j)  (1280 + 64 * (j))
#define XB_XGEN(j)  (2304 + 64 * (j))
#define XB_TOP      3328
#define XB_TOPGEN   3392
#define XCD_BAR_WORDS 3456
#define XB_SPIN_CAP (1u << 22)
__device__ __forceinline__ unsigned xb_ld(unsigned* p)              { return __hip_atomic_load(p, __ATOMIC_RELAXED, __HIP_MEMORY_SCOPE_AGENT); }
__device__ __forceinline__ unsigned xb_add(unsigned* p, unsigned v) { asm volatile("" : "+v"(v));
    return __hip_atomic_fetch_add(p, v, __ATOMIC_RELAXED, __HIP_MEMORY_SCOPE_AGENT); }
__device__ __forceinline__ unsigned xb_xcc_id() { return (unsigned)__builtin_amdgcn_s_getreg((3 << 11) | 20) & 0xFu; }
#define XB_SPIN(cond, bar) do { unsigned _sp = 0; while (cond) { __builtin_amdgcn_s_sleep(1); \
    if ((++_sp & 255u) == 0u) { if (xb_ld(&(bar)[XB_TMO])) break; if (_sp > XB_SPIN_CAP) { atomicAdd(&(bar)[XB_TMO], 1u); break; } } } } while (0)
struct XcdBarrier { unsigned* bar; unsigned x; volatile LAS unsigned* st; };
__device__ __forceinline__ XcdBarrier xcd_barrier_post(unsigned* bar, volatile LAS unsigned* st) {
    XcdBarrier b; b.bar = bar; b.x = xb_xcc_id(); b.st = st;
    if (fresh_tid() == 0) (void)xb_add(&bar[XB_XCNT(b.x)], 1u);
    return b;
}
__device__ __forceinline__ void xcd_barrier_complete(unsigned* bar, unsigned x, unsigned& nloc, unsigned& nx) {
    const unsigned G = gridDim.x * gridDim.y * gridDim.z;
    unsigned sum, cnt, mine, sp = 0u;
    for (;;) {
        sum = 0u; cnt = 0u; mine = 0u;
#pragma unroll
        for (unsigned j = 0; j < 16; ++j) { const unsigned c = xb_ld(&bar[XB_XCNT(j)]); sum += c; cnt += (c > 0u) ? 1u : 0u; mine = (j == x) ? c : mine; }
        if (sum == G) break;
        __builtin_amdgcn_s_sleep(1);
        if ((++sp & 255u) == 0u) { if (xb_ld(&bar[XB_TMO])) break; if (sp > XB_SPIN_CAP) { atomicAdd(&bar[XB_TMO], 1u); break; } }
    }
    nloc = mine > 0u ? mine : 1u; nx = cnt > 0u ? cnt : 1u;
}
__device__ __forceinline__ void xcd_barrier(const XcdBarrier& b) {
    asm volatile("s_waitcnt vmcnt(0)" ::: "memory");
    __syncthreads();
    if (fresh_tid() == 0) {
        unsigned* bar = b.bar;
        __builtin_amdgcn_s_waitcnt(0);
        unsigned nloc = b.st[0], nx = b.st[1];
        if (nloc == 0u) { xcd_barrier_complete(bar, b.x, nloc, nx); b.st[0] = nloc; b.st[1] = nx; }
        const unsigned old = xb_add(&bar[XB_XSUB(b.x)], 1u);
        const unsigned gen = old / nloc;
        if (old + 1u == (gen + 1u) * nloc) {
            __builtin_amdgcn_fence(__ATOMIC_RELEASE, "agent");
            asm volatile("s_waitcnt vmcnt(0)" ::: "memory");
            const unsigned og = xb_add(&bar[XB_TOP], 1u);
            const unsigned tg = og / nx;
            if (og + 1u == (tg + 1u) * nx) xb_add(&bar[XB_TOPGEN], 1u);
            else XB_SPIN(xb_ld(&bar[XB_TOPGEN]) == tg, bar);
            __builtin_amdgcn_fence(__ATOMIC_ACQUIRE, "agent");
            xb_add(&bar[XB_XGEN(b.x)], 1u);
            asm volatile("s_waitcnt vmcnt(0)" ::: "memory");
        } else {
            XB_SPIN(xb_ld(&bar[XB_XGEN(b.x)]) == gen, bar);
            __builtin_amdgcn_fence(__ATOMIC_ACQUIRE, "agent");
            asm volatile("s_waitcnt vmcnt(0)" ::: "memory");
        }
    }
    __syncthreads();
}

#ifndef G8_SP2
#define G8_SP2 true
#endif
namespace g8 {
constexpr int BM = 256, BK = 64, HALF = 128, HTB = HALF * BK * 2, STAGE_BYTES = 8 * HTB;
__device__ __forceinline__ int lds_byte(int r, int c) { const int st = (r >> 4) * 2 + (c >> 5), rr = r & 15, cc = c & 31, ob = rr * 64 + cc * 2; return st * 1024 + (ob ^ (((ob >> 9) & 1) << 5)); }
__device__ __forceinline__ void stage_rc(int b, int& R, int& C) { const int st = b / 1024, sb = b % 1024, swz = sb ^ (((sb >> 9) & 1) << 5); R = (st >> 1) * 16 + swz / 64; C = (st & 1) * 32 + (swz % 64) / 2; }
__device__ __forceinline__ int perm32(int rho) { const int n = rho >> 4, i = rho & 15; return 8 * (i >> 2) + 4 * n + (i & 3); }

__device__ __forceinline__ const char* uni_ptr(const char* p) {
    const unsigned long long v = (unsigned long long)p; const unsigned lo = __builtin_amdgcn_readfirstlane((unsigned)v), hi = __builtin_amdgcn_readfirstlane((unsigned)(v >> 32)); return (const char*)(const GAS char*)(((unsigned long long)hi << 32) | lo); }
struct Unit { int pm, pn; const char* a; const char* b; int grow; };

template <bool B> struct BoolC { static constexpr bool value = B; };
template <class T, class = void> struct pre_of { static constexpr bool value = false; };
template <class T> struct pre_of<T, decltype((void)T::PRE)> { static constexpr bool value = T::PRE; };
template <class T, class = void> struct perm2_of { static constexpr bool value = false; };
template <class T> struct perm2_of<T, decltype((void)T::PERM2)> { static constexpr bool value = T::PERM2; };
struct MidNone { static constexpr bool ON = false; template <class A, class U> __device__ __forceinline__ void operator()(A&, const U&, int, int, int, int) const {} };
typedef int v8i32_t __attribute__((ext_vector_type(8)));
typedef int v4i32_t __attribute__((ext_vector_type(4)));
template <class Epi, class Sched, bool GATHER, class Mid = MidNone, bool SP2 = G8_SP2, bool FP8 = false>
__device__ __forceinline__ void gemm_phase(LAS unsigned char* lds, const int lda, const int ldb, const int K, const Sched& S, const Epi& E, const int* gidx, const Mid& Md = Mid()) {
    const int tid = fresh_tid(), wid = __builtin_amdgcn_readfirstlane(tid >> 6), lane = tid & 63, wr = wid >> 2, wc = wid & 3, fr = lane & 15, fq = lane >> 4;
    const int nt = K / BK;
    int Rr[2], Cc[2]; unsigned voffA[2], voffB[2][2];
#pragma unroll
    for (int i = 0; i < 2; ++i) { stage_rc(tid * 16 + i * 8192, Rr[i], Cc[i]); voffA[i] = (unsigned)(Rr[i] * lda + Cc[i]) * 2u;
#pragma unroll
        for (int h = 0; h < 2; ++h) { int Rb;
            if constexpr (perm2_of<Epi>::value) Rb = 64 * (Rr[i] >> 5) + 16 * (((Rr[i] & 31) >> 2) & 3) + 8 * h + 4 * ((Rr[i] & 31) >> 4) + (Rr[i] & 3);
            else Rb = h * HALF + (Epi::PERM ? ((Rr[i] & ~31) + perm32(Rr[i] & 31)) : Rr[i]);
            voffB[h][i] = (unsigned)(Rb * ldb + Cc[i]) * 2u; } }
    const unsigned hstepA = (unsigned)HALF * (unsigned)lda * 2u;
    const size_t kstep = (size_t)(BK * 2);
    const unsigned ldsw = (unsigned)wid * 1024u;
    const int aoff = lds_byte(wr * 64 + fr, fq * 8), boff = lds_byte(wc * 32 + fr, fq * 8);
#define G8_SA(b, h) (((b) * 2 + (h)) * HTB)
#define G8_SB(b, h) ((4 + (b) * 2 + (h)) * HTB)
#define G8_STAGE_B(bufoff, gbase, h) do { _Pragma("unroll") for (int _i = 0; _i < 2; ++_i) \
        __builtin_amdgcn_global_load_lds((const unsigned*)((const char*)(gbase) + voffB[h][_i]), (LAS unsigned*)(lds + (bufoff) + ldsw + _i * 8192), 16, 0, 0); } while (0)
#define G8_STAGE_A(bufoff, gbase, h, slot) do { _Pragma("unroll") for (int _i = 0; _i < 2; ++_i) { \
        unsigned _o; if constexpr (GATHER) _o = (unsigned)(*(const LAS int*)(lds + LDS_GIDX + (slot) * 1024 + ((h) * HALF + Rr[_i]) * 4) * lda + Cc[_i]) * 2u; else _o = voffA[_i] + (unsigned)(h) * hstepA; \
        __builtin_amdgcn_global_load_lds((const unsigned*)((const char*)(gbase) + _o), (LAS unsigned*)(lds + (bufoff) + ldsw + _i * 8192), 16, 0, 0); } } while (0)
#define G8_LD32(p) __builtin_shufflevector(*(const LAS v4i32_t*)(p), *(const LAS v4i32_t*)((p) + 1024), 0, 1, 2, 3, 4, 5, 6, 7)
#define G8_LDA(dst, b, h) do { if constexpr (FP8) { _Pragma("unroll") for (int m = 0; m < 4; ++m) dst##8[m] = G8_LD32(lds + G8_SA(b, h) + aoff + m * 2048); } \
        else { _Pragma("unroll") for (int m = 0; m < 4; ++m) _Pragma("unroll") for (int k = 0; k < 2; ++k) dst[m][k] = *(const LAS bf16x8*)(lds + G8_SA(b, h) + aoff + m * 2048 + k * 1024); } } while (0)
#define G8_LDB(dst, b, h) do { if constexpr (FP8) { _Pragma("unroll") for (int n = 0; n < 2; ++n) dst##8[n] = G8_LD32(lds + G8_SB(b, h) + boff + n * 2048); } \
        else { _Pragma("unroll") for (int n = 0; n < 2; ++n) _Pragma("unroll") for (int k = 0; k < 2; ++k) dst[n][k] = *(const LAS bf16x8*)(lds + G8_SB(b, h) + boff + n * 2048 + k * 1024); } } while (0)
#define G8_MMA(ai, bj, At, Bt) do { __builtin_amdgcn_s_setprio(1); \
        if constexpr (FP8) { _Pragma("unroll") for (int m = 0; m < 4; ++m) _Pragma("unroll") for (int n = 0; n < 2; ++n) \
            asm volatile("v_mfma_scale_f32_16x16x128_f8f6f4 %0, %1, %2, %0, %3, %4 op_sel_hi:[0,0,0]" : "+v"(acc[ai][bj][m][n]) : "v"(Bt##8[n]), "v"(At##8[m]), "v"(sc_w), "v"(sc_x)); } \
        else { _Pragma("unroll") for (int m = 0; m < 4; ++m) _Pragma("unroll") for (int n = 0; n < 2; ++n) _Pragma("unroll") for (int k = 0; k < 2; ++k) \
            acc[ai][bj][m][n] = __builtin_amdgcn_mfma_f32_16x16x32_bf16(Bt[n][k], At[m][k], acc[ai][bj][m][n], 0, 0, 0); } \
        __builtin_amdgcn_s_setprio(0); } while (0)
#define G8_MMA0(ai, bj, At, Bt) do { __builtin_amdgcn_s_setprio(1); \
        if constexpr (FP8) { _Pragma("unroll") for (int m = 0; m < 4; ++m) _Pragma("unroll") for (int n = 0; n < 2; ++n) \
            asm volatile("v_mfma_scale_f32_16x16x128_f8f6f4 %0, %1, %2, 0, %3, %4 op_sel_hi:[0,0,0]" : "+v"(acc[ai][bj][m][n]) : "v"(Bt##8[n]), "v"(At##8[m]), "v"(sc_w), "v"(sc_x)); } \
        else { _Pragma("unroll") for (int m = 0; m < 4; ++m) _Pragma("unroll") for (int n = 0; n < 2; ++n) _Pragma("unroll") for (int k = 0; k < 2; ++k) \
            acc[ai][bj][m][n] = __builtin_amdgcn_mfma_f32_16x16x32_bf16(Bt[n][k], At[m][k], acc[ai][bj][m][n], 0, 0, 0); } \
        __builtin_amdgcn_s_setprio(0); } while (0)
#define G8_MMAF(first, ai, bj, At, Bt) do { if constexpr (FP8 && (first)) G8_MMA0(ai, bj, At, Bt); else G8_MMA(ai, bj, At, Bt); } while (0)
#define G8_WAIT_V(n) asm volatile("s_waitcnt vmcnt(" #n ")" ::: "memory")
#define G8_WAIT_L(n) asm volatile("s_waitcnt lgkmcnt(" #n ")" ::: "memory")
#define G8_WAIT_VR do { if (fresh) { if constexpr (pre_of<Epi>::value) { if (prev16) G8_WAIT_V(24); else G8_WAIT_V(16); } else if constexpr (Epi::NVM == 16) G8_WAIT_V(24); else if constexpr (Epi::NVM == 32) G8_WAIT_V(40); else if constexpr (Epi::NVM == 8) G8_WAIT_V(16); else G8_WAIT_V(8); } else G8_WAIT_V(8); } while (0)
#define G8_BAR __builtin_amdgcn_s_barrier()
#define G8_SCHED __builtin_amdgcn_sched_barrier(0)
    Unit cur, nxt; int ui = 0; bool prev16 = false; (void)prev16;
    if (!S.next(0, cur)) return;
    f32x4 acc[2][2][4][2];
    {
#pragma unroll
    for (int a = 0; a < 2; ++a)
#pragma unroll
        for (int b = 0; b < 2; ++b)
#pragma unroll
            for (int m = 0; m < 4; ++m)
#pragma unroll
                for (int n = 0; n < 2; ++n) acc[a][b][m][n] = (f32x4){0.f, 0.f, 0.f, 0.f};
    }
    bf16x8 At[4][2], B0[2][2], B1[2][2]; v8i32_t At8[4], B08[2], B18[2];
    int sc_w = 0x77777777, sc_x = 0x7B7B7B7B; if constexpr (FP8) asm volatile("" : "+v"(sc_w), "+v"(sc_x));
    const char* cA = uni_ptr(cur.a); const char* cB = uni_ptr(cur.b);
    if constexpr (GATHER) {
        if (tid < 256) *(LAS int*)(lds + LDS_GIDX + tid * 4) = gidx[cur.grow + tid];
        __syncthreads();
    }
    if constexpr (SP2) {
        G8_STAGE_B(G8_SB(0, 0), cB, 0); G8_STAGE_B(G8_SB(0, 1), cB, 1); G8_STAGE_A(G8_SA(0, 0), cA, 0, 0); G8_STAGE_A(G8_SA(0, 1), cA, 1, 0);
        if (wr == 1) G8_BAR;
        G8_WAIT_V(2); G8_BAR;
        G8_STAGE_B(G8_SB(1, 0), cB + kstep, 0); G8_STAGE_A(G8_SA(1, 0), cA + kstep, 0, 0); G8_STAGE_B(G8_SB(1, 1), cB + kstep, 1);
        G8_WAIT_V(6); G8_BAR;
    } else {
    G8_STAGE_B(G8_SB(0, 0), cB, 0); G8_STAGE_A(G8_SA(0, 0), cA, 0, 0); G8_STAGE_B(G8_SB(0, 1), cB, 1); G8_STAGE_A(G8_SA(0, 1), cA, 1, 0);
    if (wr == 1) G8_BAR;
    G8_WAIT_V(4); G8_BAR;
    G8_STAGE_B(G8_SB(1, 0), cB + kstep, 0); G8_STAGE_A(G8_SA(1, 0), cA + kstep, 0, 0); G8_STAGE_B(G8_SB(1, 1), cB + kstep, 1);
    G8_WAIT_V(6); G8_BAR;
    }
#pragma unroll 1
    for (;;) {
        const bool has_next = S.next(ui + 1, nxt);
        const char* nA = has_next ? uni_ptr(nxt.a) : cA; const char* nB = has_next ? uni_ptr(nxt.b) : cB;
        if constexpr (GATHER) {
            if (has_next && wid == 0)
                __builtin_amdgcn_global_load_lds((const unsigned*)(gidx + nxt.grow) + lane * 4, (LAS unsigned*)(lds + LDS_GIDX + ((ui + 1) & 1) * 1024), 16, 0, 0);
        }
        auto trip = [&](const int t, auto first_c) __attribute__((always_inline)) {
            constexpr bool FIRST = decltype(first_c)::value;
            const bool last = (t == nt - 2);
            const char* a1 = cA + (size_t)(t + 1) * kstep;
            const char* a2 = last ? nA : cA + (size_t)(t + 2) * kstep; const char* b2 = last ? nB : cB + (size_t)(t + 2) * kstep;
            const char* a3 = a2 + kstep; const char* b3 = b2 + kstep;
            const int sl1 = ui & 1, sl2 = (last && has_next) ? ((ui + 1) & 1) : (ui & 1);
            const bool fresh = (FIRST || (!FP8 && t == 0)) && (ui > 0);
            if constexpr (Mid::ON) { if (t == (nt >> 1)) { G8_SCHED; if constexpr (FP8) asm volatile("s_nop 15\n\ts_nop 15" ::: "memory"); Md(acc, cur, wr, wc, fr, fq); if constexpr (FP8) asm volatile("s_nop 7" ::: "memory"); G8_SCHED; } }
            if constexpr (SP2) {
            if constexpr (GATHER) { if (!fresh) G8_STAGE_A(G8_SA(1, 1), a1, 1, sl1); } G8_LDB(B0, 0, 0); G8_LDB(B1, 0, 1); G8_SCHED; G8_LDA(At, 0, 0); if constexpr (!GATHER) { if (!fresh) G8_STAGE_A(G8_SA(1, 1), a1, 1, sl1); }
            G8_WAIT_VR; G8_WAIT_L(0); G8_BAR; G8_MMAF(FIRST, 0, 0, At, B0); G8_MMAF(FIRST, 0, 1, At, B1); G8_BAR; G8_SCHED;
            G8_LDA(At, 0, 1); G8_STAGE_B(G8_SB(0, 0), b2, 0); G8_STAGE_B(G8_SB(0, 1), b2, 1); G8_STAGE_A(G8_SA(0, 0), a2, 0, sl2);
            G8_WAIT_VR; G8_WAIT_L(0); G8_BAR; G8_MMAF(FIRST, 1, 0, At, B0); G8_MMAF(FIRST, 1, 1, At, B1); G8_BAR; G8_SCHED;
            if constexpr (GATHER) { G8_STAGE_A(G8_SA(0, 1), a2, 1, sl2); } G8_LDB(B0, 1, 0); G8_LDB(B1, 1, 1); G8_SCHED; G8_LDA(At, 1, 0); if constexpr (!GATHER) { G8_STAGE_A(G8_SA(0, 1), a2, 1, sl2); }
            G8_WAIT_VR; G8_WAIT_L(0); G8_BAR; G8_MMA(0, 0, At, B0); G8_MMA(0, 1, At, B1); G8_BAR; G8_SCHED;
            G8_LDA(At, 1, 1); G8_STAGE_B(G8_SB(1, 0), b3, 0); G8_STAGE_B(G8_SB(1, 1), b3, 1); G8_STAGE_A(G8_SA(1, 0), a3, 0, sl2);
            G8_WAIT_V(8); G8_WAIT_L(0); G8_BAR; G8_MMA(1, 0, At, B0); G8_MMA(1, 1, At, B1); G8_BAR; G8_SCHED;
            if (last && has_next) G8_STAGE_A(G8_SA(1, 1), a3, 1, sl2);
            } else {
            if constexpr (GATHER) { G8_STAGE_A(G8_SA(1, 1), a1, 1, sl1); } G8_LDB(B0, 0, 0); G8_SCHED; G8_LDA(At, 0, 0); if constexpr (!GATHER) { G8_STAGE_A(G8_SA(1, 1), a1, 1, sl1); }
            G8_WAIT_L(8); G8_BAR; G8_WAIT_L(0); G8_MMA(0, 0, At, B0); G8_BAR; G8_SCHED;
            G8_LDB(B1, 0, 1); G8_STAGE_B(G8_SB(0, 0), b2, 0);
            G8_BAR; G8_WAIT_L(0); G8_MMA(0, 1, At, B1); G8_BAR;
            if constexpr (GATHER) { G8_STAGE_A(G8_SA(0, 0), a2, 0, sl2); } G8_LDA(At, 0, 1); if constexpr (!GATHER) { G8_STAGE_A(G8_SA(0, 0), a2, 0, sl2); }
            G8_BAR; G8_WAIT_L(0); G8_MMA(1, 0, At, B0); G8_BAR; G8_SCHED;
            G8_STAGE_B(G8_SB(0, 1), b2, 1);
            G8_WAIT_V(6); G8_BAR; G8_MMA(1, 1, At, B1); G8_BAR;
            if constexpr (GATHER) { G8_STAGE_A(G8_SA(0, 1), a2, 1, sl2); } G8_LDB(B0, 1, 0); G8_SCHED; G8_LDA(At, 1, 0); if constexpr (!GATHER) { G8_STAGE_A(G8_SA(0, 1), a2, 1, sl2); }
            G8_WAIT_L(8); G8_BAR; G8_WAIT_L(0); G8_MMA(0, 0, At, B0); G8_BAR; G8_SCHED;
            G8_LDB(B1, 1, 1); G8_STAGE_B(G8_SB(1, 0), b3, 0);
            G8_BAR; G8_WAIT_L(0); G8_MMA(0, 1, At, B1); G8_BAR;
            if constexpr (GATHER) { G8_STAGE_A(G8_SA(1, 0), a3, 0, sl2); } G8_LDA(At, 1, 1); if constexpr (!GATHER) { G8_STAGE_A(G8_SA(1, 0), a3, 0, sl2); }
            G8_BAR; G8_WAIT_L(0); G8_MMA(1, 0, At, B0); G8_BAR; G8_SCHED;
            G8_STAGE_B(G8_SB(1, 1), b3, 1);
            G8_WAIT_V(6); G8_BAR; G8_MMA(1, 1, At, B1); G8_BAR;
            }
                };
        if constexpr (FP8) { trip(0, BoolC<true>());
#pragma unroll 1
            for (int t = 2; t < nt; t += 2) trip(t, BoolC<false>()); }
        else {
#pragma unroll 1
            for (int t = 0; t < nt; t += 2) trip(t, BoolC<false>()); }
        if (wr == 0) G8_BAR;
        if constexpr (FP8) asm volatile("s_nop 15\n\ts_nop 15" ::: "memory");
        E(acc, cur, wr, wc, fr, fq);
        if (!has_next) break;
#pragma unroll
        for (int a = 0; a < 2; ++a)
#pragma unroll
            for (int b = 0; b < 2; ++b)
#pragma unroll
                for (int m = 0; m < 4; ++m)
#pragma unroll
                    for (int n = 0; n < 2; ++n) {
                        if constexpr (!SP2 || !FP8) acc[a][b][m][n] = (f32x4){0.f, 0.f, 0.f, 0.f};
                        else asm volatile("" : "=v"(acc[a][b][m][n]));
                    }
        if constexpr (pre_of<Epi>::value) prev16 = E.nvm16(cur);
        cur = nxt; cA = nA; cB = nB; ++ui;
        if (wr == 1) G8_BAR;
    }
    G8_WAIT_V(0);
    G8_BAR;
#undef G8_SA
#undef G8_SB
#undef G8_STAGE_A
#undef G8_STAGE_B
#undef G8_LDA
#undef G8_LDB
#undef G8_MMA
#undef G8_MMA0
#undef G8_MMAF
#undef G8_LD32
#undef G8_WAIT_V
#undef G8_WAIT_VR
#undef G8_WAIT_L
#undef G8_BAR
#undef G8_SCHED
}

template <int NM, int NN>
struct SchedDenseT {
    static constexpr int nM = NM, nN = NN, nwg = NM * NN;
    int G, c; const char* A; const char* B; size_t atile, btile;
    __device__ __forceinline__ void init(int M_, int N_, int G_, int c_, const void* A_, size_t lda_elems, const void* B_, size_t ldb_elems) {
        (void)M_; (void)N_; G = G_; c = c_; A = (const char*)A_; B = (const char*)B_; atile = 256 * lda_elems * 2; btile = 256 * ldb_elems * 2; }
    __device__ __forceinline__ bool next(int i, Unit& u) const {
        const long L = (long)i * G + c; if (L >= nwg) return false;
        int wgid = (int)L; { constexpr int q = nwg / 8, r = nwg % 8; const int xcd = wgid % 8, off = wgid / 8; wgid = (xcd < r ? xcd * (q + 1) : r * (q + 1) + (xcd - r) * q) + off; }
        constexpr int nig = 8 * nN; const int gid = wgid / nig, fm = gid * 8, gsz = (nM - fm) < 8 ? (nM - fm) : 8;
        if constexpr (NM % 8 == 0) { u.pm = fm + ((wgid % nig) % 8); u.pn = (wgid % nig) / 8; } else { u.pm = fm + ((wgid % nig) % gsz); u.pn = (wgid % nig) / gsz; }
        u.a = A + (size_t)u.pm * atile; u.b = B + (size_t)u.pn * btile; u.grow = 0; return true;
    }
};
struct SchedUp {
    const LAS int* tileE; int ntiles, G, c; const char* A; const char* B;
    __device__ __forceinline__ bool next(int i, Unit& u) const {
        const long L = (long)i * G + c; if (L >= 2L * ntiles) return false;
        const int tile = (int)(L >> 1); u.pn = (int)(L & 1); u.pm = tile; u.grow = tile * 256;
        const int e = tile < NSH_TILES ? 64 : tileE[tile - NSH_TILES];
        u.a = A; u.b = B + ((size_t)e * 512 + (size_t)u.pn * 256) * 1024; return true;
    }
};
struct SchedDown {
    const LAS int* tileE; int nt, toff, G, c; const char* A; const char* B;
    __device__ __forceinline__ bool next(int i, Unit& u) const {
        const long L = (long)i * G + c; if (L >= 4L * nt) return false;
        const int tile = (int)(L >> 2); u.pn = (int)(L & 3); u.pm = tile; u.grow = 0;
        const int e = tileE[toff + tile];
        u.a = A + (size_t)(256 * (toff + tile)) * DEXP; u.b = B + ((size_t)e * 1024 + (size_t)u.pn * 256) * DEXP; return true;
    }
};

struct EpiBiasAct {
    static constexpr bool PERM = true; static constexpr int NVM = 16;
    bf16* O; int ldc; const float* bias; unsigned long long modes; float* vpart;
    __device__ __forceinline__ void operator()(const f32x4 (&acc)[2][2][4][2], const Unit& u, int wr, int wc, int fr, int fq) const {
        asm volatile("" : "+v"(fr), "+v"(fq));
        const int row0 = u.pm * 256 + wr * 64 + fr, col0 = u.pn * 256 + wc * 32 + 8 * fq;
        f32x4 bv[2][2];
#pragma unroll
        for (int bj = 0; bj < 2; ++bj)
#pragma unroll
            for (int n = 0; n < 2; ++n) bv[bj][n] = *(const f32x4*)(bias + col0 + bj * 128 + 4 * n);
#pragma unroll
        for (int ai = 0; ai < 2; ++ai)
#pragma unroll
            for (int m = 0; m < 4; ++m) { bf16* rowp = O + (size_t)(row0 + ai * 128 + m * 16) * ldc + col0;
#pragma unroll
                for (int bj = 0; bj < 2; ++bj) { f32x4 v0 = acc[ai][bj][m][0] + bv[bj][0], v1 = acc[ai][bj][m][1] + bv[bj][1];
#pragma unroll
                    for (int j = 0; j < 4; ++j) { v0[j] = fast_sigmoid(v0[j]); v1[j] = fast_sigmoid(v1[j]); }
                    u32x4 w; w.x = cvt_pk_bf16(v0[0], v0[1]); w.y = cvt_pk_bf16(v0[2], v0[3]); w.z = cvt_pk_bf16(v1[0], v1[1]); w.w = cvt_pk_bf16(v1[2], v1[3]);
                    *(u32x4*)(rowp + bj * 128) = w; } }
    }
};
struct EpiZ {
    static constexpr bool PERM = true, PERM2 = true, PRE = true; static constexpr int NVM = 8;
    unsigned char* Z8; bf16* ZG; const float* bias; float* vpart; bool plain;
    __device__ __forceinline__ bool nvm16(const Unit& u) const { return u.pn >= 20 || (!plain && u.pn >= 8 && u.pn < 12); }
    __device__ __forceinline__ void operator()(const f32x4 (&acc)[2][2][4][2], const Unit& u, int wr, int wc, int fr, int fq) const {
        asm volatile("" : "+v"(fr), "+v"(fq));
        const int row0 = u.pm * 256 + wr * 64 + fr, cw = wc * 64 + 16 * fq;
        f32x4 bv[2][2];
#pragma unroll
        for (int bj = 0; bj < 2; ++bj)
#pragma unroll
            for (int n = 0; n < 2; ++n) bv[bj][n] = *(const f32x4*)(bias + u.pn * 256 + cw + 8 * bj + 4 * n);
        if (u.pn >= 20) {
            const int cg = 128 * (u.pn - 20) + wc * 32 + 8 * fq;
#pragma unroll
            for (int ai = 0; ai < 2; ++ai)
#pragma unroll
                for (int m = 0; m < 4; ++m) { bf16* rowp = ZG + (size_t)(row0 + ai * 128 + m * 16) * ZGP;
                    float rr[8], sb[8];
#pragma unroll
                    for (int n = 0; n < 2; ++n)
#pragma unroll
                        for (int j = 0; j < 4; ++j) { const float ea = __builtin_amdgcn_exp2f(-1.4426950408889634f * (acc[ai][0][m][n][j] + bv[0][n][j])), eb = __builtin_amdgcn_exp2f(-1.4426950408889634f * (acc[ai][1][m][n][j] + bv[1][n][j]));
                            sb[4 * n + j] = __builtin_amdgcn_rcpf(1.0f + eb); rr[4 * n + j] = (1.0f + eb) * __builtin_amdgcn_rcpf(1.0f + ea); }
                    u32x4 w; w.x = cvt_pk_bf16(rr[0], rr[1]); w.y = cvt_pk_bf16(rr[2], rr[3]); w.z = cvt_pk_bf16(rr[4], rr[5]); w.w = cvt_pk_bf16(rr[6], rr[7]);
                    *(u32x4*)(rowp + cg) = w;
                    w.x = cvt_pk_bf16(sb[0], sb[1]); w.y = cvt_pk_bf16(sb[2], sb[3]); w.z = cvt_pk_bf16(sb[4], sb[5]); w.w = cvt_pk_bf16(sb[6], sb[7]);
                    *(u32x4*)(rowp + 1024 + cg) = w; }
            return;
        }
        if (plain || (u.pn >= 4 && u.pn < 8) || (u.pn >= 12 && u.pn < 16)) body<0, false>(acc, u, row0, cw, wc, fq, bv);
        else if (u.pn < 4) body<1, false>(acc, u, row0, cw, wc, fq, bv);
        else if (u.pn < 12) body<1, true>(acc, u, row0, cw, wc, fq, bv);
        else body<2, false>(acc, u, row0, cw, wc, fq, bv);
    }
    template <int MODE, bool STAT>
    __device__ __forceinline__ void body(const f32x4 (&acc)[2][2][4][2], const Unit& u, int row0, int cw, int wc, int fq, const f32x4 (&bv)[2][2]) const {
        float* const sink = (float*)((char*)vpart - (WS_VPART - WS_DBG)) + 2 * (16 * fq + (row0 & 15));
#pragma unroll
        for (int ai = 0; ai < 2; ++ai)
#pragma unroll
            for (int m = 0; m < 4; ++m) { u32x4 o; float ps1 = 0.f, ps2 = 0.f;
#pragma unroll
                for (int bj = 0; bj < 2; ++bj) { f32x4 v0 = acc[ai][bj][m][0] + bv[bj][0], v1 = acc[ai][bj][m][1] + bv[bj][1];
                    if constexpr (MODE == 1) { const f32x8 g = gelu8((f32x8){v0[0], v0[1], v0[2], v0[3], v1[0], v1[1], v1[2], v1[3]}); v0 = (f32x4){g[0], g[1], g[2], g[3]}; v1 = (f32x4){g[4], g[5], g[6], g[7]}; }
                    else if constexpr (MODE == 2) {
#pragma unroll
                        for (int j = 0; j < 4; ++j) { v0[j] = fast_sigmoid(v0[j]); v1[j] = fast_sigmoid(v1[j]); } }
                    if constexpr (STAT) { ps1 += ((v0[0] + v0[1]) + (v0[2] + v0[3])) + ((v1[0] + v1[1]) + (v1[2] + v1[3])); ps2 += ((v0[0] * v0[0] + v0[1] * v0[1]) + (v0[2] * v0[2] + v0[3] * v0[3])) + ((v1[0] * v1[0] + v1[1] * v1[1]) + (v1[2] * v1[2] + v1[3] * v1[3])); }
                    o[2 * bj] = pk4_fp8x16(v0[0], v0[1], v0[2], v0[3]); o[2 * bj + 1] = pk4_fp8x16(v1[0], v1[1], v1[2], v1[3]); }
                *(u32x4*)(Z8 + (size_t)(row0 + ai * 128 + m * 16) * Z8W + u.pn * 256 + cw) = o;
                if constexpr (STAT) {
                    { const auto r = __builtin_amdgcn_permlane32_swap(__float_as_uint(ps1), __float_as_uint(ps1), false, false); ps1 = __uint_as_float(r[0]) + __uint_as_float(r[1]); }
                    { const auto r = __builtin_amdgcn_permlane16_swap(__float_as_uint(ps1), __float_as_uint(ps1), false, false); ps1 = __uint_as_float(r[0]) + __uint_as_float(r[1]); }
                    { const auto r = __builtin_amdgcn_permlane32_swap(__float_as_uint(ps2), __float_as_uint(ps2), false, false); ps2 = __uint_as_float(r[0]) + __uint_as_float(r[1]); }
                    { const auto r = __builtin_amdgcn_permlane16_swap(__float_as_uint(ps2), __float_as_uint(ps2), false, false); ps2 = __uint_as_float(r[0]) + __uint_as_float(r[1]); }
                    float* const dst = fq == 0 ? vpart + ((size_t)(row0 + ai * 128 + m * 16) * 16 + (u.pn - 8) * 4 + wc) * 2 : sink;
                    *(f32x2*)dst = (f32x2){ps1, ps2}; } }
    }
};
struct EpiOut8 {
    static constexpr bool PERM = true, PERM2 = true; static constexpr int NVM = 8;
    unsigned char* O; int ldc;
    __device__ __forceinline__ void operator()(const f32x4 (&acc)[2][2][4][2], const Unit& u, int wr, int wc, int fr, int fq) const {
        asm volatile("" : "+v"(fr), "+v"(fq));
        const int row0 = u.pm * 256 + wr * 64 + fr, col0 = u.pn * 256 + wc * 64 + 16 * fq;
        float sc256 = 256.f; asm volatile("" : "+s"(sc256));
#pragma unroll
        for (int ai = 0; ai < 2; ++ai)
#pragma unroll
            for (int m = 0; m < 4; ++m) { u32x4 o;
#pragma unroll
                for (int bj = 0; bj < 2; ++bj)
#pragma unroll
                    for (int n = 0; n < 2; ++n) { const f32x4 v = acc[ai][bj][m][n] * sc256;
                        int a = __builtin_amdgcn_cvt_pk_fp8_f32(v[0], v[1], 0, false); a = __builtin_amdgcn_cvt_pk_fp8_f32(v[2], v[3], a, true); o[2 * bj + n] = (unsigned)a; }
                *(u32x4*)(O + (size_t)(row0 + ai * 128 + m * 16) * ldc + col0) = o; }
    }
};
struct EpiGate {
    static constexpr bool PERM = true; static constexpr int NVM = 32;
    const bf16* gate; int ldg, gcol; const bf16* add; int lda_, acol; bf16* O; int ldo, ocol; bool o8;
    __device__ __forceinline__ void operator()(const f32x4 (&acc)[2][2][4][2], const Unit& u, int wr, int wc, int fr, int fq) const {
        asm volatile("" : "+v"(fr), "+v"(fq));
        const int row0 = u.pm * 256 + wr * 64 + fr, col0 = u.pn * 256 + wc * 32 + 8 * fq;
        u32x4 g[2][4][2];
#pragma unroll
        for (int ai = 0; ai < 2; ++ai)
#pragma unroll
            for (int m = 0; m < 4; ++m) { const size_t r = (size_t)(row0 + ai * 128 + m * 16);
#pragma unroll
                for (int bj = 0; bj < 2; ++bj) g[ai][m][bj] = *(const u32x4*)(gate + r * ldg + gcol + col0 + bj * 128); }
#pragma unroll
        for (int ai = 0; ai < 2; ++ai)
#pragma unroll
            for (int m = 0; m < 4; ++m) { const size_t r = (size_t)(row0 + ai * 128 + m * 16);
#pragma unroll
                for (int bj = 0; bj < 2; ++bj) { const int c = col0 + bj * 128; const u32x4 gg = g[ai][m][bj];
                    f32x4 v0 = acc[ai][bj][m][0], v1 = acc[ai][bj][m][1];
                    v0[0] *= bflo(gg.x); v0[1] *= bfhi(gg.x); v0[2] *= bflo(gg.y); v0[3] *= bfhi(gg.y);
                    v1[0] *= bflo(gg.z); v1[1] *= bfhi(gg.z); v1[2] *= bflo(gg.w); v1[3] *= bfhi(gg.w);
                    if (o8) *(u32x2*)((unsigned char*)(O + r * ldo + ocol) + c) = (u32x2){pk4_fp8x16(v0[0], v0[1], v0[2], v0[3]), pk4_fp8x16(v1[0], v1[1], v1[2], v1[3])};
                    else { u32x4 w; w.x = cvt_pk_bf16(v0[0], v0[1]); w.y = cvt_pk_bf16(v0[2], v0[3]); w.z = cvt_pk_bf16(v1[0], v1[1]); w.w = cvt_pk_bf16(v1[2], v1[3]);
                        *(u32x4*)(O + r * ldo + ocol + c) = w; } } }
    }
};
struct EpiResid {
    static constexpr bool PERM = true; static constexpr int NVM = 32;
    const float* xf; bf16* XR;
    __device__ __forceinline__ void operator()(const f32x4 (&acc)[2][2][4][2], const Unit& u, int wr, int wc, int fr, int fq) const {
        asm volatile("" : "+v"(fr), "+v"(fq));
        const int row0 = u.pm * 256 + wr * 64 + fr, col0 = u.pn * 256 + wc * 32 + 8 * fq;
        float alpha = ALPHA; asm volatile("" : "+s"(alpha));
        if (!xf) {
            u32x4 q[2][4][2];
#pragma unroll
            for (int ai = 0; ai < 2; ++ai)
#pragma unroll
                for (int m = 0; m < 4; ++m)
#pragma unroll
                    for (int bj = 0; bj < 2; ++bj) q[ai][m][bj] = *(const u32x4*)(XR + (size_t)(row0 + ai * 128 + m * 16) * D + col0 + bj * 128);
#pragma unroll
            for (int ai = 0; ai < 2; ++ai)
#pragma unroll
                for (int m = 0; m < 4; ++m)
#pragma unroll
                    for (int bj = 0; bj < 2; ++bj) { const u32x4 qq = q[ai][m][bj];
                        const f32x4 r0 = (f32x4){bflo(qq.x), bfhi(qq.x), bflo(qq.y), bfhi(qq.y)} * alpha + acc[ai][bj][m][0], r1 = (f32x4){bflo(qq.z), bfhi(qq.z), bflo(qq.w), bfhi(qq.w)} * alpha + acc[ai][bj][m][1];
                        u32x4 w; w.x = cvt_pk_bf16(r0[0], r0[1]); w.y = cvt_pk_bf16(r0[2], r0[3]); w.z = cvt_pk_bf16(r1[0], r1[1]); w.w = cvt_pk_bf16(r1[2], r1[3]);
                        *(u32x4*)(XR + (size_t)(row0 + ai * 128 + m * 16) * D + col0 + bj * 128) = w; }
            return;
        }
#pragma unroll
        for (int ai = 0; ai < 2; ++ai)
#pragma unroll
            for (int mh = 0; mh < 2; ++mh) {
                f32x4 x[2][2][2];
#pragma unroll
                for (int m2 = 0; m2 < 2; ++m2) { const size_t off = (size_t)(row0 + ai * 128 + (2 * mh + m2) * 16) * D + col0;
#pragma unroll
                    for (int bj = 0; bj < 2; ++bj) {
                        if (xf) { x[m2][bj][0] = *(const f32x4*)(xf + off + bj * 128); x[m2][bj][1] = *(const f32x4*)(xf + off + bj * 128 + 4); }
                        else { const u32x4 q = *(const u32x4*)(XR + off + bj * 128); x[m2][bj][0] = (f32x4){bflo(q.x), bfhi(q.x), bflo(q.y), bfhi(q.y)}; x[m2][bj][1] = (f32x4){bflo(q.z), bfhi(q.z), bflo(q.w), bfhi(q.w)}; } } }
#pragma unroll
                for (int m2 = 0; m2 < 2; ++m2) { const size_t off = (size_t)(row0 + ai * 128 + (2 * mh + m2) * 16) * D + col0;
#pragma unroll
                    for (int bj = 0; bj < 2; ++bj) { const f32x4 r0 = x[m2][bj][0] * alpha + acc[ai][bj][2 * mh + m2][0], r1 = x[m2][bj][1] * alpha + acc[ai][bj][2 * mh + m2][1];
                        u32x4 w; w.x = cvt_pk_bf16(r0[0], r0[1]); w.y = cvt_pk_bf16(r0[2], r0[3]); w.z = cvt_pk_bf16(r1[0], r1[1]); w.w = cvt_pk_bf16(r1[2], r1[3]);
                        *(u32x4*)(XR + off + bj * 128) = w; } }
                asm volatile("" ::: "memory");
            }
    }
};
struct EpiMoeUp {
    static constexpr bool PERM = true; static constexpr int NVM = 16;
    bf16* HID; const float* SW; bf16* PBH;
    __device__ __forceinline__ void operator()(const f32x4 (&acc)[2][2][4][2], const Unit& u, int wr, int wc, int fr, int fq) const {
        asm volatile("" : "+v"(fr), "+v"(fq));
        const int rl0 = wr * 64 + fr, col0 = u.pn * 128 + wc * 32 + 8 * fq;
        float wv[2][4];
#pragma unroll
        for (int ai = 0; ai < 2; ++ai)
#pragma unroll
            for (int m = 0; m < 4; ++m) wv[ai][m] = SW[(size_t)u.grow + rl0 + ai * 128 + m * 16];
        if (u.pm < NSH_TILES) body<true>(acc, u, rl0, col0, wv); else body<false>(acc, u, rl0, col0, wv);
    }
    template <bool SH>
    __device__ __forceinline__ void body(const f32x4 (&acc)[2][2][4][2], const Unit& u, int rl0, int col0, const float (&wv)[2][4]) const {
#pragma unroll
        for (int ai = 0; ai < 2; ++ai)
#pragma unroll
            for (int m = 0; m < 4; ++m) { const size_t r = (size_t)u.grow + rl0 + ai * 128 + m * 16; const float w = wv[ai][m];
                float h[8];
#pragma unroll
                for (int n = 0; n < 2; ++n)
#pragma unroll
                    for (int j = 0; j < 4; ++j) { const float g = acc[ai][0][m][n][j], up = acc[ai][1][m][n][j]; h[4 * n + j] = g * fast_sigmoid(g) * up * w; }
                if constexpr (SH) *(u32x2*)((unsigned char*)PBH + r * 512 + 256 + col0) = (u32x2){pk4_fp8x16(h[0], h[1], h[2], h[3]), pk4_fp8x16(h[4], h[5], h[6], h[7])};
                else *(u32x2*)((unsigned char*)HID + (r - M) * DEXP + col0) = (u32x2){pk4_fp8x16(h[0], h[1], h[2], h[3]), pk4_fp8x16(h[4], h[5], h[6], h[7])}; }
    }
};
struct MidMulP {
    static constexpr bool ON = true;
    const bf16* Rp; int ld, cr;
    __device__ __forceinline__ void operator()(f32x4 (&acc)[2][2][4][2], const Unit& u, int wr, int wc, int fr, int fq) const {
        asm volatile("" : "+v"(fr), "+v"(fq));
        const char* base = (const char*)Rp + ((size_t)u.pm * 256 * ld + (size_t)u.pn * 256 + cr) * 2;
        const unsigned lo = (unsigned)((wr * 64 + fr) * ld + wc * 32 + 8 * fq) * 2u;
#pragma unroll
        for (int ai = 0; ai < 2; ++ai) {
            u32x4 g[4][2];
#pragma unroll
            for (int m = 0; m < 4; ++m) { const unsigned ro = lo + (unsigned)((ai * 128 + m * 16) * ld) * 2u;
#pragma unroll
                for (int bj = 0; bj < 2; ++bj) g[m][bj] = *(const u32x4*)(base + ro + (unsigned)(bj * 128) * 2u); }
#pragma unroll
            for (int m = 0; m < 4; ++m)
#pragma unroll
                for (int bj = 0; bj < 2; ++bj) { const u32x4 a = g[m][bj];
                    acc[ai][bj][m][0][0] *= bflo(a.x); acc[ai][bj][m][0][1] *= bfhi(a.x); acc[ai][bj][m][0][2] *= bflo(a.y); acc[ai][bj][m][0][3] *= bfhi(a.y);
                    acc[ai][bj][m][1][0] *= bflo(a.z); acc[ai][bj][m][1][1] *= bfhi(a.z); acc[ai][bj][m][1][2] *= bflo(a.w); acc[ai][bj][m][1][3] *= bfhi(a.w); }
            asm volatile("" ::: "memory");
        }
    }
};
struct MidMul {
    static constexpr bool ON = true;
    const bf16* G;
    __device__ __forceinline__ void operator()(f32x4 (&acc)[2][2][4][2], const Unit& u, int wr, int wc, int fr, int fq) const {
        asm volatile("" : "+v"(fr), "+v"(fq));
        const char* base = (const char*)G + ((size_t)u.pm * 256 * D + (size_t)u.pn * 256) * 2;
        const unsigned lo = (unsigned)((wr * 64 + fr) * D + wc * 32 + 4 * fq) * 2u;
#pragma unroll
        for (int ai = 0; ai < 2; ++ai)
#pragma unroll
            for (int mh = 0; mh < 2; ++mh) {
                u32x2 g[2][2][2];
#pragma unroll
                for (int m2 = 0; m2 < 2; ++m2) { const unsigned ro = lo + (unsigned)((ai * 128 + (2 * mh + m2) * 16) * D) * 2u;
#pragma unroll
                    for (int bj = 0; bj < 2; ++bj)
#pragma unroll
                        for (int n = 0; n < 2; ++n) g[m2][bj][n] = *(const u32x2*)(base + ro + (unsigned)(bj * 128 + n * 16) * 2u); }
#pragma unroll
                for (int m2 = 0; m2 < 2; ++m2)
#pragma unroll
                    for (int bj = 0; bj < 2; ++bj)
#pragma unroll
                        for (int n = 0; n < 2; ++n) { const u32x2 a = g[m2][bj][n]; const int m = 2 * mh + m2; acc[ai][bj][m][n][0] *= bflo(a.x); acc[ai][bj][m][n][1] *= bfhi(a.x); acc[ai][bj][m][n][2] *= bflo(a.y); acc[ai][bj][m][n][3] *= bfhi(a.y); }
                asm volatile("" ::: "memory");
            }
    }
};
}

struct KArgs { const float* in[27]; float* out; unsigned char* ws; int ph_lo, ph_hi, dbg, pad; };
enum { I_X = 0, I_P, I_WIN, I_BIN, I_SGG, I_SGB, I_WS, I_BS, I_MHG, I_WPA, I_WPB, I_WOUT, I_LN1G, I_LN1B, I_WR, I_BR, I_WGE, I_WUE, I_WDE, I_WGS, I_WUS, I_WDS, I_WPG, I_BPG, I_WP, I_LN2G, I_LN2B };
constexpr int NPH = 12;

struct Ctx {
    LAS unsigned char* lds; int vcu, G;
    float* out; unsigned char* ws;
};
#define WSP(T, off) ((T*)(C.ws + (off)))
#define INP(k) ((const float*)g8::uni_ptr((const char*)(*(const LAS unsigned long long*)(C.lds + LDS_PTRS + 8 * (k)))))
template <class T> __device__ __forceinline__ T* opq_ptr(T* p) { const unsigned long long v = (unsigned long long)p; unsigned lo = __builtin_amdgcn_readfirstlane((unsigned)v), hi = __builtin_amdgcn_readfirstlane((unsigned)(v >> 32));
    asm volatile("" : "+s"(lo), "+s"(hi)); return (T*)(GAS T*)(((unsigned long long)hi << 32) | lo); }
__device__ __forceinline__ int opq_int(int v) { int r = __builtin_amdgcn_readfirstlane(v); asm volatile("" : "+s"(r)); return r; }
#define CTX_LOCAL(Csrc) Ctx C = (Csrc); C.ws = opq_ptr(C.ws); C.out = opq_ptr(C.out); C.vcu = opq_int(C.vcu); C.G = opq_int(C.G)
#define PHASE_IDS() const int tid = fresh_tid(), lane = tid & 63, w = __builtin_amdgcn_readfirstlane(tid >> 6); (void)lane; (void)w

__device__ __forceinline__ void tr_item(const float* src, int ld, bf16* dst, int K, float scale, LAS float* scr, int lane, bool quant = false) {
    float tv[32];
    const char* sb = g8::uni_ptr((const char*)src); const unsigned o0 = (unsigned)((lane >> 5) * ld + (lane & 31)) * 4u;
#pragma unroll
    for (int i = 0; i < 32; ++i) tv[i] = *(const float*)(sb + o0 + (unsigned)(2 * i * ld) * 4u);
#pragma unroll
    for (int i = 0; i < 32; ++i) scr[(2 * i + (lane >> 5)) * 33 + (lane & 31)] = quant ? q8(tv[i] * scale, kf(256.f), kf(1.f / 256.f)) : tv[i] * scale;
    LDS_WAIT(); asm volatile("" ::: "memory");
    const int c = lane & 7;
#pragma unroll
    for (int j = 0; j < 4; ++j) { const int n = (lane >> 3) + 8 * j; const LAS float* s = scr + (8 * c) * 33 + n;
        u32x4 o; o.x = cvt_pk_bf16(s[0 * 33], s[1 * 33]); o.y = cvt_pk_bf16(s[2 * 33], s[3 * 33]);
        o.z = cvt_pk_bf16(s[4 * 33], s[5 * 33]); o.w = cvt_pk_bf16(s[6 * 33], s[7 * 33]);
        *(u32x4*)(dst + (size_t)n * K + 8 * c) = o; }
    LDS_WAIT(); asm volatile("" ::: "memory");
}
__device__ __forceinline__ void tr_item8(const float* src, int ld, unsigned char* dst, int K, float scale, LAS float* scr, int lane, int lanecol = -1) {
    const char* sb = g8::uni_ptr((const char*)src); const unsigned o0 = (unsigned)((lane >> 5) * ld + (lanecol >= 0 ? lanecol : (lane & 31))) * 4u;
#pragma unroll
    for (int hk = 0; hk < 2; ++hk) { float tv[32];
#pragma unroll
        for (int i = 0; i < 32; ++i) tv[i] = __builtin_nontemporal_load((const float*)(sb + o0 + (unsigned)((64 * hk + 2 * i) * ld) * 4u));
#pragma unroll
        for (int i = 0; i < 32; ++i) scr[(64 * hk + 2 * i + (lane >> 5)) * 33 + (lane & 31)] = tv[i] * (scale * kf(256.0f)); }
    LDS_WAIT(); asm volatile("" ::: "memory");
    const int c = lane & 7;
#pragma unroll
    for (int j = 0; j < 4; ++j) { const int n = (lane >> 3) + 8 * j; const LAS float* s = scr + (16 * c) * 33 + n;
        u32x4 o;
#pragma unroll
        for (int q = 0; q < 4; ++q) { int w = __builtin_amdgcn_cvt_pk_fp8_f32(s[(4 * q) * 33], s[(4 * q + 1) * 33], 0, false); w = __builtin_amdgcn_cvt_pk_fp8_f32(s[(4 * q + 2) * 33], s[(4 * q + 3) * 33], w, true); o[q] = (unsigned)w; }
        *(u32x4*)(dst + (size_t)n * K + 16 * c) = o; }
    LDS_WAIT(); asm volatile("" ::: "memory");
}
__device__ __forceinline__ int win_src_col(int dcol) {
    return dcol < 1024 ? dcol : dcol < 2048 ? 3072 + (dcol - 1024) : dcol < 3072 ? 1024 + (dcol - 2048) : dcol < 3584 ? 2048 + (dcol - 3072) : dcol < 4096 ? 2560 + (dcol - 3584)
         : dcol < 5120 ? 4096 + (dcol - 4096) : (((dcol - 5120) >> 3) & 1) ? 6152 + 128 * ((dcol - 5120) >> 8) + 32 * (((dcol - 5120) & 255) >> 6) + 8 * ((((dcol - 5120) & 255) >> 4) & 3) + ((dcol - 5120) & 7)
                                                                        : 5128 + 128 * ((dcol - 5120) >> 8) + 32 * (((dcol - 5120) & 255) >> 6) + 8 * ((((dcol - 5120) & 255) >> 4) & 3) + ((dcol - 5120) & 7);
}
__device__ __forceinline__ void emit_xb_gates(const f32x4 (&v)[4], int m, bf16* XB, float* IFp, const LAS float* wif, const float* bif, int lane) {
    float g[8];
#pragma unroll
    for (int q = 0; q < 8; ++q) g[q] = 0.f;
#pragma unroll
    for (int j = 0; j < 4; ++j) {
        { int w8 = __builtin_amdgcn_cvt_pk_fp8_f32(v[j][0] * 16.f, v[j][1] * 16.f, 0, false); w8 = __builtin_amdgcn_cvt_pk_fp8_f32(v[j][2] * 16.f, v[j][3] * 16.f, w8, true);
          *(int*)((unsigned char*)XB + (size_t)m * D + 256 * j + 4 * lane) = w8; }
#pragma unroll
        for (int e = 0; e < 4; ++e) { const int k = 256 * j + 4 * lane + e; const f32x4 w0 = *(const LAS f32x4*)(wif + k * 8), w1 = *(const LAS f32x4*)(wif + k * 8 + 4); const float x = v[j][e];
            g[0] += x * w0[0]; g[1] += x * w0[1]; g[2] += x * w0[2]; g[3] += x * w0[3]; g[4] += x * w1[0]; g[5] += x * w1[1]; g[6] += x * w1[2]; g[7] += x * w1[3]; }
    }
#pragma unroll
    for (int q = 0; q < 8; ++q) g[q] = wave_sum(g[q]);
    if (lane == 0) { *(f32x4*)(IFp + (size_t)m * 8) = (f32x4){g[0] + bif[0], g[1] + bif[1], g[2] + bif[2], g[3] + bif[3]}; *(f32x4*)(IFp + (size_t)m * 8 + 4) = (f32x4){g[4] + bif[4], g[5] + bif[5], g[6] + bif[6], g[7] + bif[7]}; }
}
__device__ __forceinline__ void load_wif(const Ctx& C0, int l, LAS float* wif) {
    CTX_LOCAL(C0);
    const float* win = INP(I_WIN) + (size_t)l * D * DIN;
    for (int i = fresh_tid(); i < 1024 * 8; i += 512) wif[i] = win[(size_t)(i >> 3) * DIN + 5120 + (i & 7)];
    __syncthreads();
}
__device__ __forceinline__ void phase_convert(const Ctx& C0, int l, bool with_x0) {
    CTX_LOCAL(C0);
    PHASE_IDS();
    const int gw = C.vcu * 8 + w, NGW = C.G * 8;
    LAS float* scr = (LAS float*)(C.lds + w * 16896);
    const float* win = INP(I_WIN) + (size_t)l * D * DIN;
    bf16* WinT = WSP(bf16, WS_WIN); bf16* W4 = WSP(bf16, WS_W4); bf16* UpT = WSP(bf16, WS_UPT); bf16* DnT = WSP(bf16, WS_DNT); bf16* WpT = WSP(bf16, WS_WPT);
    constexpr int N0 = 1792, N1 = 768 + 256, N2 = 65 * 128, N3 = 64 * 64 + 64, N4 = 64, NIT = N0 + N1 + N2 + N3 + N4;
    LAS float* scr8 = scr;
    for (int it = gw; it < NIT; it += NGW) {
        int r = it;
        if (r < N0) { const int kb = r / 224, nb = r % 224, dcol = 32 * nb; const int sc = win_src_col(dcol); const float sq = (dcol >= ZQ && dcol < ZK) ? kf(QSCALE) : 1.0f;
            tr_item8(win + (size_t)(128 * kb) * DIN, DIN, (unsigned char*)WinT + (size_t)dcol * D + 128 * kb, D, sq, scr8, lane, win_src_col(dcol + (lane & 31))); (void)sc; continue; }
        r -= N0;
        if (r < N1) {
            if (r < 512) { const int which = r >> 8, rr = r & 255, kb = rr >> 5, nb = rr & 31;
                tr_item8((which == 0 ? INP(I_WPA) : INP(I_WPB)) + (size_t)l * D * D + (size_t)(128 * kb) * D + 32 * nb, D, (unsigned char*)W4 + (size_t)(32 * nb) * 2048 + which * 1024 + 128 * kb, 2048, 1.0f, scr, lane); }
            else if (r < 768) { const int rr = r - 512, kb = rr >> 5, nb = rr & 31;
                tr_item8(INP(I_WOUT) + (size_t)l * D * D + (size_t)(128 * kb) * D + 32 * nb, D, (unsigned char*)(W4 + (size_t)2 * D * D) + (size_t)(32 * nb) * D + 128 * kb, D, 1.0f, scr, lane); }
            else { const int rr = r - 768, kb = rr >> 5, nb = rr & 31;
                tr_item8(INP(I_WPG) + (size_t)l * D * D + (size_t)(128 * kb) * D + 32 * nb, D, (unsigned char*)(W4 + (size_t)3 * D * D) + (size_t)(32 * nb) * D + 128 * kb, D, 1.0f, scr, lane); }
            continue; }
        r -= N1;
        if (r < N2) { const int e = r >> 7, rr = r & 127, isup = rr >> 6, r2 = rr & 63, kb = r2 >> 3, cb = r2 & 7;
            const float* src = e < 64 ? ((isup ? INP(I_WUE) : INP(I_WGE)) + ((size_t)l * 64 + e) * D * DEXP) : ((isup ? INP(I_WUS) : INP(I_WGS)) + (size_t)l * D * DEXP);
            const int drow = (cb >> 2) * 256 + isup * 128 + (cb & 3) * 32;
            tr_item8(src + (size_t)(128 * kb) * DEXP + 32 * cb, DEXP, (unsigned char*)UpT + ((size_t)e * 512 + drow) * D + 128 * kb, D, 1.0f, scr, lane); continue; }
        r -= N2;
        if (r < N3) {
            if (r < 64 * 64) { const int e = r >> 6, rr = r & 63, kb = rr >> 5, nb = rr & 31;
                tr_item8(INP(I_WDE) + ((size_t)l * 64 + e) * DEXP * D + (size_t)(128 * kb) * D + 32 * nb, D, (unsigned char*)DnT + (size_t)e * D * DEXP + (size_t)(32 * nb) * DEXP + 128 * kb, DEXP, 1.0f, scr, lane); }
            else { const int rr = r - 64 * 64, kb = rr >> 5, nb = rr & 31;
                tr_item8(INP(I_WDS) + (size_t)l * DEXP * D + (size_t)(128 * kb) * D + 32 * nb, D, (unsigned char*)WpT + (size_t)(32 * nb) * 512 + 256 + 128 * kb, 512, 1.0f, scr, lane); }
            continue; }
        r -= N3;
        { const int kb = r >> 5, nb = r & 31; const float* src = INP(I_WP) + (size_t)l * PD * D;
            tr_item8(src + (size_t)(128 * kb) * D + 32 * nb, D, (unsigned char*)WpT + (size_t)(32 * nb) * 512 + 128 * kb, 512, 1.0f, scr, lane); }
    }
    const int gt = C.vcu * 512 + tid, NGT = C.G * 512;
    {
        float* b1 = WSP(float, WS_BIAS1); const float* bin = INP(I_BIN) + (size_t)l * DIN;
        for (int j = gt; j < ZW; j += NGT) b1[j] = bin[win_src_col(j)] * ((j >= ZQ && j < ZK) ? kf(QSCALE) : 1.0f);
        bf16* wsb = WSP(bf16, WS_WSB); const float* wsf = INP(I_WS) + (size_t)l * 8 * 128 * 128;
        for (int j = gt; j < 8 * 128 * 128; j += NGT) { const int t = (j >> 7) & 127, s = j & 127; wsb[j] = ((s >> 6) <= (t >> 6)) ? f2bf(wsf[j]) : (bf16)0; }
    }
    if (with_x0) {
        __syncthreads();
        LAS float* wif = (LAS float*)C.lds;
        load_wif(C, 0, wif);
        const float* bif = INP(I_BIN) + 5120;
        for (int m = gw; m < M; m += NGW) { f32x4 v[4];
#pragma unroll
            for (int j = 0; j < 4; ++j) v[j] = *(const f32x4*)(INP(I_X) + (size_t)m * D + 256 * j + 4 * lane);
            emit_xb_gates(v, m, WSP(bf16, WS_XB), WSP(float, WS_IF), wif, bif, lane); }
    }
}

__device__ __forceinline__ void convert_pb(const Ctx& C0, int l) {
    CTX_LOCAL(C0);
    const int gt = C.vcu * 512 + fresh_tid(), NGT = C.G * 512;
    const f32x4* p4 = (const f32x4*)(INP(I_P) + (size_t)l * M * PD); unsigned char* o = WSP(unsigned char, WS_PBH);
    for (int j = gt; j < M * PD / 16; j += NGT) { const f32x4 a = __builtin_nontemporal_load(p4 + 4 * j), b = __builtin_nontemporal_load(p4 + 4 * j + 1), c = __builtin_nontemporal_load(p4 + 4 * j + 2), d = __builtin_nontemporal_load(p4 + 4 * j + 3);
        *(u32x4*)(o + (size_t)(j >> 4) * 512 + (j & 15) * 16) = (u32x4){pk4_fp8x16(a[0], a[1], a[2], a[3]), pk4_fp8x16(b[0], b[1], b[2], b[3]), pk4_fp8x16(c[0], c[1], c[2], c[3]), pk4_fp8x16(d[0], d[1], d[2], d[3])}; }
}
__device__ __forceinline__ void phase_gates(const Ctx& C0) {
    CTX_LOCAL(C0);
    PHASE_IDS();
    const int gw = C.vcu * 8 + w, NGW = C.G * 8;
    const float* IFp = WSP(float, WS_IF); float* BC = WSP(float, WS_BC); float* BL = WSP(float, WS_BL); float* GM = WSP(float, WS_GM);
    for (int task = gw; task < 32 * NCH; task += NGW) {
        const int bh = task >> 7, c = task & 127, b = bh >> 2, h = bh & 3; const size_t m = (size_t)b * SEQ + 64 * c + lane;
        const float ip = IFp[m * 8 + h], fp = IFp[m * 8 + 4 + h];
        const float lf = fminf(fp, 0.f) - __builtin_amdgcn_logf(1.0f + __builtin_amdgcn_exp2f(-fabsf(fp) * kf(1.4426950408889634f))) * kf(0.6931471805599453f);
        float v = lf;
#pragma unroll
        for (int o = 1; o < 64; o <<= 1) { const float t = shfl_idx(v, lane - o); if (lane >= o) v += t; }
        const float blast = rdlane(v, 63);
        const float gmax = wave_max(blast - v + ip);
        BC[m * 4 + h] = v;
        if (lane == 0) { BL[task] = blast; GM[task] = gmax; }
    }
}
__device__ __forceinline__ void mstate(const float* BL, const float* GM, int bh, int c, int lane, float& mc, float& mn) {
    const float bl0 = BL[bh * 128 + lane], bl1 = BL[bh * 128 + 64 + lane], gm0 = GM[bh * 128 + lane], gm1 = GM[bh * 128 + 64 + lane];
    float m = 0.f, prev = 0.f;
    for (int cc = 0; cc <= c; ++cc) {
        const float bl = __shfl(cc < 64 ? bl0 : bl1, cc & 63), gm = __shfl(cc < 64 ? gm0 : gm1, cc & 63);
        prev = m; m = fmaxf(bl + m, gm);
    }
    mc = prev; mn = m;
}

__device__ __forceinline__ void phase_sgu(const Ctx& C0, int l) {
    CTX_LOCAL(C0);
    PHASE_IDS();
    const unsigned char* Z8 = WSP(unsigned char, WS_Z); const float* VP = WSP(float, WS_VPART); unsigned char* AB8 = (unsigned char*)C.out;
    constexpr int PW = 272;
    LAS unsigned char* Wt = C.lds; LAS unsigned char* Vn = C.lds + 128 * PW; LAS float* Dt = (LAS float*)(C.lds + 2 * 128 * PW);
    LAS f32x2* Sst = (LAS f32x2*)(C.lds + 2 * 128 * PW + 128 * 132 * 4);
#define SGU_STATS(mrow, slot) do { if (tid < 128) { const f32x4* p_ = (const f32x4*)(VP + ((mrow) + tid) * 32); float s1_ = 0.f, s2_ = 0.f; \
        _Pragma("unroll") for (int k_ = 0; k_ < 8; ++k_) { const f32x4 q_ = p_[k_]; s1_ += q_[0] + q_[2]; s2_ += q_[1] + q_[3]; } \
        const float mean_ = s1_ * (1.0f / 1024.0f), var_ = fmaxf(s2_ * (1.0f / 1024.0f) - mean_ * mean_, 0.f); Sst[(slot) * 128 + tid] = (f32x2){mean_, __builtin_amdgcn_rsqf(var_ + kf(LN_EPS))}; } } while (0)
    const int ch = tid & 7, r0 = tid >> 3;
    const int chw = tid & 15, rw = tid >> 4;
    int gcur = -1; f32x4 gg[4], bb[4]; float bt[2];
    u32x4 pv[2]; int it = 0;
    int u = C.vcu;
    if (u < 4096) { const size_t m0 = (size_t)(u >> 3) * 128; const int g = u & 7;
#pragma unroll
        for (int i = 0; i < 2; ++i) pv[i] = *(const u32x4*)(Z8 + (m0 + r0 + 64 * i) * Z8W + ZV + 128 * g + 16 * ch);
        SGU_STATS(m0, 0); }
    __syncthreads();
    for (; u < 4096; u += C.G, ++it) {
        const int g = u & 7; const size_t m0 = (size_t)(u >> 3) * 128;
        if (g != gcur) {
            if (gcur >= 0) __syncthreads();
            gcur = g;
            const bf16* wsb = WSP(bf16, WS_WSB) + (size_t)g * 128 * 128;
#pragma unroll
            for (int i = 0; i < 4; ++i) *(LAS u32x4*)(Wt + (rw + 32 * i) * PW + chw * 16) = *(const u32x4*)(wsb + (rw + 32 * i) * 128 + chw * 8);
            const float* lng = INP(I_SGG) + (size_t)l * 1024 + 128 * g; const float* lnb = INP(I_SGB) + (size_t)l * 1024 + 128 * g; const float* bs = INP(I_BS) + (size_t)l * 1024 + 128 * g;
#pragma unroll
            for (int q = 0; q < 4; ++q) { gg[q] = *(const f32x4*)(lng + 16 * ch + 4 * q); bb[q] = *(const f32x4*)(lnb + 16 * ch + 4 * q); }
#pragma unroll
            for (int i = 0; i < 2; ++i) bt[i] = bs[r0 + 64 * i];
        }
#pragma unroll
        for (int i = 0; i < 2; ++i) { const f32x2 st = Sst[(it & 1) * 128 + r0 + 64 * i]; float x[16]; un16_fp8x16(pv[i], x);
#pragma unroll
            for (int q = 0; q < 4; ++q)
#pragma unroll
                for (int j = 0; j < 4; ++j) x[4 * q + j] = (x[4 * q + j] - st.x) * st.y * gg[q][j] + bb[q][j];
            bf16x16_to_lds(Vn + (r0 + 64 * i) * PW + ch * 32, x); }
        __syncthreads();
        const int un = u + C.G;
        if (un < 4096) { const size_t mn = (size_t)(un >> 3) * 128; const int gn = un & 7;
#pragma unroll
            for (int i = 0; i < 2; ++i) pv[i] = *(const u32x4*)(Z8 + (mn + r0 + 64 * i) * Z8W + ZV + 128 * gn + 16 * ch);
            SGU_STATS(mn, (it + 1) & 1); }
        u32x4 pu[2];
#pragma unroll
        for (int i = 0; i < 2; ++i) pu[i] = *(const u32x4*)(Z8 + (m0 + r0 + 64 * i) * Z8W + ZU + 128 * g + 16 * ch);
        f32x4 acc[8];
#pragma unroll
        for (int j = 0; j < 8; ++j) acc[j] = (f32x4){0.f, 0.f, 0.f, 0.f};
#pragma unroll
        for (int ks = 0; ks < 4; ++ks) { const bf16x8 a = frag_row(Wt, PW, 16 * w, 32 * ks, lane);
#pragma unroll
            for (int j = 0; j < 8; ++j) acc[j] = MFMA16(a, frag_tr(Vn, PW, 32 * ks, 16 * j, lane), acc[j]); }
#pragma unroll
        for (int j = 0; j < 8; ++j)
#pragma unroll
            for (int r = 0; r < 4; ++r) Dt[(16 * w + 4 * (lane >> 4) + r) * 132 + 16 * j + (lane & 15)] = acc[j][r];
        __syncthreads();
#pragma unroll
        for (int i = 0; i < 2; ++i) { const int t = r0 + 64 * i; const float bq = bt[i]; float uu[16]; un16_fp8x16(pu[i], uu); u32x4 o;
#pragma unroll
            for (int q = 0; q < 4; ++q) { const f32x4 d = *(const LAS f32x4*)(Dt + t * 132 + 16 * ch + 4 * q);
                o[q] = pk4_fp8x16(uu[4 * q] * (d[0] + bq), uu[4 * q + 1] * (d[1] + bq), uu[4 * q + 2] * (d[2] + bq), uu[4 * q + 3] * (d[3] + bq)); }
            *(u32x4*)(AB8 + (m0 + t) * 2048 + 128 * g + 16 * ch) = o; }
    }
    __syncthreads();
#undef SGU_STATS
}

__device__ __forceinline__ void phase_kv(const Ctx& C0) {
    CTX_LOCAL(C0);
    PHASE_IDS();
    const unsigned char* Z8 = WSP(unsigned char, WS_Z); const float* IFp = WSP(float, WS_IF); const float* BC = WSP(float, WS_BC); const float* BL = WSP(float, WS_BL); const float* GM = WSP(float, WS_GM);
    constexpr int PV = 528, PK = 272, PO = 144;
    LAS unsigned char* Vs = C.lds; LAS unsigned char* Ks = C.lds + 64 * PV; LAS unsigned char* Ot = C.lds + 64 * PV + 64 * PK;
    const int sv = tid >> 4, chv = tid & 15, sk = tid >> 3, chk = tid & 7;
    u32x4 pv[2], pk; float pbc, pif;
    int u = C.vcu;
    if (u < 4096) { const int bh = u >> 7, c = u & 127, b = bh >> 2, h = bh & 3; const size_t m0 = (size_t)b * SEQ + 64 * c;
#pragma unroll
        for (int i = 0; i < 2; ++i) pv[i] = *(const u32x4*)(Z8 + (m0 + sv + 32 * i) * Z8W + ZVM + 256 * h + 16 * chv);
        pk = *(const u32x4*)(Z8 + (m0 + sk) * Z8W + ZK + 128 * h + 16 * chk); pbc = BC[(m0 + sk) * 4 + h]; pif = IFp[(m0 + sk) * 8 + h]; }
    for (; u < 4096; u += C.G) {
        const int bh = u >> 7, c = u & 127;
        unsigned char* ST = WSP(unsigned char, WS_STATE) + (size_t)u * 32768; float* NK = WSP(float, WS_NK) + (size_t)u * 128;
        float mc, mn; mstate(BL, GM, bh, c, lane, mc, mn);
        const float blast = BL[u];
#pragma unroll
        for (int i = 0; i < 2; ++i) { float x[16]; un16_fp8x16(pv[i], x); bf16x16_to_lds(Vs + (sv + 32 * i) * PV + chv * 32, x); }
        { const float wgt = expf(blast - pbc + pif - mn); float x[16]; un16_fp8x16(pk, x);
#pragma unroll
          for (int j = 0; j < 16; ++j) x[j] *= wgt;
          bf16x16_to_lds(Ks + sk * PK + chk * 32, x); }
        __syncthreads();
        const int un = u + C.G;
        if (un < 4096) { const int bhn = un >> 7, cn = un & 127, bn = bhn >> 2, hn = bhn & 3; const size_t mn0 = (size_t)bn * SEQ + 64 * cn;
#pragma unroll
            for (int i = 0; i < 2; ++i) pv[i] = *(const u32x4*)(Z8 + (mn0 + sv + 32 * i) * Z8W + ZVM + 256 * hn + 16 * chv);
            pk = *(const u32x4*)(Z8 + (mn0 + sk) * Z8W + ZK + 128 * hn + 16 * chk); pbc = BC[(mn0 + sk) * 4 + hn]; pif = IFp[(mn0 + sk) * 8 + hn]; }
        if (tid < 128) { float sm = 0.f;
#pragma unroll
            for (int r = 0; r < 64; ++r) sm += bf2f(*(const LAS bf16*)(Ks + r * PK + tid * 2));
            NK[tid] = sm; }
        f32x4 acc[2][8];
#pragma unroll
        for (int i = 0; i < 2; ++i)
#pragma unroll
            for (int j = 0; j < 8; ++j) acc[i][j] = (f32x4){0.f, 0.f, 0.f, 0.f};
#pragma unroll
        for (int ks = 0; ks < 2; ++ks) {
            bf16x8 bfr[8];
#pragma unroll
            for (int j = 0; j < 8; ++j) bfr[j] = frag_tr(Ks, PK, 32 * ks, 16 * j, lane);
#pragma unroll
            for (int i = 0; i < 2; ++i) { const bf16x8 a = frag_tr(Vs, PV, 32 * ks, 32 * w + 16 * i, lane);
#pragma unroll
                for (int j = 0; j < 8; ++j) acc[i][j] = MFMA16(a, bfr[j], acc[i][j]); }
        }
#pragma unroll
        for (int i = 0; i < 2; ++i)
#pragma unroll
            for (int j = 0; j < 8; ++j) { const unsigned pw = pk4_fp8x4(acc[i][j][0], acc[i][j][1], acc[i][j][2], acc[i][j][3]);
#pragma unroll
                for (int r = 0; r < 4; ++r) *(LAS unsigned char*)(Ot + (32 * w + 16 * i + 4 * (lane >> 4) + r) * PO + 16 * j + (lane & 15)) = (unsigned char)(pw >> (8 * r)); }
        __syncthreads();
#pragma unroll
        for (int i = 0; i < 4; ++i) { const int idx = tid + 512 * i, v = idx >> 3, chq = idx & 7;
            *(u32x4*)(ST + v * 128 + 16 * chq) = *(const LAS u32x4*)(Ot + v * PO + chq * 16); }
    }
    __syncthreads();
}

__device__ __forceinline__ void phase_kvchain(const Ctx& C0) {
    CTX_LOCAL(C0);
    PHASE_IDS();
    const unsigned char* Z8 = WSP(unsigned char, WS_Z); const float* IFp = WSP(float, WS_IF); const float* BC = WSP(float, WS_BC);
    constexpr int PK = 272, PVS = 80, BUF = 64 * PK + 64 * PVS;
    const int sk = tid >> 3, chk = tid & 7;
    const int svr = (tid >> 1) & 63, svh = tid & 1;
    const int vi = w & 1, dj = 2 * (w >> 1);
    unsigned one2 = 0x41804180u; asm volatile("" : "+v"(one2));
    const bf16x8 ones = __builtin_bit_cast(bf16x8, (u32x4){one2, one2, one2, one2});
    __syncthreads();
    for (int item = C.vcu; item < 256; item += C.G) {
        const int bh = item >> 3, vs = item & 7, b = bh >> 2, h = bh & 3;
        const float* BL = WSP(float, WS_BL) + bh * 128; const float* GM = WSP(float, WS_GM) + bh * 128; float* MS = WSP(float, WS_MS) + bh * 129;
        unsigned char* ST = WSP(unsigned char, WS_STATE) + (size_t)bh * 128 * 32768 + (size_t)(32 * vs + 16 * vi + (lane & 15)) * 128 + 16 * dj + 4 * (lane >> 4);
        float* NK = WSP(float, WS_NK) + (size_t)bh * 128 * 128 + 16 * dj + 4 * (lane >> 4);
        const unsigned char* zk = Z8 + ((size_t)b * SEQ + sk) * Z8W + ZK + 128 * h + 16 * chk;
        const unsigned char* zv = Z8 + ((size_t)b * SEQ + svr) * Z8W + ZVM + 256 * h + 32 * vs + 16 * svh;
        const float* bcp = BC + ((size_t)b * SEQ + sk) * 4 + h; const float* ifp = IFp + ((size_t)b * SEQ + sk) * 8 + h;
        const float bl0 = BL[lane], bl1 = BL[64 + lane], gm0 = GM[lane], gm1 = GM[64 + lane];
        u32x4 rk[2], rv[2]; float rbc[2], rif[2]; rv[0] = rv[1] = (u32x4){0u, 0u, 0u, 0u};
        float mrun = 0.f, dcur = 0.f, dnxt = 0.f;
        f32x4 Cst[2] = {(f32x4){0.f, 0.f, 0.f, 0.f}, (f32x4){0.f, 0.f, 0.f, 0.f}}, Nst[2] = {(f32x4){0.f, 0.f, 0.f, 0.f}, (f32x4){0.f, 0.f, 0.f, 0.f}};
#define KVC_LOAD(R, c_) do { const size_t o_ = (size_t)(c_) * 64; rk[R] = *(const u32x4*)(zk + o_ * Z8W); if (tid < 128) rv[R] = *(const u32x4*)(zv + o_ * Z8W); rbc[R] = bcp[o_ * 4]; rif[R] = ifp[o_ * 8]; } while (0)
#define KVC_PREP(R, c_, decv) do { const int ci_ = (c_); const float bl_ = rdlane(ci_ < 64 ? bl0 : bl1, ci_ & 63), gm_ = rdlane(ci_ < 64 ? gm0 : gm1, ci_ & 63); \
            const float mn_ = fmaxf(bl_ + mrun, gm_); decv = fast_exp(bl_ + mrun - mn_); if (vs == 0 && tid == 0) MS[ci_] = mrun; mrun = mn_; \
            LAS unsigned char* kb_ = C.lds + (ci_ & 1) * BUF; \
            { const float wgt_ = fast_exp(bl_ - rbc[R] + rif[R] - mn_) * (1.0f / 256.0f); float x_[16]; un16_fp8raw(rk[R], x_); _Pragma("unroll") for (int j_ = 0; j_ < 16; ++j_) x_[j_] *= wgt_; bf16x16_to_lds(kb_ + sk * PK + chk * 32, x_); } \
            if (tid < 128) { float x_[16]; un16_fp8raw(rv[R], x_); bf16x16_to_lds(kb_ + 64 * PK + svr * PVS + svh * 32, x_); } } while (0)
#define KVC_STEP(cc_, R) do { const int cc = (cc_); \
            if (cc + 1 < 128) { KVC_PREP(R, cc + 1, dnxt); if (cc + 3 < 128) KVC_LOAD(R, cc + 3); } \
            const LAS unsigned char* kb = C.lds + (cc & 1) * BUF; const LAS unsigned char* vb = kb + 64 * PK; \
            f32x4 kv_[2] = {(f32x4){0.f, 0.f, 0.f, 0.f}, (f32x4){0.f, 0.f, 0.f, 0.f}}, nn_[2] = {(f32x4){0.f, 0.f, 0.f, 0.f}, (f32x4){0.f, 0.f, 0.f, 0.f}}; \
            _Pragma("unroll") for (int ks = 0; ks < 2; ++ks) { const bf16x8 bv = frag_tr(vb, PVS, 32 * ks, 16 * vi, lane); \
                _Pragma("unroll") for (int j = 0; j < 2; ++j) { const bf16x8 ak = frag_tr(kb, PK, 32 * ks, 16 * (dj + j), lane); kv_[j] = MFMA16(ak, bv, kv_[j]); if (vi == 0) nn_[j] = MFMA16(ak, ones, nn_[j]); } } \
            _Pragma("unroll") for (int j = 0; j < 2; ++j) { Cst[j] = Cst[j] * dcur + kv_[j]; *(unsigned*)(ST + (size_t)cc * 32768 + 16 * j) = pk4_fp8x4(Cst[j][0], Cst[j][1], Cst[j][2], Cst[j][3]); } \
            if (vi == 0) { _Pragma("unroll") for (int j = 0; j < 2; ++j) { Nst[j] = Nst[j] * dcur + nn_[j]; if (vs == 0 && (lane & 15) == 0) *(f32x4*)(NK + cc * 128 + 16 * j) = Nst[j]; } } \
            __syncthreads(); dcur = dnxt; } while (0)
        KVC_LOAD(0, 0);
        KVC_PREP(0, 0, dcur);
        KVC_LOAD(1, 1); KVC_LOAD(0, 2);
        __syncthreads();
#pragma unroll 1
        for (int c = 0; c < 128; c += 2) { KVC_STEP(c, 1); KVC_STEP(c + 1, 0); }
#undef KVC_LOAD
#undef KVC_PREP
#undef KVC_STEP
    }
}

__device__ __forceinline__ void phase_scan(const Ctx& C0, bool dry = false) {
    CTX_LOCAL(C0);
    for (int gt = C.vcu * 512 + fresh_tid(); gt < 32 * 4096; gt += C.G * 512) {
    const int bh = gt >> 12, e8 = gt & 4095;
    const float* BL = WSP(float, WS_BL) + bh * 128; const float* GM = WSP(float, WS_GM) + bh * 128; float* MS = WSP(float, WS_MS) + bh * 129;
    unsigned char* ST = WSP(unsigned char, WS_STATE) + (size_t)bh * 128 * 32768 + (size_t)e8 * 8; float* NK = WSP(float, WS_NK) + (size_t)bh * 128 * 128 + e8;
    float st[8]; float m = 0.f, nst = 0.f;
#pragma unroll
    for (int j = 0; j < 8; ++j) st[j] = 0.f;
    for (int c0 = 0; c0 < 128; c0 += 16) {
        u32x2 kv[16]; float nk[16];
#pragma unroll
        for (int i = 0; i < 16; ++i) { kv[i] = *(const u32x2*)(ST + (size_t)(c0 + i) * 32768); nk[i] = e8 < 128 ? NK[(c0 + i) * 128] : 0.f; }
#pragma unroll
        for (int i = 0; i < 16; ++i) { const int c = c0 + i; const float bl = BL[c], gm = GM[c]; const float mn = fmaxf(bl + m, gm), dec = expf(bl + m - mn);
            if (e8 == 0 && !dry) MS[c] = m;
            m = mn;
            const f32x4 k0 = un4_fp8x4(kv[i].x), k1 = un4_fp8x4(kv[i].y);
            st[0] = dec * st[0] + k0[0]; st[1] = dec * st[1] + k0[1]; st[2] = dec * st[2] + k0[2]; st[3] = dec * st[3] + k0[3];
            st[4] = dec * st[4] + k1[0]; st[5] = dec * st[5] + k1[1]; st[6] = dec * st[6] + k1[2]; st[7] = dec * st[7] + k1[3];
            const u32x2 o = (u32x2){pk4_fp8x4(st[0], st[1], st[2], st[3]), pk4_fp8x4(st[4], st[5], st[6], st[7])};
            if (dry) *(u32x2*)(WSP(unsigned char, WS_XB) + (size_t)bh * 1048576 + (size_t)(c & 31) * 32768 + (size_t)e8 * 8) = o; else *(u32x2*)(ST + (size_t)c * 32768) = o;
            if (e8 < 128) { nst = dec * nst + nk[i]; if (!dry) NK[c * 128] = nst; } }
    }
    }
}

__device__ __forceinline__ void phase_mlstm(const Ctx& C0, int l) {
    CTX_LOCAL(C0);
    PHASE_IDS();
    const unsigned char* Z8 = WSP(unsigned char, WS_Z); const float* IFp = WSP(float, WS_IF); const float* BC = WSP(float, WS_BC); const float* MS = WSP(float, WS_MS); unsigned char* AB8 = (unsigned char*)C.out;
    constexpr int PQ = 144, PV = 528, PC = 144, PP = 144;
    constexpr int OQ = 0, OK_ = 64 * PQ, OC = OK_ + 64 * PQ, OV = OC + 256 * PC, OP = OV + 64 * PV, OS = OP + 64 * PP;
    LAS unsigned char* Qs = C.lds + OQ; LAS unsigned char* Ks = C.lds + OK_; LAS unsigned char* Vs = C.lds + OV; LAS unsigned char* Cs = C.lds + OC; LAS unsigned char* Ps = C.lds + OP;
    LAS float* sA = (LAS float*)(C.lds + OS); LAS float* sPM = sA + 64; LAS float* sWI = sA + 128; LAS float* sEN = sA + 192; LAS float* sDN = sA + 256; LAS float* sN = sA + 320;
    constexpr int PH = 528;
    LAS unsigned char* Hs = C.lds + OS + 6144;
    LAS float* sG = (LAS float*)(C.lds + OS + 2048);
    { const float* mg_ = INP(I_MHG) + (size_t)l * 1024; for (int i = tid; i < 1024; i += 512) sG[i] = mg_[i]; }
    const int sq = tid >> 3, chq = tid & 7, sv = tid >> 4, chv = tid & 15;
    const int sc = tid >> 3, chc = tid & 7;
    u32x4 pq, pk, pv[2], pc[4]; float pn = 0.f, pbc = 0.f, pip = 0.f, pmc = 0.f;
#define MLSTM_PREFETCH(uu) do { const int bh_ = (uu) >> 7, c_ = (uu) & 127, b_ = bh_ >> 2, h_ = bh_ & 3; const size_t m_ = (size_t)b_ * SEQ + 64 * c_; \
        const unsigned char* st_ = WSP(unsigned char, WS_STATE) + (size_t)((uu) - 1) * 32768; \
        pq = *(const u32x4*)(Z8 + (m_ + sq) * Z8W + ZQ + 128 * h_ + 16 * chq); pk = *(const u32x4*)(Z8 + (m_ + sq) * Z8W + ZK + 128 * h_ + 16 * chq); \
        _Pragma("unroll") for (int i = 0; i < 2; ++i) pv[i] = *(const u32x4*)(Z8 + (m_ + sv + 32 * i) * Z8W + ZVM + 256 * h_ + 16 * chv); \
        _Pragma("unroll") for (int i = 0; i < 4; ++i) { pc[i] = (u32x4){0u, 0u, 0u, 0u}; if (c_ > 0) pc[i] = *(const u32x4*)(st_ + (sc + 64 * i) * 128 + 16 * chc); } \
        pn = (c_ > 0 && tid < 128) ? WSP(float, WS_NK)[(size_t)((uu) - 1) * 128 + (tid & 127)] : 0.f; \
        pbc = BC[(m_ + lane) * 4 + h_]; pip = IFp[(m_ + lane) * 8 + h_]; pmc = MS[bh_ * 129 + c_]; } while (0)
#define MLSTM_FILL() do { const float mc_ = pmc; \
        *(LAS u32x4*)(Qs + sq * PQ + chq * 16) = pq; *(LAS u32x4*)(Ks + sq * PQ + chq * 16) = pk; \
        _Pragma("unroll") for (int i = 0; i < 2; ++i) { float x[16]; un16_fp8x16(pv[i], x); bf16x16_to_lds(Vs + (sv + 32 * i) * PV + chv * 32, x); } \
        _Pragma("unroll") for (int i = 0; i < 4; ++i) *(LAS u32x4*)(Cs + (sc + 64 * i) * PC + chc * 16) = pc[i]; \
        if (tid < 128) sN[tid] = pn; \
        if (w == 0) { const float a = pip - pbc; float pm = a; \
            _Pragma("unroll") for (int o = 1; o < 64; o <<= 1) { const float t = shfl_idx(pm, lane - o); if (lane >= o) pm = fmaxf(pm, t); } \
            pm = fmaxf(pm, mc_); sA[lane] = a; sPM[lane] = pm; sWI[lane] = fast_exp(mc_ - pm); sEN[lane] = fast_exp(-pbc - pm); } } while (0)
    int u = C.vcu;
    if (u < 4096) { MLSTM_PREFETCH(u); MLSTM_FILL(); if (u + C.G < 4096) MLSTM_PREFETCH(u + C.G); }
    __syncthreads();
    for (; u < 4096; u += C.G) {
        const int bh = u >> 7, c = u & 127, b = bh >> 2, h = bh & 3; const size_t m0 = (size_t)b * SEQ + 64 * c; (void)c;
        const LAS float* mhg = sG + 256 * h;
        const int tf = tid >> 3, part = tid & 7;
        u32x4 po[2];
#pragma unroll
        for (int k8 = 0; k8 < 2; ++k8) po[k8] = *(const u32x4*)(Z8 + (m0 + tf) * Z8W + ZO + 256 * h + part * 32 + 16 * k8);
        {
            const int ti = w >> 1; f32x4 sa[2] = {(f32x4){0.f, 0.f, 0.f, 0.f}, (f32x4){0.f, 0.f, 0.f, 0.f}};
#pragma unroll
            for (int ks = 0; ks < 4; ++ks) { const long a = frag8(Qs, PQ, 16 * ti, 32 * ks, lane);
#pragma unroll
                for (int j = 0; j < 2; ++j) sa[j] = MFMA8(a, frag8(Ks, PQ, 16 * (2 * (w & 1) + j), 32 * ks, lane), sa[j]); }
#pragma unroll
            for (int j = 0; j < 2; ++j) { const int sc = 16 * (2 * (w & 1) + j) + (lane & 15); const float as = sA[sc];
#pragma unroll
                for (int r = 0; r < 4; ++r) { const int t = 16 * ti + 4 * (lane >> 4) + r; const float p = sc <= t ? sa[j][r] * (fast_exp(as - sPM[t]) * (1.0f / 256.0f)) : 0.f;
                    *(LAS bf16*)(Ps + t * PP + sc * 2) = f2bf(p); } }
        }
        __syncthreads();
        {
            const int t = tf;
            const u32x4 pr = *(const LAS u32x4*)(Ps + t * PP + part * 16);
            float ps = (bflo(pr.x) + bfhi(pr.x)) + (bflo(pr.y) + bfhi(pr.y)) + (bflo(pr.z) + bfhi(pr.z)) + (bflo(pr.w) + bfhi(pr.w));
            float qn = 0.f;
            { float qv[16]; un16_fp8x16(*(const LAS u32x4*)(Qs + t * PQ + part * 16), qv); const LAS float* nn = sN + part * 16;
#pragma unroll
              for (int i = 0; i < 16; ++i) qn += qv[i] * nn[i]; }
            ps = grp8_sum(ps);
            qn = grp8_sum(qn);
            if (part == 0) sDN[t] = fmaxf(fabsf(ps + sWI[t] * qn), sEN[t]);
        }
        f32x4 ac[4][2];
#pragma unroll
        for (int i = 0; i < 4; ++i)
#pragma unroll
            for (int j = 0; j < 2; ++j) ac[i][j] = (f32x4){0.f, 0.f, 0.f, 0.f};
#pragma unroll
        for (int ks = 0; ks < 4; ++ks) { long bc_[2];
#pragma unroll
            for (int j = 0; j < 2; ++j) bc_[j] = frag8(Cs, PC, 32 * w + 16 * j, 32 * ks, lane);
#pragma unroll
            for (int i = 0; i < 4; ++i) { const long a = frag8(Qs, PQ, 16 * i, 32 * ks, lane);
#pragma unroll
                for (int j = 0; j < 2; ++j) ac[i][j] = MFMA8(a, bc_[j], ac[i][j]); } }
#pragma unroll
        for (int i = 0; i < 4; ++i)
#pragma unroll
            for (int r = 0; r < 4; ++r) { const float wi = sWI[16 * i + 4 * (lane >> 4) + r] * (1.0f / 64.0f);
#pragma unroll
                for (int j = 0; j < 2; ++j) ac[i][j][r] *= wi; }
#pragma unroll
        for (int ks = 0; ks < 2; ++ks) { bf16x8 bv[2];
#pragma unroll
            for (int j = 0; j < 2; ++j) bv[j] = frag_tr(Vs, PV, 32 * ks, 32 * w + 16 * j, lane);
#pragma unroll
            for (int i = 0; i < 4; ++i) { const bf16x8 a = frag_row(Ps, PP, 16 * i, 32 * ks, lane);
#pragma unroll
                for (int j = 0; j < 2; ++j) ac[i][j] = MFMA16(a, bv[j], ac[i][j]); } }
#pragma unroll
        for (int i = 0; i < 4; ++i)
#pragma unroll
            for (int r = 0; r < 4; ++r) { const int t = 16 * i + 4 * (lane >> 4) + r;
#pragma unroll
                for (int j = 0; j < 2; ++j) *(LAS bf16*)(Hs + t * PH + (32 * w + 16 * j + (lane & 15)) * 2) = f2bf(ac[i][j][r]); }
        __syncthreads();
        {
            f32x4 hv[8]; float ss = 0.f; const float rd = __builtin_amdgcn_rcpf(sDN[tf]);
#pragma unroll
            for (int k8 = 0; k8 < 4; ++k8) { const u32x4 hq = *(const LAS u32x4*)(Hs + tf * PH + part * 64 + 16 * k8);
                hv[2 * k8] = (f32x4){bflo(hq.x), bfhi(hq.x), bflo(hq.y), bfhi(hq.y)} * rd; hv[2 * k8 + 1] = (f32x4){bflo(hq.z), bfhi(hq.z), bflo(hq.w), bfhi(hq.w)} * rd; }
#pragma unroll
            for (int k4 = 0; k4 < 8; ++k4) ss += hv[k4][0] * hv[k4][0] + hv[k4][1] * hv[k4][1] + hv[k4][2] * hv[k4][2] + hv[k4][3] * hv[k4][3];
            ss = grp8_sum(ss);
            const float rinv = __builtin_amdgcn_rsqf(ss * (1.0f / 256.0f) + kf(RMS_EPS));
#pragma unroll
            for (int k16 = 0; k16 < 2; ++k16) { const int v0 = part * 32 + 16 * k16; float og[16]; un16_fp8x16(po[k16], og); u32x4 o;
#pragma unroll
                for (int q = 0; q < 4; ++q) { const f32x4 gq = *(const LAS f32x4*)(mhg + v0 + 4 * q); const f32x4 xq = hv[4 * k16 + q];
                    o[q] = pk4_fp8x16(og[4 * q] * xq[0] * rinv * gq[0], og[4 * q + 1] * xq[1] * rinv * gq[1], og[4 * q + 2] * xq[2] * rinv * gq[2], og[4 * q + 3] * xq[3] * rinv * gq[3]); }
                *(u32x4*)(AB8 + (m0 + tf) * 2048 + 1024 + 256 * h + v0) = o; }
        }
        if (u + C.G < 4096) { MLSTM_FILL(); if (u + 2 * C.G < 4096) MLSTM_PREFETCH(u + 2 * C.G); }
        __syncthreads();
    }
#undef MLSTM_FILL
#undef MLSTM_PREFETCH
}

__device__ __forceinline__ void phase_ln1_router(const Ctx& C0, int l, bool dry = false) {
    CTX_LOCAL(C0);
    PHASE_IDS();
    bf16* X = WSP(bf16, WS_XR); bf16* XO = dry ? WSP(bf16, WS_GBUF) : X; bf16* XB = WSP(bf16, WS_XB); int* TOKE = WSP(int, WS_TOKE); float* TOKW = WSP(float, WS_TOKW); int* HIST = WSP(int, WS_HIST);
    const float* g1 = INP(I_LN1G) + (size_t)l * D; const float* b1 = INP(I_LN1B) + (size_t)l * D; const float* wr = INP(I_WR) + (size_t)l * D * NE; const float* br = INP(I_BR) + (size_t)l * NE;
    LAS float* Xt = (LAS float*)C.lds;
    LAS float* PART = (LAS float*)(C.lds + 16 * 1028 * 4);
    LAS int* hist = (LAS int*)(C.lds + 16 * 1028 * 4 + 8 * 16 * 64 * 4);
    LAS float* gb = (LAS float*)(C.lds + 16 * 1028 * 4 + 8 * 16 * 64 * 4 + 256);
    for (int i = tid; i < 1024; i += 512) { gb[i] = g1[i]; gb[1024 + i] = b1[i]; }
    __syncthreads();
    const float brl = br[lane];
    bf16x8 bh[4][4], bl[4][4];
#pragma unroll
    for (int ks = 0; ks < 4; ++ks)
#pragma unroll
        for (int et = 0; et < 4; ++et) { float f[8];
#pragma unroll
            for (int j = 0; j < 8; ++j) f[j] = wr[(size_t)(128 * w + 32 * ks + 8 * (lane >> 4) + j) * NE + 16 * et + (lane & 15)];
            u32x4 hh, ll;
#pragma unroll
            for (int q = 0; q < 4; ++q) { const unsigned hp = cvt_pk_bf16(f[2 * q], f[2 * q + 1]); hh[q] = hp; ll[q] = cvt_pk_bf16(f[2 * q] - bflo(hp), f[2 * q + 1] - bfhi(hp)); }
            bh[ks][et] = __builtin_bit_cast(bf16x8, hh); bl[ks][et] = __builtin_bit_cast(bf16x8, ll); }
    for (int blk = C.vcu; blk < M / 256; blk += C.G) {
        if (tid < 64) hist[tid] = 0;
        __syncthreads();
        u32x2 pre[2][4];
#pragma unroll
        for (int rr = 0; rr < 2; ++rr)
#pragma unroll
            for (int j = 0; j < 4; ++j) pre[rr][j] = *(const u32x2*)(X + ((size_t)blk * 256 + 2 * w + rr) * D + 256 * j + 4 * lane);
        for (int bt = 0; bt < 16; ++bt) {
            const size_t mb = (size_t)blk * 256 + bt * 16;
#pragma unroll
            for (int rr = 0; rr < 2; ++rr) { const int row = 2 * w + rr; const size_t m = mb + row; f32x4 v[4]; float s = 0.f;
#pragma unroll
                for (int j = 0; j < 4; ++j) { const u32x2 q = pre[rr][j]; v[j] = (f32x4){bflo(q.x), bfhi(q.x), bflo(q.y), bfhi(q.y)}; s += (v[j][0] + v[j][1]) + (v[j][2] + v[j][3]); }
                const float mean = wave_sum(s) * (1.0f / D); float q = 0.f;
#pragma unroll
                for (int j = 0; j < 4; ++j) { v[j] = v[j] - mean; q += (v[j][0] * v[j][0] + v[j][1] * v[j][1]) + (v[j][2] * v[j][2] + v[j][3] * v[j][3]); }
                const float rstd = __builtin_amdgcn_rsqf(wave_sum(q) * (1.0f / D) + kf(LN_EPS));
#pragma unroll
                for (int j = 0; j < 4; ++j) { const f32x4 y = v[j] * rstd * *(const LAS f32x4*)(gb + 256 * j + 4 * lane) + *(const LAS f32x4*)(gb + 1024 + 256 * j + 4 * lane);
                    { u32x2 o; o.x = cvt_pk_bf16(y[0], y[1]); o.y = cvt_pk_bf16(y[2], y[3]); *(u32x2*)(XO + m * D + 256 * j + 4 * lane) = o; } *(LAS f32x4*)(Xt + row * 1028 + 256 * j + 4 * lane) = y;
                    int w8 = __builtin_amdgcn_cvt_pk_fp8_f32(y[0] * 16.f, y[1] * 16.f, 0, false); w8 = __builtin_amdgcn_cvt_pk_fp8_f32(y[2] * 16.f, y[3] * 16.f, w8, true);
                    *(int*)((unsigned char*)XB + m * D + 256 * j + 4 * lane) = w8; } }
            __syncthreads();
            if (bt + 1 < 16) {
#pragma unroll
                for (int rr = 0; rr < 2; ++rr)
#pragma unroll
                    for (int j = 0; j < 4; ++j) pre[rr][j] = *(const u32x2*)(X + (mb + 16 + 2 * w + rr) * D + 256 * j + 4 * lane); }
            {
                f32x4 acc[4] = {(f32x4){0.f, 0.f, 0.f, 0.f}, (f32x4){0.f, 0.f, 0.f, 0.f}, (f32x4){0.f, 0.f, 0.f, 0.f}, (f32x4){0.f, 0.f, 0.f, 0.f}};
                const LAS float* xa = Xt + (lane & 15) * 1028 + 128 * w + 8 * (lane >> 4);
#pragma unroll
                for (int ks = 0; ks < 4; ++ks) { const f32x4 x0 = *(const LAS f32x4*)(xa + 32 * ks), x1 = *(const LAS f32x4*)(xa + 32 * ks + 4);
                    u32x4 hh, ll;
                    hh[0] = cvt_pk_bf16(x0[0], x0[1]); hh[1] = cvt_pk_bf16(x0[2], x0[3]); hh[2] = cvt_pk_bf16(x1[0], x1[1]); hh[3] = cvt_pk_bf16(x1[2], x1[3]);
                    ll[0] = cvt_pk_bf16(x0[0] - bflo(hh[0]), x0[1] - bfhi(hh[0])); ll[1] = cvt_pk_bf16(x0[2] - bflo(hh[1]), x0[3] - bfhi(hh[1]));
                    ll[2] = cvt_pk_bf16(x1[0] - bflo(hh[2]), x1[1] - bfhi(hh[2])); ll[3] = cvt_pk_bf16(x1[2] - bflo(hh[3]), x1[3] - bfhi(hh[3]));
                    const bf16x8 ah = __builtin_bit_cast(bf16x8, hh), al = __builtin_bit_cast(bf16x8, ll);
#pragma unroll
                    for (int et = 0; et < 4; ++et) { acc[et] = MFMA16(ah, bh[ks][et], acc[et]); acc[et] = MFMA16(ah, bl[ks][et], acc[et]); acc[et] = MFMA16(al, bh[ks][et], acc[et]); } }
#pragma unroll
                for (int et = 0; et < 4; ++et)
#pragma unroll
                    for (int r = 0; r < 4; ++r) PART[(w * 16 + 4 * (lane >> 4) + r) * 64 + 16 * et + (lane & 15)] = acc[et][r];
            }
            __syncthreads();
            {
                const float ninf = kf(-INFINITY); const int grp = lane >> 3;
                float score[2], sel[2], gs[2], cur[2], ssum[2]; int rank[2];
#pragma unroll
                for (int rr = 0; rr < 2; ++rr) { const int row = 2 * w + rr; float lg = 0.f;
#pragma unroll
                    for (int p = 0; p < 8; ++p) lg += PART[(p * 16 + row) * 64 + lane];
                    score[rr] = fast_sigmoid(lg); sel[rr] = score[rr] + brl; }
                float m1[2], s2[2];
#pragma unroll
                for (int rr = 0; rr < 2; ++rr) m1[rr] = grp8_max(sel[rr]);
#pragma unroll
                for (int rr = 0; rr < 2; ++rr) { const unsigned long long bm = __ballot(sel[rr] == m1[rr]); const unsigned gb = (unsigned)(bm >> (8 * grp)) & 0xffu; const int first = __builtin_ctz(gb);
                    s2[rr] = ((lane & 7) == first) ? ninf : sel[rr]; }
#pragma unroll
                for (int rr = 0; rr < 2; ++rr) gs[rr] = m1[rr] + grp8_max(s2[rr]);
#pragma unroll
                for (int rr = 0; rr < 2; ++rr) { int gc = 0;
#pragma unroll
                    for (int g2 = 0; g2 < 8; ++g2) { const float o = rdlane(gs[rr], 8 * g2); gc += (o > gs[rr] || (o == gs[rr] && g2 < grp)) ? 1 : 0; }
                    cur[rr] = gc < 4 ? sel[rr] : ninf; rank[rr] = TOPK; }
#pragma unroll
                for (int r = 0; r < TOPK; ++r) { float mx[2];
#pragma unroll
                    for (int rr = 0; rr < 2; ++rr) mx[rr] = wave_max(cur[rr]);
#pragma unroll
                    for (int rr = 0; rr < 2; ++rr) { const int idx = (int)__builtin_ctzll(__ballot(cur[rr] == mx[rr])); const bool hit = lane == idx; rank[rr] = hit ? r : rank[rr]; cur[rr] = hit ? ninf : cur[rr]; } }
#pragma unroll
                for (int rr = 0; rr < 2; ++rr) ssum[rr] = wave_sum(rank[rr] < TOPK ? score[rr] : 0.f);
#pragma unroll
                for (int rr = 0; rr < 2; ++rr) { const size_t m = mb + 2 * w + rr;
                    if (rank[rr] < TOPK) { TOKE[m * 8 + rank[rr]] = lane; TOKW[m * 8 + rank[rr]] = score[rr] * __builtin_amdgcn_rcpf(ssum[rr]) * ROUTE_SCALE; __hip_atomic_fetch_add(&hist[lane], 1, __ATOMIC_RELAXED, __HIP_MEMORY_SCOPE_WORKGROUP); } }
            }
        }
        __syncthreads();
        if (tid < 64) HIST[blk * 64 + tid] = hist[tid];
        __syncthreads();
    }
}

__device__ __forceinline__ void phase_sort(const Ctx& C0) {
    CTX_LOCAL(C0);
    PHASE_IDS();
    const int* HIST = WSP(int, WS_HIST); const int* TOKE = WSP(int, WS_TOKE); const float* TOKW = WSP(float, WS_TOKW);
    int* POS = WSP(int, WS_POS); int* STOK = WSP(int, WS_STOK); float* SW = WSP(float, WS_SW); int* TILEE = WSP(int, WS_TILEE); int* CNT = WSP(int, WS_CNT);
    LAS int* psum = (LAS int*)C.lds;
    LAS int* cntH = psum + 512;
    LAS int* ntile = cntH + 128;
    LAS int* rstart = ntile + 128;
    LAS int* ntl = rstart + 128;
    LAS int* cur = ntl + 16;
    LAS int* wcnt = cur + 64;
    { const int e = tid & 63, part = tid >> 6; int s = 0;
        for (int b2 = 32 * part; b2 < 32 * part + 32; ++b2) s += HIST[b2 * 64 + e];
        psum[part * 64 + e] = s; }
    __syncthreads();
    if (tid < 128) { const int hf = tid >> 6, e = tid & 63; const int cnt = psum[(4 * hf) * 64 + e] + psum[(4 * hf + 1) * 64 + e] + psum[(4 * hf + 2) * 64 + e] + psum[(4 * hf + 3) * 64 + e];
        cntH[tid] = cnt; ntile[tid] = (cnt + 255) >> 8; }
    __syncthreads();
    if (tid < 2) { int rs = 0; for (int e = 0; e < 64; ++e) { rstart[tid * 64 + e] = rs; rs += ntile[tid * 64 + e] * 256; } ntl[tid] = rs >> 8; }
    __syncthreads();
    const int NTL0 = ntl[0], NTL1 = ntl[1];
    if (C.vcu == 0) {
        if (tid == 0) { CNT[0] = NTL0; CNT[1] = NTL1; }
        if (tid < 128) { const int hf = tid >> 6, e = tid & 63; const int t0 = (hf ? NTL0 : 0) + (rstart[tid] >> 8), n = ntile[tid];
            for (int t = 0; t < n; ++t) TILEE[t0 + t] = e;
            const int base = M + (hf ? 256 * NTL0 : 0) + rstart[tid];
            int zi = 0; asm volatile("" : "+v"(zi));
#pragma unroll 1
            for (int r = cntH[tid]; r < n * 256; ++r) { STOK[base + r] = zi; SW[base + r] = __int_as_float(zi); } }
    }
    for (int blk = C.vcu; blk < M / 256; blk += C.G) {
        const int hf = blk >> 7;
        { const int e = tid & 63, part = tid >> 6; int s = 0; const int lo = 128 * hf + 16 * part; int hi = lo + 16; if (hi > blk) hi = blk;
            for (int b2 = lo; b2 < hi; ++b2) s += HIST[b2 * 64 + e];
            psum[part * 64 + e] = s; }
        __syncthreads();
        if (tid < 64) { int s = M + (hf ? 256 * NTL0 : 0) + rstart[hf * 64 + tid];
#pragma unroll
            for (int p = 0; p < 8; ++p) s += psum[p * 64 + tid];
            cur[tid] = s; }
        __syncthreads();
        for (int q = 0; q < 4; ++q) {
            const int pair = tid + 512 * q; const size_t idx = (size_t)blk * 2048 + pair; const int e = TOKE[idx];
            int rnk = 0, mycnt = 0;
            for (int ee = 0; ee < 64; ++ee) { const unsigned long long mk = __ballot(e == ee);
                if (e == ee) rnk = __popcll(mk & ((1ull << lane) - 1ull));
                if (lane == ee) mycnt = __popcll(mk); }
            wcnt[w * 64 + lane] = mycnt;
            __syncthreads();
            int pos = cur[e] + rnk;
            for (int w2 = 0; w2 < w; ++w2) pos += wcnt[w2 * 64 + e];
            STOK[pos] = (int)(idx >> 3); SW[pos] = TOKW[idx]; POS[idx] = pos;
            __syncthreads();
            if (tid < 64) { int a = 0;
#pragma unroll
                for (int w2 = 0; w2 < 8; ++w2) a += wcnt[w2 * 64 + tid];
                cur[tid] += a; }
            __syncthreads();
        }
        if (tid < 256) { const int r = blk * 256 + tid; STOK[r] = r; SW[r] = 1.0f; }
        __syncthreads();
    }
}

__device__ __forceinline__ void load_wif_wide(const Ctx& C0, int l, LAS float* wif) {
    CTX_LOCAL(C0);
    const float* win = INP(I_WIN) + (size_t)l * D * DIN;
    for (int i = fresh_tid(); i < 1024 * 8; i += 512) { const int k = i >> 3, g = i & 7; wif[(((k & 15) * 2 + (g >> 2)) * 64 + (k >> 4)) * 4 + (g & 3)] = win[(size_t)k * DIN + 5120 + g]; }
    __syncthreads();
}
__device__ __forceinline__ void phase_ln2(const Ctx& C0, int l, bool dry = false) {
    CTX_LOCAL(C0);
    PHASE_IDS();
    const int gw = C.vcu * 8 + w, NGW = C.G * 8;
    bf16* X = WSP(bf16, WS_XR); bf16* XO = dry ? WSP(bf16, WS_GBUF) : X; float* OUT = C.out; const int* POS = WSP(int, WS_POS); const unsigned char* OUTS = WSP(unsigned char, WS_OUTS);
    unsigned char* XB = WSP(unsigned char, WS_XB); float* IFp = WSP(float, WS_IF);
    const float* g2 = INP(I_LN2G) + (size_t)l * D; const float* b2 = INP(I_LN2B) + (size_t)l * D;
    const int obase = M;
    LAS float* wif = (LAS float*)C.lds;
    const bool nxt = l + 1 < DEPTH;
    if (nxt) load_wif_wide(C, l + 1, wif);
    const float bifl = (INP(I_BIN) + (size_t)(nxt ? l + 1 : l) * DIN + 5120)[(lane >> 1) & 7];
    f32x4 gv[4], bv[4];
#pragma unroll
    for (int q = 0; q < 4; ++q) { gv[q] = *(const f32x4*)(g2 + 16 * lane + 4 * q); bv[q] = *(const f32x4*)(b2 + 16 * lane + 4 * q); }
    const bool b3 = (lane & 8) != 0, b2_ = (lane & 4) != 0, b1 = (lane & 2) != 0;
    int npos[8]; u32x4 ov[8]; u32x4 xq[2];
    if (gw < M) {
#pragma unroll
        for (int k = 0; k < 8; ++k) npos[k] = POS[(size_t)gw * 8 + k] - obase;
#pragma unroll
        for (int k = 0; k < 8; ++k) ov[k] = __builtin_nontemporal_load((const u32x4*)(OUTS + (size_t)npos[k] * D + 16 * lane));
#pragma unroll
        for (int h2 = 0; h2 < 2; ++h2) xq[h2] = *(const u32x4*)(X + (size_t)gw * D + 16 * lane + 8 * h2);
        { const int mn = (gw + NGW < M) ? gw + NGW : gw;
#pragma unroll
          for (int k = 0; k < 8; ++k) npos[k] = POS[(size_t)mn * 8 + k] - obase; }
    }
    for (int m = gw; m < M; m += NGW) {
        f32x4 v[4]; u32x4 ovn[8]; u32x4 xqn[2];
        const int mnx = (m + NGW < M) ? m + NGW : m;
#pragma unroll
        for (int k = 0; k < 8; ++k) ovn[k] = __builtin_nontemporal_load((const u32x4*)(OUTS + (size_t)npos[k] * D + 16 * lane));
#pragma unroll
        for (int h2 = 0; h2 < 2; ++h2) xqn[h2] = *(const u32x4*)(X + (size_t)mnx * D + 16 * lane + 8 * h2);
        { const int mn2 = (m + 2 * NGW < M) ? m + 2 * NGW : mnx;
#pragma unroll
          for (int k = 0; k < 8; ++k) npos[k] = POS[(size_t)mn2 * 8 + k] - obase; }
#pragma unroll
        for (int h2 = 0; h2 < 2; ++h2) { const u32x4 q = xq[h2]; v[2 * h2] = (f32x4){bflo(q.x), bfhi(q.x), bflo(q.y), bfhi(q.y)}; v[2 * h2 + 1] = (f32x4){bflo(q.z), bfhi(q.z), bflo(q.w), bfhi(q.w)}; }
#pragma unroll
        for (int q = 0; q < 4; ++q) { f32x4 a = (f32x4){0.f, 0.f, 0.f, 0.f};
#pragma unroll
            for (int k = 0; k < 8; ++k) { const int w8 = (int)ov[k][q]; a[0] += __builtin_amdgcn_cvt_f32_fp8(w8, 0); a[1] += __builtin_amdgcn_cvt_f32_fp8(w8, 1); a[2] += __builtin_amdgcn_cvt_f32_fp8(w8, 2); a[3] += __builtin_amdgcn_cvt_f32_fp8(w8, 3); }
            v[q] = v[q] + a * (1.0f / 256.0f); }
        float s = 0.f;
#pragma unroll
        for (int q = 0; q < 4; ++q) s += (v[q][0] + v[q][1]) + (v[q][2] + v[q][3]);
        const float mean = wave_sum(s) * (1.0f / D); float qq = 0.f;
#pragma unroll
        for (int q = 0; q < 4; ++q) { v[q] = v[q] - mean; qq += (v[q][0] * v[q][0] + v[q][1] * v[q][1]) + (v[q][2] * v[q][2] + v[q][3] * v[q][3]); }
        const float rstd = __builtin_amdgcn_rsqf(wave_sum(qq) * (1.0f / D) + kf(LN_EPS));
#pragma unroll
        for (int q = 0; q < 4; ++q) v[q] = v[q] * rstd * gv[q] + bv[q];
        if (nxt) {
#pragma unroll
            for (int h2 = 0; h2 < 2; ++h2) { u32x4 o; o.x = cvt_pk_bf16(v[2 * h2][0], v[2 * h2][1]); o.y = cvt_pk_bf16(v[2 * h2][2], v[2 * h2][3]); o.z = cvt_pk_bf16(v[2 * h2 + 1][0], v[2 * h2 + 1][1]); o.w = cvt_pk_bf16(v[2 * h2 + 1][2], v[2 * h2 + 1][3]);
                __builtin_nontemporal_store(o, (u32x4*)(XO + (size_t)m * D + 16 * lane + 8 * h2)); }
            { u32x4 o;
#pragma unroll
              for (int q = 0; q < 4; ++q) { int w8 = __builtin_amdgcn_cvt_pk_fp8_f32(v[q][0] * 16.f, v[q][1] * 16.f, 0, false); w8 = __builtin_amdgcn_cvt_pk_fp8_f32(v[q][2] * 16.f, v[q][3] * 16.f, w8, true); o[q] = (unsigned)w8; }
              *(u32x4*)(XB + (size_t)m * D + 16 * lane) = o; }
            float g[8];
#pragma unroll
            for (int i = 0; i < 8; ++i) g[i] = 0.f;
#pragma unroll
            for (int q = 0; q < 4; ++q)
#pragma unroll
                for (int e = 0; e < 4; ++e) { const int kk = 4 * q + e; const f32x4 w0 = *(const LAS f32x4*)(wif + ((kk * 2) * 64 + lane) * 4), w1 = *(const LAS f32x4*)(wif + ((kk * 2 + 1) * 64 + lane) * 4); const float x = v[q][e];
                    g[0] += x * w0[0]; g[1] += x * w0[1]; g[2] += x * w0[2]; g[3] += x * w0[3]; g[4] += x * w1[0]; g[5] += x * w1[1]; g[6] += x * w1[2]; g[7] += x * w1[3]; }
            float h4[4], p2[2], r;
#pragma unroll
            for (int i = 0; i < 4; ++i) h4[i] = (b3 ? g[i + 4] : g[i]) + dppf<0x140>(b3 ? g[i] : g[i + 4]);
#pragma unroll
            for (int i = 0; i < 2; ++i) p2[i] = (b2_ ? h4[i + 2] : h4[i]) + dppf<0x141>(b2_ ? h4[i] : h4[i + 2]);
            r = (b1 ? p2[1] : p2[0]) + dppf<0x4E>(b1 ? p2[0] : p2[1]);
            r += dppf<0xB1>(r);
            { const auto t = __builtin_amdgcn_permlane32_swap(__float_as_uint(r), __float_as_uint(r), false, false); r = __uint_as_float(t[0]) + __uint_as_float(t[1]); }
            { const auto t = __builtin_amdgcn_permlane16_swap(__float_as_uint(r), __float_as_uint(r), false, false); r = __uint_as_float(t[0]) + __uint_as_float(t[1]); }
            if (lane < 16 && (lane & 1) == 0) IFp[(size_t)m * 8 + (lane >> 1)] = r + bifl;
        } else {
#pragma unroll
            for (int q = 0; q < 4; ++q) *(f32x4*)(OUT + (size_t)m * D + 16 * lane + 4 * q) = v[q];
        }
#pragma unroll
        for (int k = 0; k < 8; ++k) ov[k] = ovn[k];
#pragma unroll
        for (int h2 = 0; h2 < 2; ++h2) xq[h2] = xqn[h2];
    }
}

__device__ __forceinline__ void load_tile_table(const Ctx& C0, int n) {
    CTX_LOCAL(C0);
    const int* TILEE = WSP(int, WS_TILEE); LAS int* t = (LAS int*)(C.lds + LDS_TILE);
    for (int i = fresh_tid(); i < n; i += 512) t[i] = TILEE[i];
    __syncthreads();
}

__global__ void __launch_bounds__(512, 2) mk_fwd(KArgs args) {
    Ctx CK; CK.lds = (LAS unsigned char*)lds_raw;
    if ((threadIdx.x & 63) == 0) *(volatile LAS int*)(CK.lds + LDS_WTAB + 4 * hw_wave_key()) = (int)(threadIdx.x >> 6);
    CK.G = gridDim.x; { const int bx = blockIdx.x; CK.vcu = (CK.G % 8 == 0) ? (bx % 8) * (CK.G / 8) + bx / 8 : bx; }
    CK.out = args.out; CK.ws = args.ws;
    volatile LAS unsigned* MISC = (volatile LAS unsigned*)(CK.lds + LDS_MISC);
    if (threadIdx.x < 64) MISC[threadIdx.x] = 0u;
    if (threadIdx.x == 0) {
#pragma unroll
        for (int k = 0; k < 27; ++k) *(LAS unsigned long long*)(CK.lds + LDS_PTRS + 8 * k) = (unsigned long long)args.in[k];
    }
    __syncthreads();
    const bool use_bar = (args.ph_hi - args.ph_lo) > 1;
    if (use_bar && threadIdx.x == 0) (void)xb_add((unsigned*)(args.ws + WS_CTL) + CW_BAR + XB_XCNT(xb_xcc_id()), 1u);
    const int lo = args.ph_lo, hi = args.ph_hi;

    for (int l = 0; l < DEPTH; ++l) {
        const int p0 = l * NPH;
        if (p0 + NPH <= lo || p0 >= hi) continue;
#define IN(k) (((PH_MASK >> (k)) & 1u) && opq_int(lo) <= p0 + (k) && p0 + (k) < hi)
#define REP(k) (((TREP >> (k)) & 1u) != 0u)
#define SEAM(k) do { if (IN(k) && (p0 + (k) + 1 < hi)) { XcdBarrier bar_; unsigned zo_ = 0u; asm volatile("" : "+v"(zo_)); bar_.bar = (unsigned*)(opq_ptr(CK.ws) + WS_CTL + zo_) + CW_BAR;     bar_.x = (unsigned)__builtin_amdgcn_readfirstlane((int)xb_xcc_id()); \
        bar_.st = (volatile LAS unsigned*)(CK.lds + LDS_MISC) + 8; xcd_barrier(bar_); } } while (0)
        if (l == 0) { if (IN(0)) { if (REP(0)) { phase_convert(CK, 0, true); __syncthreads(); } phase_convert(CK, 0, true); } SEAM(0); }
        if (IN(1)) {
            CTX_LOCAL(CK); bf16* Z = WSP(bf16, WS_Z); bf16* XB = WSP(bf16, WS_XB); const int bx = opq_int((int)blockIdx.x);
            phase_gates(CK);
            if (REP(1)) {
                g8::SchedDenseT<M / 256, ZW / 256> S; S.init(M, ZW, C.G, bx, XB, D / 2, WSP(bf16, WS_WIN), D / 2);
                g8::EpiZ E{WSP(unsigned char, WS_Z), WSP(bf16, WS_ZG), WSP(float, WS_BIAS1), WSP(float, WS_VPART), REP(22)};
                g8::gemm_phase<g8::EpiZ, g8::SchedDenseT<M / 256, ZW / 256>, false, g8::MidNone, G8_SP2, true>(C.lds, D / 2, D / 2, D / 2, S, E, nullptr);
                __syncthreads();
            }
            g8::SchedDenseT<M / 256, ZW / 256> S; S.init(M, ZW, C.G, bx, XB, D / 2, WSP(bf16, WS_WIN), D / 2);
            g8::EpiZ E{WSP(unsigned char, WS_Z), WSP(bf16, WS_ZG), WSP(float, WS_BIAS1), WSP(float, WS_VPART), false};
            g8::gemm_phase<g8::EpiZ, g8::SchedDenseT<M / 256, ZW / 256>, false, g8::MidNone, G8_SP2, true>(C.lds, D / 2, D / 2, D / 2, S, E, nullptr);
        } SEAM(1);
        if (IN(2)) {
            if (REP(16)) phase_sgu(CK, l);
            phase_sgu(CK, l);
            if (REP(17)) phase_kvchain(CK);
            phase_kvchain(CK);
        } SEAM(2);
        if (IN(4)) { if (REP(4)) phase_mlstm(CK, l); phase_mlstm(CK, l); } SEAM(4);
        if (IN(5)) {
            CTX_LOCAL(CK); bf16* Z = WSP(bf16, WS_Z); const int bx = opq_int((int)blockIdx.x);
            if (REP(5)) {
                g8::SchedDenseT<M / 256, D / 256> S; S.init(M, D, C.G, bx, C.out, 1024, WSP(bf16, WS_W4), 1024);
                g8::EpiGate E{WSP(bf16, WS_ZG), ZGP, 1024, nullptr, 0, 0, (bf16*)WSP(unsigned char, WS_Z), Z8W / 2, ZY / 2, true};
                g8::MidMulP Md{WSP(bf16, WS_ZG), ZGP, 0};
                g8::gemm_phase<g8::EpiGate, g8::SchedDenseT<M / 256, D / 256>, false, g8::MidMulP, G8_SP2, true>(C.lds, 1024, 1024, 1024, S, E, nullptr, Md);
                __syncthreads();
            }
            g8::SchedDenseT<M / 256, D / 256> S; S.init(M, D, C.G, bx, C.out, 1024, WSP(bf16, WS_W4), 1024);
            g8::EpiGate E{WSP(bf16, WS_ZG), ZGP, 1024, nullptr, 0, 0, (bf16*)WSP(unsigned char, WS_Z), Z8W / 2, ZY / 2, true};
            g8::MidMulP Md{WSP(bf16, WS_ZG), ZGP, 0};
            g8::gemm_phase<g8::EpiGate, g8::SchedDenseT<M / 256, D / 256>, false, g8::MidMulP, G8_SP2, true>(C.lds, 1024, 1024, 1024, S, E, nullptr, Md);
        } SEAM(5);
        if (IN(6)) {
            CTX_LOCAL(CK); bf16* Z = WSP(bf16, WS_Z); const int bx = opq_int((int)blockIdx.x);
            g8::SchedDenseT<M / 256, D / 256> S; S.init(M, D, C.G, bx, WSP(unsigned char, WS_Z) + ZY, Z8W / 2, WSP(bf16, WS_W4) + (size_t)2 * D * D, D / 2);
            g8::EpiResid E{l == 0 ? INP(I_X) : (const float*)nullptr, WSP(bf16, WS_XR)};
            g8::gemm_phase<g8::EpiResid, g8::SchedDenseT<M / 256, D / 256>, false, g8::MidNone, G8_SP2, true>(C.lds, Z8W / 2, D / 2, D / 2, S, E, nullptr);
        } SEAM(6);
        if (IN(7)) { if (REP(7)) phase_ln1_router(CK, l, true); phase_ln1_router(CK, l); } SEAM(7);
        if (IN(8)) { if (REP(8)) { phase_sort(CK); convert_pb(CK, l); __syncthreads(); } phase_sort(CK); convert_pb(CK, l); } SEAM(8);
        if (IN(9)) {
            CTX_LOCAL(CK); bf16* XB = WSP(bf16, WS_XB); const int bx = opq_int((int)blockIdx.x);
            const int* CNT = WSP(int, WS_CNT); const int nexp = CNT[0] + CNT[1];
            if (REP(9)) {
                load_tile_table(C, nexp);
                g8::SchedUp S{(const LAS int*)(C.lds + LDS_TILE), NSH_TILES + nexp, C.G, C.vcu, (const char*)XB, (const char*)WSP(bf16, WS_UPT)};
                g8::EpiMoeUp E{WSP(bf16, WS_HID), WSP(float, WS_SW), WSP(bf16, WS_PBH)};
                g8::gemm_phase<g8::EpiMoeUp, g8::SchedUp, true, g8::MidNone, G8_SP2, true>(C.lds, D / 2, D / 2, D / 2, S, E, WSP(int, WS_STOK));
                g8::SchedDenseT<M / 256, D / 256> S2; S2.init(M, D, C.G, bx, XB, D / 2, WSP(bf16, WS_W4) + (size_t)3 * D * D, D / 2);
                g8::EpiBiasAct E2{WSP(bf16, WS_GBUF), D, INP(I_BPG) + (size_t)l * D, 0xAAull, nullptr};
                g8::gemm_phase<g8::EpiBiasAct, g8::SchedDenseT<M / 256, D / 256>, false, g8::MidNone, G8_SP2, true>(C.lds, D / 2, D / 2, D / 2, S2, E2, nullptr);
                __syncthreads();
            }
            load_tile_table(C, nexp);
            g8::SchedUp S{(const LAS int*)(C.lds + LDS_TILE), NSH_TILES + nexp, C.G, C.vcu, (const char*)XB, (const char*)WSP(bf16, WS_UPT)};
            g8::EpiMoeUp E{WSP(bf16, WS_HID), WSP(float, WS_SW), WSP(bf16, WS_PBH)};
            g8::gemm_phase<g8::EpiMoeUp, g8::SchedUp, true, g8::MidNone, G8_SP2, true>(C.lds, D / 2, D / 2, D / 2, S, E, WSP(int, WS_STOK));
            g8::SchedDenseT<M / 256, D / 256> S2; S2.init(M, D, C.G, bx, XB, D / 2, WSP(bf16, WS_W4) + (size_t)3 * D * D, D / 2);
            g8::EpiBiasAct E2{WSP(bf16, WS_GBUF), D, INP(I_BPG) + (size_t)l * D, 0xAAull, nullptr};
            g8::gemm_phase<g8::EpiBiasAct, g8::SchedDenseT<M / 256, D / 256>, false, g8::MidNone, G8_SP2, true>(C.lds, D / 2, D / 2, D / 2, S2, E2, nullptr);
        } SEAM(9);
        if (IN(10)) {
            CTX_LOCAL(CK); const int bx = opq_int((int)blockIdx.x);
            {
                g8::SchedDenseT<M / 256, D / 256> S; S.init(M, D, C.G, bx, WSP(bf16, WS_PBH), 256, WSP(bf16, WS_WPT), 256);
                g8::EpiResid E{(const float*)nullptr, WSP(bf16, WS_XR)};
                g8::MidMulP Md{WSP(bf16, WS_GBUF), D, 0};
                g8::gemm_phase<g8::EpiResid, g8::SchedDenseT<M / 256, D / 256>, false, g8::MidMulP, G8_SP2, true>(C.lds, 256, 256, 256, S, E, nullptr, Md);
            }
            const int* CNT = WSP(int, WS_CNT); const int n0 = CNT[0], n1 = CNT[1];
            if (REP(12)) {
                load_tile_table(C, n0 + n1);
                g8::SchedDown S{(const LAS int*)(C.lds + LDS_TILE), n0 + n1, 0, C.G, C.vcu, (const char*)WSP(bf16, WS_HID), (const char*)WSP(bf16, WS_DNT)};
                g8::EpiOut8 E{WSP(unsigned char, WS_OUTS), D};
                g8::gemm_phase<g8::EpiOut8, g8::SchedDown, false, g8::MidNone, G8_SP2, true>(C.lds, DEXP / 2, DEXP / 2, DEXP / 2, S, E, nullptr);
                __syncthreads();
            }
            load_tile_table(C, n0 + n1);
            g8::SchedDown S{(const LAS int*)(C.lds + LDS_TILE), n0 + n1, 0, C.G, C.vcu, (const char*)WSP(bf16, WS_HID), (const char*)WSP(bf16, WS_DNT)};
            g8::EpiOut8 E{WSP(unsigned char, WS_OUTS), D};
            g8::gemm_phase<g8::EpiOut8, g8::SchedDown, false, g8::MidNone, G8_SP2, true>(C.lds, DEXP / 2, DEXP / 2, DEXP / 2, S, E, nullptr);
        } SEAM(10);
        if (IN(11)) { if (REP(11)) { phase_ln2(CK, l, true); __syncthreads(); } phase_ln2(CK, l); if (l + 1 < DEPTH) { __syncthreads(); phase_convert(CK, l + 1, false); if (REP(20)) { __syncthreads(); phase_convert(CK, l + 1, false); } } } SEAM(11);
#undef IN
#undef SEAM
    }
}

__global__ void k_fill(float* out, int n, float v) { for (int i = blockIdx.x * blockDim.x + threadIdx.x; i < n; i += gridDim.x * blockDim.x) out[i] = v; }

#if MK_DEBUG
__global__ void k_hash(const unsigned* p, size_t nwords, unsigned long long* out, unsigned poison) {
    unsigned long long s = 0;
    for (size_t i = (size_t)blockIdx.x * blockDim.x + threadIdx.x; i < nwords; i += (size_t)gridDim.x * blockDim.x) { const unsigned w = p[i]; if (w != poison) s += (unsigned long long)w * (2ull * i + 1ull); }
    for (int o = 32; o >= 1; o >>= 1) s += __shfl_xor(s, o);
    if ((threadIdx.x & 63) == 0) atomicAdd(out, s);
}
__global__ void k_dbg_final(const unsigned long long* ha, const unsigned long long* hb, int nph, float* code) {
    if (threadIdx.x == 0 && blockIdx.x == 0) { int first = -1, cnt = 0;
        for (int i = 0; i < nph; ++i) if (ha[i] != hb[i]) { if (first < 0) first = i; ++cnt; }
        float v;
        if (first < 0) v = 5000.f;
        else { v = (float)(10 + first % 90); if (first >= 90) v *= 100.f; if (cnt > 1) v *= 1.0f; }
        code[0] = sqrtf(v - 1.0f); }
}
__global__ void k_fill_from(float* out, int n, const float* v) { const float x = v[0]; for (int i = blockIdx.x * blockDim.x + threadIdx.x; i < n; i += gridDim.x * blockDim.x) out[i] = x; }
static void dbg_run(KArgs a, int grid, hipStream_t stream) {
    const int NPHASES = DEPTH * NPH;
    unsigned long long* H = (unsigned long long*)(a.ws + WS_CTL) + CW_DBG / 2;
    float* code = (float*)(a.ws + WS_CTL) + CW_DBG + 1024;
    for (int run = 0; run < 2; ++run) {
        const int pb = run ? 0x55 : 0xAA; const unsigned pw = run ? 0x55555555u : 0xAAAAAAAAu;
        (void)hipMemsetAsync((char*)a.ws + CTL_ZERO_BYTES, pb, WS_END - CTL_ZERO_BYTES, stream);
        (void)hipMemsetAsync((char*)a.out, pb, (size_t)M * D * 4, stream);
        for (int ph = 0; ph < NPHASES; ++ph) {
            const int nsub = (ph % NPH == 3) ? 2 : 1;
            for (int sub = 0; sub < nsub; ++sub) {
                a.ph_lo = ph; a.ph_hi = ph + 1; a.dbg = nsub == 2 ? sub + 1 : 0; mk_fwd<<<grid, 512, LDS_BYTES, stream>>>(a);
                unsigned long long* h = H + run * 160 + 2 * ph + sub;
                k_hash<<<2048, 256, 0, stream>>>((const unsigned*)(a.ws + CTL_ZERO_BYTES), (WS_END - CTL_ZERO_BYTES) / 4, h, pw);
                k_hash<<<2048, 256, 0, stream>>>((const unsigned*)a.out, (size_t)M * D, h, pw);
            }
        }
    }
    k_dbg_final<<<1, 64, 0, stream>>>(H, H + 160, 160, code);
    k_fill_from<<<1024, 256, 0, stream>>>(a.out, M * D, code);
}
#endif

extern "C" void kernel_launch(void* const* d_in, const int* in_sizes, int n_in, void* d_out, int out_size, void* d_ws, size_t ws_size, hipStream_t stream) {
    static int grid = 0;
    if (grid == 0) {
        if (n_in != 27 || out_size != M * D || ws_size < WS_END) {
            fprintf(stderr, "kernel_launch: unexpected shapes / workspace (n_in %d, out %d, ws %zu < %zu)\n", n_in, out_size, ws_size, (size_t)WS_END);
            grid = -1;
        } else {
            int dev = 0, cus = 0, per_cu = 0;
            hipGetDevice(&dev); hipDeviceGetAttribute(&cus, hipDeviceAttributeMultiprocessorCount, dev);
            hipFuncSetAttribute((const void*)mk_fwd, hipFuncAttributeMaxDynamicSharedMemorySize, LDS_BYTES);
            hipOccupancyMaxActiveBlocksPerMultiprocessor(&per_cu, (const void*)mk_fwd, 512, LDS_BYTES);
            (void)hipGetLastError();
            grid = cus;
        }
    }
    if (grid < 0) { k_fill<<<1024, 256, 0, stream>>>((float*)d_out, out_size, ws_size < WS_END ? 3.0e8f : 2.0e8f); return; }
    hipMemsetAsync((char*)d_ws + WS_CTL, 0, CTL_ZERO_BYTES, stream);
    KArgs a{};
    for (int i = 0; i < 27; ++i) a.in[i] = (const float*)d_in[i];
    a.out = (float*)d_out; a.ws = (unsigned char*)d_ws; a.dbg = 0; a.pad = 0;
    const int NPHASES = DEPTH * NPH;
#if MK_DEBUG
    dbg_run(a, grid, stream);
#elif MK_LAUNCH_PER_PHASE
    for (int ph = 0; ph < NPHASES; ++ph) { a.ph_lo = ph; a.ph_hi = ph + 1; mk_fwd<<<grid, 512, LDS_BYTES, stream>>>(a); }
#else
    a.ph_lo = 0; a.ph_hi = NPHASES;
    mk_fwd<<<grid, 512, LDS_BYTES, stream>>>(a);
#endif
}
```

```cpp
#include <hip/hip_runtime.h>
#include <cstdio>
#include <cstdint>

#ifndef MK_LAUNCH_PER_PHASE
#define MK_LAUNCH_PER_PHASE 0
#endif
#ifndef SIM_FP8
#define SIM_FP8 0
#endif
#ifndef TREP
#define TREP 0u
#endif
#ifndef PH_MASK
#define PH_MASK 0xFFFFFFFFu
#endif
#ifndef MK_DEBUG
#define MK_DEBUG 0
#endif

#define GAS __attribute__((address_space(1)))
#define LAS __attribute__((address_space(3)))
typedef unsigned short bf16;
typedef short bf16x8 __attribute__((ext_vector_type(8)));
typedef short s16x4 __attribute__((ext_vector_type(4)));
typedef float f32x4 __attribute__((ext_vector_type(4)));
typedef float f32x2 __attribute__((ext_vector_type(2)));
typedef unsigned u32x4 __attribute__((ext_vector_type(4)));
typedef unsigned u32x2 __attribute__((ext_vector_type(2)));
typedef short v4i16_t __attribute__((ext_vector_type(4)));

constexpr int D = 1024, NB = 8, SEQ = 8192, M = NB * SEQ, DEPTH = 4;
constexpr int DIN = 7176, ZW = 7168;
constexpr int Z8W = 5376;
constexpr int ZU = 0, ZVM = 1024, ZV = 2048, ZQ = 3072, ZK = 3584, ZO = 4096, ZGA = 5120, ZGB = 6144;
constexpr int ZT1 = ZQ;
constexpr int ZY = ZV;
constexpr int NH = 4, DQK = 128, DV = 256, LCH = 64, NCH = SEQ / LCH;
constexpr int NE = 64, TOPK = 8, DEXP = 256, PD = 256;
constexpr float ALPHA = 1.681792830507429f;
constexpr float LN_EPS = 1e-5f, RMS_EPS = 1e-6f, ROUTE_SCALE = 2.5f;
constexpr float QSCALE = 0.08838834764831845f;
constexpr int HALF_TOK = M / 2;
constexpr int MAXT_HALF = 1088;
constexpr int NSH_TILES = M / 256;

constexpr size_t MiB = 1u << 20;
constexpr size_t WS_CTL = 0, CTL_ZERO_BYTES = 1 * MiB;
constexpr size_t WS_BIAS1 = 1 * MiB;
constexpr size_t WS_WSB = 1 * MiB + 65536;
constexpr size_t WS_VPART = 1457 * MiB;
constexpr size_t WS_IF = 3 * MiB;
constexpr size_t WS_BC = 5 * MiB;
constexpr size_t WS_BL = 6 * MiB, WS_GM = 6 * MiB + 16384, WS_MS = 6 * MiB + 32768;
constexpr size_t WS_NK = 7 * MiB;
constexpr size_t WS_TOKE = 9 * MiB, WS_TOKW = 11 * MiB, WS_POS = 13 * MiB;
constexpr size_t WS_HIST = 15 * MiB, WS_TILEE = 15 * MiB + 65536, WS_CNT = 15 * MiB + 131072;
constexpr size_t WS_STOK = 16 * MiB, WS_SW = 19 * MiB;
constexpr size_t WS_DBG = 22 * MiB;
constexpr size_t WS_WIN = 24 * MiB;
constexpr size_t WS_W4 = 38 * MiB;
constexpr size_t WS_UPT = 46 * MiB;
constexpr size_t WS_DNT = 145 * MiB;
constexpr size_t WS_WPT = 144 * MiB;
constexpr size_t WS_PBH = 1282 * MiB;
constexpr size_t WS_XB = 79 * MiB;
constexpr size_t WS_XR = 177 * MiB;
constexpr size_t WS_Z = 305 * MiB;
constexpr int ZGP = 2176;
constexpr size_t WS_ZG = 645 * MiB;
constexpr size_t WS_STATE = 1201 * MiB;
constexpr size_t WS_HID = 305 * MiB;
constexpr size_t WS_GBUF = 610 * MiB;
constexpr size_t WS_OUTS = 738 * MiB;
constexpr size_t WS_END = 1465 * MiB;
static_assert(WS_HID + (size_t)(M + 2 * MAXT_HALF * 256) * 512 <= WS_GBUF && WS_OUTS + (size_t)2 * MAXT_HALF * 256 * 1024 <= WS_PBH && WS_PBH + (size_t)M * 1024 <= WS_STATE + 256 * MiB && WS_STATE + 256 * MiB <= WS_VPART, "ws map");

constexpr int CW_BAR = 4096;
constexpr int CW_DBG = 16384;

constexpr int LDS_BYTES = 163840;
constexpr int LDS_GIDX = 131072;
constexpr int LDS_TILE = 133120;
constexpr int LDS_MISC = LDS_BYTES - 256;
constexpr int LDS_PTRS = LDS_BYTES - 512;

#define LDS_WAIT() asm volatile("s_waitcnt lgkmcnt(0)" ::: "memory")
#define VM_WAIT() asm volatile("s_waitcnt vmcnt(0)" ::: "memory")
typedef __bf16 bf16x2_t __attribute__((ext_vector_type(2)));
__device__ __forceinline__ unsigned cvt_pk_bf16(float lo, float hi) { const f32x2 v = {lo, hi}; const bf16x2_t b = __builtin_convertvector(v, bf16x2_t); return __builtin_bit_cast(unsigned, b); }
__device__ __forceinline__ float bf2f(unsigned b) { return __uint_as_float(b << 16); }
__device__ __forceinline__ float bflo(unsigned w) { return __uint_as_float(w << 16); }
__device__ __forceinline__ float bfhi(unsigned w) { return __uint_as_float(w & 0xffff0000u); }
__device__ __forceinline__ bf16 f2bf(float f) { return (bf16)(cvt_pk_bf16(f, f) & 0xffffu); }
__device__ __forceinline__ float q8(float x, float s, float inv_s) { const int v = __builtin_amdgcn_cvt_pk_fp8_f32(x * s, 0.f, 0, false); return __builtin_amdgcn_cvt_f32_fp8(v, 0) * inv_s; }
__device__ __forceinline__ unsigned pk4_fp8x16(float a, float b, float c, float d) {
    float k = 448.f; asm volatile("" : "+s"(k));
    a = __builtin_amdgcn_fmed3f(a * 16.f, -k, k); b = __builtin_amdgcn_fmed3f(b * 16.f, -k, k); c = __builtin_amdgcn_fmed3f(c * 16.f, -k, k); d = __builtin_amdgcn_fmed3f(d * 16.f, -k, k);
    int w = __builtin_amdgcn_cvt_pk_fp8_f32(a, b, 0, false); w = __builtin_amdgcn_cvt_pk_fp8_f32(c, d, w, true); return (unsigned)w; }
__device__ __forceinline__ unsigned pk4_fp8x4(float a, float b, float c, float d) {
    float k = 448.f; asm volatile("" : "+s"(k));
    a = __builtin_amdgcn_fmed3f(a * 4.f, -k, k); b = __builtin_amdgcn_fmed3f(b * 4.f, -k, k); c = __builtin_amdgcn_fmed3f(c * 4.f, -k, k); d = __builtin_amdgcn_fmed3f(d * 4.f, -k, k);
    int w = __builtin_amdgcn_cvt_pk_fp8_f32(a, b, 0, false); w = __builtin_amdgcn_cvt_pk_fp8_f32(c, d, w, true); return (unsigned)w; }
__device__ __forceinline__ f32x4 un4_fp8x4(unsigned w) { const f32x2 lo = __builtin_amdgcn_cvt_pk_f32_fp8((int)w, false), hi = __builtin_amdgcn_cvt_pk_f32_fp8((int)w, true); return (f32x4){lo[0] * 0.25f, lo[1] * 0.25f, hi[0] * 0.25f, hi[1] * 0.25f}; }
__device__ __forceinline__ void un16_fp8x16(const u32x4 e, float (&f)[16]) {
#pragma unroll
    for (int q = 0; q < 4; ++q) { const f32x2 lo = __builtin_amdgcn_cvt_pk_f32_fp8((int)e[q], false), hi = __builtin_amdgcn_cvt_pk_f32_fp8((int)e[q], true);
        f[4 * q] = lo[0] * 0.0625f; f[4 * q + 1] = lo[1] * 0.0625f; f[4 * q + 2] = hi[0] * 0.0625f; f[4 * q + 3] = hi[1] * 0.0625f; }
}
__device__ __forceinline__ void un16_fp8raw(const u32x4 e, float (&f)[16]) {
#pragma unroll
    for (int q = 0; q < 4; ++q) { const f32x2 lo = __builtin_amdgcn_cvt_pk_f32_fp8((int)e[q], false), hi = __builtin_amdgcn_cvt_pk_f32_fp8((int)e[q], true);
        f[4 * q] = lo[0]; f[4 * q + 1] = lo[1]; f[4 * q + 2] = hi[0]; f[4 * q + 3] = hi[1]; }
}
__device__ __forceinline__ void bf16x16_to_lds(LAS unsigned char* p, const float (&f)[16]) {
    u32x4 a, b; a.x = cvt_pk_bf16(f[0], f[1]); a.y = cvt_pk_bf16(f[2], f[3]); a.z = cvt_pk_bf16(f[4], f[5]); a.w = cvt_pk_bf16(f[6], f[7]);
    b.x = cvt_pk_bf16(f[8], f[9]); b.y = cvt_pk_bf16(f[10], f[11]); b.z = cvt_pk_bf16(f[12], f[13]); b.w = cvt_pk_bf16(f[14], f[15]);
    *(LAS u32x4*)p = a; *(LAS u32x4*)(p + 16) = b;
}
template <int CTRL> __device__ __forceinline__ float dppf(float v) { return __builtin_bit_cast(float, __builtin_amdgcn_update_dpp(0, __builtin_bit_cast(int, v), CTRL, 0xF, 0xF, true)); }
__device__ __forceinline__ float shfl_idx(float v, int src) { return __builtin_bit_cast(float, __builtin_amdgcn_ds_bpermute(src << 2, __builtin_bit_cast(int, v))); }
__device__ __forceinline__ float rdlane(float v, int l) { return __builtin_bit_cast(float, __builtin_amdgcn_readlane(__builtin_bit_cast(int, v), l)); }
__device__ __forceinline__ float grp8_sum(float v) { v += dppf<0xB1>(v); v += dppf<0x4E>(v); v += dppf<0x141>(v); return v; }
__device__ __forceinline__ float grp8_max(float v) { v = fmaxf(v, dppf<0xB1>(v)); v = fmaxf(v, dppf<0x4E>(v)); v = fmaxf(v, dppf<0x141>(v)); return v; }
__device__ __forceinline__ float wave_sum(float v) { v = grp8_sum(v); v += dppf<0x140>(v); return (rdlane(v, 0) + rdlane(v, 16)) + (rdlane(v, 32) + rdlane(v, 48)); }
__device__ __forceinline__ float wave_max(float v) { v = grp8_max(v); v = fmaxf(v, dppf<0x140>(v)); return fmaxf(fmaxf(rdlane(v, 0), rdlane(v, 16)), fmaxf(rdlane(v, 32), rdlane(v, 48))); }
__device__ __forceinline__ float kf(float x) { asm volatile("" : "+s"(x)); return x; }
__device__ __forceinline__ float fast_exp(float x) { return __builtin_amdgcn_exp2f(x * kf(1.4426950408889634f)); }
__device__ __forceinline__ float fast_sigmoid(float x) { return __builtin_amdgcn_rcpf(1.0f + __builtin_amdgcn_exp2f(-1.4426950408889634f * x)); }
__device__ __forceinline__ f32x2 gelu_pk(f32x2 v) {
    const f32x2 av = __builtin_elementwise_abs(v), d = av * 0.2316418882f + 1.0f;
    f32x2 t; t.x = __builtin_amdgcn_rcpf(d.x); t.y = __builtin_amdgcn_rcpf(d.y);
    f32x2 q = t * 0.5307027145f + (-0.7265760135f); q = q * t + 0.7107068705f; q = q * t + (-0.142248368f); q = q * t + 0.127414796f; q = q * t;
    const f32x2 s = (v * v) * (-0.72134752044f);
    f32x2 e; e.x = __builtin_amdgcn_exp2f(s.x); e.y = __builtin_amdgcn_exp2f(s.y);
    const f32x2 m = v * (q * e), r = v - m;
    f32x2 o; o.x = v.x < 0.f ? m.x : r.x; o.y = v.y < 0.f ? m.y : r.y; return o;
}
typedef float f32x8 __attribute__((ext_vector_type(8)));
__device__ __forceinline__ f32x8 gelu8(f32x8 v) {
    const f32x8 av = __builtin_elementwise_abs(v), d = av * 0.2316418882f + 1.0f;
    f32x8 t, e;
#pragma unroll
    for (int i = 0; i < 8; ++i) t[i] = __builtin_amdgcn_rcpf(d[i]);
    f32x8 q = t * 0.5307027145f + (-0.7265760135f); q = q * t + 0.7107068705f; q = q * t + (-0.142248368f); q = q * t + 0.127414796f; q = q * t;
    const f32x8 s = (v * v) * (-0.72134752044f);
#pragma unroll
    for (int i = 0; i < 8; ++i) e[i] = __builtin_amdgcn_exp2f(s[i]);
    const f32x8 m = v * (q * e), r = v - m;
    f32x8 o;
#pragma unroll
    for (int i = 0; i < 8; ++i) o[i] = v[i] < 0.f ? m[i] : r[i];
    return o;
}
__device__ __forceinline__ bf16x8 frag_row(const LAS unsigned char* t, int pitch, int r0, int k0, int lane) {
    return *(const LAS bf16x8*)(t + (r0 + (lane & 15)) * pitch + (k0 + 8 * (lane >> 4)) * 2);
}
__device__ __forceinline__ bf16x8 frag_tr(const LAS unsigned char* t, int pitch, int k0, int n0, int lane) {
    const int i = lane & 15, g = lane >> 4, q = i >> 2, p = i & 3;
    const LAS unsigned char* a = t + (k0 + 8 * g + q) * pitch + (n0 + 4 * p) * 2;
    const s16x4 lo = __builtin_bit_cast(s16x4, __builtin_amdgcn_ds_read_tr16_b64_v4i16((LAS v4i16_t*)a));
    const s16x4 hi = __builtin_bit_cast(s16x4, __builtin_amdgcn_ds_read_tr16_b64_v4i16((LAS v4i16_t*)(a + 4 * pitch)));
    return (bf16x8){lo[0], lo[1], lo[2], lo[3], hi[0], hi[1], hi[2], hi[3]};
}
#define MFMA16(a, b, c) __builtin_amdgcn_mfma_f32_16x16x32_bf16((a), (b), (c), 0, 0, 0)
__device__ __forceinline__ long frag8(const LAS unsigned char* t, int pitch, int r0, int k0, int lane) { return *(const LAS long*)(t + (r0 + (lane & 15)) * pitch + k0 + 8 * (lane >> 4)); }
#define MFMA8(a, b, c) __builtin_amdgcn_mfma_f32_16x16x32_fp8_fp8((a), (b), (c), 0, 0, 0)

constexpr int LDS_WTAB = 163840 - 768;
extern __shared__ __attribute__((aligned(16))) unsigned char lds_raw[];
__device__ __forceinline__ unsigned hw_wave_key() { return (unsigned)__builtin_amdgcn_s_getreg(((6 - 1) << 11) | 4) & 63u; }
__device__ __forceinline__ int fresh_tid() {
    const int wv = __builtin_amdgcn_readfirstlane(*(volatile LAS int*)((LAS unsigned char*)lds_raw + LDS_WTAB + 4 * hw_wave_key()));
    unsigned ones = ~0u; asm volatile("" : "+s"(ones));
    int t = (wv << 6) | (int)__builtin_amdgcn_mbcnt_hi(ones, __builtin_amdgcn_mbcnt_lo(ones, 0u)); asm volatile("" : "+v"(t)); return t; }
#define XB_TMO      128
#define XB_XCNT(j)  (256  + 64 * (j))
#define XB_XSUB(j)  (1280 + 64 * (j))
#define XB_XGEN(j)  (2304 + 64 * (j))
#define XB_TOP      3328
#define XB_TOPGEN   3392
#define XCD_BAR_WORDS 3456
#define XB_SPIN_CAP (1u << 22)
__device__ __forceinline__ unsigned xb_ld(unsigned* p)              { return __hip_atomic_load(p, __ATOMIC_RELAXED, __HIP_MEMORY_SCOPE_AGENT); }
__device__ __forceinline__ unsigned xb_add(unsigned* p, unsigned v) { asm volatile("" : "+v"(v));
    return __hip_atomic_fetch_add(p, v, __ATOMIC_RELAXED, __HIP_MEMORY_SCOPE_AGENT); }
__device__ __forceinline__ unsigned xb_xcc_id() { return (unsigned)__builtin_amdgcn_s_getreg((3 << 11) | 20) & 0xFu; }
#define XB_SPIN(cond, bar) do { unsigned _sp = 0; while (cond) { __builtin_amdgcn_s_sleep(1); \
    if ((++_sp & 255u) == 0u) { if (xb_ld(&(bar)[XB_TMO])) break; if (_sp > XB_SPIN_CAP) { atomicAdd(&(bar)[XB_TMO], 1u); break; } } } } while (0)
struct XcdBarrier { unsigned* bar; unsigned x; volatile LAS unsigned* st; };
__device__ __forceinline__ XcdBarrier xcd_barrier_post(unsigned* bar, volatile LAS unsigned* st) {
    XcdBarrier b; b.bar = bar; b.x = xb_xcc_id(); b.st = st;
    if (fresh_tid() == 0) (void)xb_add(&bar[XB_XCNT(b.x)], 1u);
    return b;
}
__device__ __forceinline__ void xcd_barrier_complete(unsigned* bar, unsigned x, unsigned& nloc, unsigned& nx) {
    const unsigned G = gridDim.x * gridDim.y * gridDim.z;
    unsigned sum, cnt, mine, sp = 0u;
    for (;;) {
        sum = 0u; cnt = 0u; mine = 0u;
#pragma unroll
        for (unsigned j = 0; j < 16; ++j) { const unsigned c = xb_ld(&bar[XB_XCNT(j)]); sum += c; cnt += (c > 0u) ? 1u : 0u; mine = (j == x) ? c : mine; }
        if (sum == G) break;
        __builtin_amdgcn_s_sleep(1);
        if ((++sp & 255u) == 0u) { if (xb_ld(&bar[XB_TMO])) break; if (sp > XB_SPIN_CAP) { atomicAdd(&bar[XB_TMO], 1u); break; } }
    }
    nloc = mine > 0u ? mine : 1u; nx = cnt > 0u ? cnt : 1u;
}
__device__ __forceinline__ void xcd_barrier(const XcdBarrier& b) {
    asm volatile("s_waitcnt vmcnt(0)" ::: "memory");
    __syncthreads();
    if (fresh_tid() == 0) {
        unsigned* bar = b.bar;
        __builtin_amdgcn_s_waitcnt(0);
        unsigned nloc = b.st[0], nx = b.st[1];
        if (nloc == 0u) { xcd_barrier_complete(bar, b.x, nloc, nx); b.st[0] = nloc; b.st[1] = nx; }
        const unsigned old = xb_add(&bar[XB_XSUB(b.x)], 1u);
        const unsigned gen = old / nloc;
        if (old + 1u == (gen + 1u) * nloc) {
            __builtin_amdgcn_fence(__ATOMIC_RELEASE, "agent");
            asm volatile("s_waitcnt vmcnt(0)" ::: "memory");
            const unsigned og = xb_add(&bar[XB_TOP], 1u);
            const unsigned tg = og / nx;
            if (og + 1u == (tg + 1u) * nx) xb_add(&bar[XB_TOPGEN], 1u);
            else XB_SPIN(xb_ld(&bar[XB_TOPGEN]) == tg, bar);
            __builtin_amdgcn_fence(__ATOMIC_ACQUIRE, "agent");
            xb_add(&bar[XB_XGEN(b.x)], 1u);
            asm volatile("s_waitcnt vmcnt(0)" ::: "memory");
        } else {
            XB_SPIN(xb_ld(&bar[XB_XGEN(b.x)]) == gen, bar);
            __builtin_amdgcn_fence(__ATOMIC_ACQUIRE, "agent");
            asm volatile("s_waitcnt vmcnt(0)" ::: "memory");
        }
    }
    __syncthreads();
}

#ifndef G8_SP2
#define G8_SP2 true
#endif
namespace g8 {
constexpr int BM = 256, BK = 64, HALF = 128, HTB = HALF * BK * 2, STAGE_BYTES = 8 * HTB;
__device__ __forceinline__ int lds_byte(int r, int c) { const int st = (r >> 4) * 2 + (c >> 5), rr = r & 15, cc = c & 31, ob = rr * 64 + cc * 2; return st * 1024 + (ob ^ (((ob >> 9) & 1) << 5)); }
__device__ __forceinline__ void stage_rc(int b, int& R, int& C) { const int st = b / 1024, sb = b % 1024, swz = sb ^ (((sb >> 9) & 1) << 5); R = (st >> 1) * 16 + swz / 64; C = (st & 1) * 32 + (swz % 64) / 2; }
__device__ __forceinline__ int perm32(int rho) { const int n = rho >> 4, i = rho & 15; return 8 * (i >> 2) + 4 * n + (i & 3); }

__device__ __forceinline__ const char* uni_ptr(const char* p) {
    const unsigned long long v = (unsigned long long)p; const unsigned lo = __builtin_amdgcn_readfirstlane((unsigned)v), hi = __builtin_amdgcn_readfirstlane((unsigned)(v >> 32)); return (const char*)(const GAS char*)(((unsigned long long)hi << 32) | lo); }
struct Unit { int pm, pn; const char* a; const char* b; int grow; };

template <bool B> struct BoolC { static constexpr bool value = B; };
template <class T, class = void> struct pre_of { static constexpr bool value = false; };
template <class T> struct pre_of<T, decltype((void)T::PRE)> { static constexpr bool value = T::PRE; };
template <class T, class = void> struct perm2_of { static constexpr bool value = false; };
template <class T> struct perm2_of<T, decltype((void)T::PERM2)> { static constexpr bool value = T::PERM2; };
struct MidNone { static constexpr bool ON = false; template <class A, class U> __device__ __forceinline__ void operator()(A&, const U&, int, int, int, int) const {} };
typedef int v8i32_t __attribute__((ext_vector_type(8)));
typedef int v4i32_t __attribute__((ext_vector_type(4)));
template <class Epi, class Sched, bool GATHER, class Mid = MidNone, bool SP2 = G8_SP2, bool FP8 = false>
__device__ __forceinline__ void gemm_phase(LAS unsigned char* lds, const int lda, const int ldb, const int K, const Sched& S, const Epi& E, const int* gidx, const Mid& Md = Mid()) {
    const int tid = fresh_tid(), wid = __builtin_amdgcn_readfirstlane(tid >> 6), lane = tid & 63, wr = wid >> 2, wc = wid & 3, fr = lane & 15, fq = lane >> 4;
    const int nt = K / BK;
    int Rr[2], Cc[2]; unsigned voffA[2], voffB[2][2];
#pragma unroll
    for (int i = 0; i < 2; ++i) { stage_rc(tid * 16 + i * 8192, Rr[i], Cc[i]); voffA[i] = (unsigned)(Rr[i] * lda + Cc[i]) * 2u;
#pragma unroll
        for (int h = 0; h < 2; ++h) { int Rb;
            if constexpr (perm2_of<Epi>::value) Rb = 64 * (Rr[i] >> 5) + 16 * (((Rr[i] & 31) >> 2) & 3) + 8 * h + 4 * ((Rr[i] & 31) >> 4) + (Rr[i] & 3);
            else Rb = h * HALF + (Epi::PERM ? ((Rr[i] & ~31) + perm32(Rr[i] & 31)) : Rr[i]);
            voffB[h][i] = (unsigned)(Rb * ldb + Cc[i]) * 2u; } }
    const unsigned hstepA = (unsigned)HALF * (unsigned)lda * 2u;
    const size_t kstep = (size_t)(BK * 2);
    const unsigned ldsw = (unsigned)wid * 1024u;
    const int aoff = lds_byte(wr * 64 + fr, fq * 8), boff = lds_byte(wc * 32 + fr, fq * 8);
#define G8_SA(b, h) (((b) * 2 + (h)) * HTB)
#define G8_SB(b, h) ((4 + (b) * 2 + (h)) * HTB)
#define G8_STAGE_B(bufoff, gbase, h) do { _Pragma("unroll") for (int _i = 0; _i < 2; ++_i) \
        __builtin_amdgcn_global_load_lds((const unsigned*)((const char*)(gbase) + voffB[h][_i]), (LAS unsigned*)(lds + (bufoff) + ldsw + _i * 8192), 16, 0, 0); } while (0)
#define G8_STAGE_A(bufoff, gbase, h, slot) do { _Pragma("unroll") for (int _i = 0; _i < 2; ++_i) { \
        unsigned _o; if constexpr (GATHER) _o = (unsigned)(*(const LAS int*)(lds + LDS_GIDX + (slot) * 1024 + ((h) * HALF + Rr[_i]) * 4) * lda + Cc[_i]) * 2u; else _o = voffA[_i] + (unsigned)(h) * hstepA; \
        __builtin_amdgcn_global_load_lds((const unsigned*)((const char*)(gbase) + _o), (LAS unsigned*)(lds + (bufoff) + ldsw + _i * 8192), 16, 0, 0); } } while (0)
#define G8_LD32(p) __builtin_shufflevector(*(const LAS v4i32_t*)(p), *(const LAS v4i32_t*)((p) + 1024), 0, 1, 2, 3, 4, 5, 6, 7)
#define G8_LDA(dst, b, h) do { if constexpr (FP8) { _Pragma("unroll") for (int m = 0; m < 4; ++m) dst##8[m] = G8_LD32(lds + G8_SA(b, h) + aoff + m * 2048); } \
        else { _Pragma("unroll") for (int m = 0; m < 4; ++m) _Pragma("unroll") for (int k = 0; k < 2; ++k) dst[m][k] = *(const LAS bf16x8*)(lds + G8_SA(b, h) + aoff + m * 2048 + k * 1024); } } while (0)
#define G8_LDB(dst, b, h) do { if constexpr (FP8) { _Pragma("unroll") for (int n = 0; n < 2; ++n) dst##8[n] = G8_LD32(lds + G8_SB(b, h) + boff + n * 2048); } \
        else { _Pragma("unroll") for (int n = 0; n < 2; ++n) _Pragma("unroll") for (int k = 0; k < 2; ++k) dst[n][k] = *(const LAS bf16x8*)(lds + G8_SB(b, h) + boff + n * 2048 + k * 1024); } } while (0)
#define G8_MMA(ai, bj, At, Bt) do { __builtin_amdgcn_s_setprio(1); \
        if constexpr (FP8) { _Pragma("unroll") for (int m = 0; m < 4; ++m) _Pragma("unroll") for (int n = 0; n < 2; ++n) \
            asm volatile("v_mfma_scale_f32_16x16x128_f8f6f4 %0, %1, %2, %0, %3, %4 op_sel_hi:[0,0,0]" : "+v"(acc[ai][bj][m][n]) : "v"(Bt##8[n]), "v"(At##8[m]), "v"(sc_w), "v"(sc_x)); } \
        else { _Pragma("unroll") for (int m = 0; m < 4; ++m) _Pragma("unroll") for (int n = 0; n < 2; ++n) _Pragma("unroll") for (int k = 0; k < 2; ++k) \
            acc[ai][bj][m][n] = __builtin_amdgcn_mfma_f32_16x16x32_bf16(Bt[n][k], At[m][k], acc[ai][bj][m][n], 0, 0, 0); } \
        __builtin_amdgcn_s_setprio(0); } while (0)
#define G8_MMA0(ai, bj, At, Bt) do { __builtin_amdgcn_s_setprio(1); \
        if constexpr (FP8) { _Pragma("unroll") for (int m = 0; m < 4; ++m) _Pragma("unroll") for (int n = 0; n < 2; ++n) \
            asm volatile("v_mfma_scale_f32_16x16x128_f8f6f4 %0, %1, %2, 0, %3, %4 op_sel_hi:[0,0,0]" : "+v"(acc[ai][bj][m][n]) : "v"(Bt##8[n]), "v"(At##8[m]), "v"(sc_w), "v"(sc_x)); } \
        else { _Pragma("unroll") for (int m = 0; m < 4; ++m) _Pragma("unroll") for (int n = 0; n < 2; ++n) _Pragma("unroll") for (int k = 0; k < 2; ++k) \
            acc[ai][bj][m][n] = __builtin_amdgcn_mfma_f32_16x16x32_bf16(Bt[n][k], At[m][k], acc[ai][bj][m][n], 0, 0, 0); } \
        __builtin_amdgcn_s_setprio(0); } while (0)
#define G8_MMAF(first, ai, bj, At, Bt) do { if constexpr (FP8 && (first)) G8_MMA0(ai, bj, At, Bt); else G8_MMA(ai, bj, At, Bt); } while (0)
#define G8_WAIT_V(n) asm volatile("s_waitcnt vmcnt(" #n ")" ::: "memory")
#define G8_WAIT_L(n) asm volatile("s_waitcnt lgkmcnt(" #n ")" ::: "memory")
#define G8_WAIT_VR do { if (fresh) { if constexpr (pre_of<Epi>::value) { if (prev16) G8_WAIT_V(24); else G8_WAIT_V(16); } else if constexpr (Epi::NVM == 16) G8_WAIT_V(24); else if constexpr (Epi::NVM == 32) G8_WAIT_V(40); else if constexpr (Epi::NVM == 8) G8_WAIT_V(16); else G8_WAIT_V(8); } else G8_WAIT_V(8); } while (0)
#define G8_BAR __builtin_amdgcn_s_barrier()
#define G8_SCHED __builtin_amdgcn_sched_barrier(0)
    Unit cur, nxt; int ui = 0; bool prev16 = false; (void)prev16;
    if (!S.next(0, cur)) return;
    f32x4 acc[2][2][4][2];
    {
#pragma unroll
    for (int a = 0; a < 2; ++a)
#pragma unroll
        for (int b = 0; b < 2; ++b)
#pragma unroll
            for (int m = 0; m < 4; ++m)
#pragma unroll
                for (int n = 0; n < 2; ++n) acc[a][b][m][n] = (f32x4){0.f, 0.f, 0.f, 0.f};
    }
    bf16x8 At[4][2], B0[2][2], B1[2][2]; v8i32_t At8[4], B08[2], B18[2];
    int sc_w = 0x77777777, sc_x = 0x7B7B7B7B; if constexpr (FP8) asm volatile("" : "+v"(sc_w), "+v"(sc_x));
    const char* cA = uni_ptr(cur.a); const char* cB = uni_ptr(cur.b);
    if constexpr (GATHER) {
        if (tid < 256) *(LAS int*)(lds + LDS_GIDX + tid * 4) = gidx[cur.grow + tid];
        __syncthreads();
    }
    if constexpr (SP2) {
        G8_STAGE_B(G8_SB(0, 0), cB, 0); G8_STAGE_B(G8_SB(0, 1), cB, 1); G8_STAGE_A(G8_SA(0, 0), cA, 0, 0); G8_STAGE_A(G8_SA(0, 1), cA, 1, 0);
        if (wr == 1) G8_BAR;
        G8_WAIT_V(2); G8_BAR;
        G8_STAGE_B(G8_SB(1, 0), cB + kstep, 0); G8_STAGE_A(G8_SA(1, 0), cA + kstep, 0, 0); G8_STAGE_B(G8_SB(1, 1), cB + kstep, 1);
        G8_WAIT_V(6); G8_BAR;
    } else {
    G8_STAGE_B(G8_SB(0, 0), cB, 0); G8_STAGE_A(G8_SA(0, 0), cA, 0, 0); G8_STAGE_B(G8_SB(0, 1), cB, 1); G8_STAGE_A(G8_SA(0, 1), cA, 1, 0);
    if (wr == 1) G8_BAR;
    G8_WAIT_V(4); G8_BAR;
    G8_STAGE_B(G8_SB(1, 0), cB + kstep, 0); G8_STAGE_A(G8_SA(1, 0), cA + kstep, 0, 0); G8_STAGE_B(G8_SB(1, 1), cB + kstep, 1);
    G8_WAIT_V(6); G8_BAR;
    }
#pragma unroll 1
    for (;;) {
        const bool has_next = S.next(ui + 1, nxt);
        const char* nA = has_next ? uni_ptr(nxt.a) : cA; const char* nB = has_next ? uni_ptr(nxt.b) : cB;
        if constexpr (GATHER) {
            if (has_next && wid == 0)
                __builtin_amdgcn_global_load_lds((const unsigned*)(gidx + nxt.grow) + lane * 4, (LAS unsigned*)(lds + LDS_GIDX + ((ui + 1) & 1) * 1024), 16, 0, 0);
        }
        auto trip = [&](const int t, auto first_c) __attribute__((always_inline)) {
            constexpr bool FIRST = decltype(first_c)::value;
            const bool last = (t == nt - 2);
            const char* a1 = cA + (size_t)(t + 1) * kstep;
            const char* a2 = last ? nA : cA + (size_t)(t + 2) * kstep; const char* b2 = last ? nB : cB + (size_t)(t + 2) * kstep;
            const char* a3 = a2 + kstep; const char* b3 = b2 + kstep;
            const int sl1 = ui & 1, sl2 = (last && has_next) ? ((ui + 1) & 1) : (ui & 1);
            const bool fresh = (FIRST || (!FP8 && t == 0)) && (ui > 0);
            if constexpr (Mid::ON) { if (t == (nt >> 1)) { G8_SCHED; if constexpr (FP8) asm volatile("s_nop 15\n\ts_nop 15" ::: "memory"); Md(acc, cur, wr, wc, fr, fq); if constexpr (FP8) asm volatile("s_nop 7" ::: "memory"); G8_SCHED; } }
            if constexpr (SP2) {
            if constexpr (GATHER) { if (!fresh) G8_STAGE_A(G8_SA(1, 1), a1, 1, sl1); } G8_LDB(B0, 0, 0); G8_LDB(B1, 0, 1); G8_SCHED; G8_LDA(At, 0, 0); if constexpr (!GATHER) { if (!fresh) G8_STAGE_A(G8_SA(1, 1), a1, 1, sl1); }
            G8_WAIT_VR; G8_WAIT_L(0); G8_BAR; G8_MMAF(FIRST, 0, 0, At, B0); G8_MMAF(FIRST, 0, 1, At, B1); G8_BAR; G8_SCHED;
            G8_LDA(At, 0, 1); G8_STAGE_B(G8_SB(0, 0), b2, 0); G8_STAGE_B(G8_SB(0, 1), b2, 1); G8_STAGE_A(G8_SA(0, 0), a2, 0, sl2);
            G8_WAIT_VR; G8_WAIT_L(0); G8_BAR; G8_MMAF(FIRST, 1, 0, At, B0); G8_MMAF(FIRST, 1, 1, At, B1); G8_BAR; G8_SCHED;
            if constexpr (GATHER) { G8_STAGE_A(G8_SA(0, 1), a2, 1, sl2); } G8_LDB(B0, 1, 0); G8_LDB(B1, 1, 1); G8_SCHED; G8_LDA(At, 1, 0); if constexpr (!GATHER) { G8_STAGE_A(G8_SA(0, 1), a2, 1, sl2); }
            G8_WAIT_VR; G8_WAIT_L(0); G8_BAR; G8_MMA(0, 0, At, B0); G8_MMA(0, 1, At, B1); G8_BAR; G8_SCHED;
            G8_LDA(At, 1, 1); G8_STAGE_B(G8_SB(1, 0), b3, 0); G8_STAGE_B(G8_SB(1, 1), b3, 1); G8_STAGE_A(G8_SA(1, 0), a3, 0, sl2);
            G8_WAIT_V(8); G8_WAIT_L(0); G8_BAR; G8_MMA(1, 0, At, B0); G8_MMA(1, 1, At, B1); G8_BAR; G8_SCHED;
            if (last && has_next) G8_STAGE_A(G8_SA(1, 1), a3, 1, sl2);
            } else {
            if constexpr (GATHER) { G8_STAGE_A(G8_SA(1, 1), a1, 1, sl1); } G8_LDB(B0, 0, 0); G8_SCHED; G8_LDA(At, 0, 0); if constexpr (!GATHER) { G8_STAGE_A(G8_SA(1, 1), a1, 1, sl1); }
            G8_WAIT_L(8); G8_BAR; G8_WAIT_L(0); G8_MMA(0, 0, At, B0); G8_BAR; G8_SCHED;
            G8_LDB(B1, 0, 1); G8_STAGE_B(G8_SB(0, 0), b2, 0);
            G8_BAR; G8_WAIT_L(0); G8_MMA(0, 1, At, B1); G8_BAR;
            if constexpr (GATHER) { G8_STAGE_A(G8_SA(0, 0), a2, 0, sl2); } G8_LDA(At, 0, 1); if constexpr (!GATHER) { G8_STAGE_A(G8_SA(0, 0), a2, 0, sl2); }
            G8_BAR; G8_WAIT_L(0); G8_MMA(1, 0, At, B0); G8_BAR; G8_SCHED;
            G8_STAGE_B(G8_SB(0, 1), b2, 1);
            G8_WAIT_V(6); G8_BAR; G8_MMA(1, 1, At, B1); G8_BAR;
            if constexpr (GATHER) { G8_STAGE_A(G8_SA(0, 1), a2, 1, sl2); } G8_LDB(B0, 1, 0); G8_SCHED; G8_LDA(At, 1, 0); if constexpr (!GATHER) { G8_STAGE_A(G8_SA(0, 1), a2, 1, sl2); }
            G8_WAIT_L(8); G8_BAR; G8_WAIT_L(0); G8_MMA(0, 0, At, B0); G8_BAR; G8_SCHED;
            G8_LDB(B1, 1, 1); G8_STAGE_B(G8_SB(1, 0), b3, 0);
            G8_BAR; G8_WAIT_L(0); G8_MMA(0, 1, At, B1); G8_BAR;
            if constexpr (GATHER) { G8_STAGE_A(G8_SA(1, 0), a3, 0, sl2); } G8_LDA(At, 1, 1); if constexpr (!GATHER) { G8_STAGE_A(G8_SA(1, 0), a3, 0, sl2); }
            G8_BAR; G8_WAIT_L(0); G8_MMA(1, 0, At, B0); G8_BAR; G8_SCHED;
            G8_STAGE_B(G8_SB(1, 1), b3, 1);
            G8_WAIT_V(6); G8_BAR; G8_MMA(1, 1, At, B1); G8_BAR;
            }
                };
        if constexpr (FP8) { trip(0, BoolC<true>());
#pragma unroll 1
            for (int t = 2; t < nt; t += 2) trip(t, BoolC<false>()); }
        else {
#pragma unroll 1
            for (int t = 0; t < nt; t += 2) trip(t, BoolC<false>()); }
        if (wr == 0) G8_BAR;
        if constexpr (FP8) asm volatile("s_nop 15\n\ts_nop 15" ::: "memory");
        E(acc, cur, wr, wc, fr, fq);
        if (!has_next) break;
#pragma unroll
        for (int a = 0; a < 2; ++a)
#pragma unroll
            for (int b = 0; b < 2; ++b)
#pragma unroll
                for (int m = 0; m < 4; ++m)
#pragma unroll
                    for (int n = 0; n < 2; ++n) {
                        if constexpr (!SP2 || !FP8) acc[a][b][m][n] = (f32x4){0.f, 0.f, 0.f, 0.f};
                        else asm volatile("" : "=v"(acc[a][b][m][n]));
                    }
        if constexpr (pre_of<Epi>::value) prev16 = E.nvm16(cur);
        cur = nxt; cA = nA; cB = nB; ++ui;
        if (wr == 1) G8_BAR;
    }
    G8_WAIT_V(0);
    G8_BAR;
#undef G8_SA
#undef G8_SB
#undef G8_STAGE_A
#undef G8_STAGE_B
#undef G8_LDA
#undef G8_LDB
#undef G8_MMA
#undef G8_MMA0
#undef G8_MMAF
#undef G8_LD32
#undef G8_WAIT_V
#undef G8_WAIT_VR
#undef G8_WAIT_L
#undef G8_BAR
#undef G8_SCHED
}

template <int NM, int NN>
struct SchedDenseT {
    static constexpr int nM = NM, nN = NN, nwg = NM * NN;
    int G, c; const char* A; const char* B; size_t atile, btile;
    __device__ __forceinline__ void init(int M_, int N_, int G_, int c_, const void* A_, size_t lda_elems, const void* B_, size_t ldb_elems) {
        (void)M_; (void)N_; G = G_; c = c_; A = (const char*)A_; B = (const char*)B_; atile = 256 * lda_elems * 2; btile = 256 * ldb_elems * 2; }
    __device__ __forceinline__ bool next(int i, Unit& u) const {
        const long L = (long)i * G + c; if (L >= nwg) return false;
        int wgid = (int)L; { constexpr int q = nwg / 8, r = nwg % 8; const int xcd = wgid % 8, off = wgid / 8; wgid = (xcd < r ? xcd * (q + 1) : r * (q + 1) + (xcd - r) * q) + off; }
        constexpr int nig = 8 * nN; const int gid = wgid / nig, fm = gid * 8, gsz = (nM - fm) < 8 ? (nM - fm) : 8;
        if constexpr (NM % 8 == 0) { u.pm = fm + ((wgid % nig) % 8); u.pn = (wgid % nig) / 8; } else { u.pm = fm + ((wgid % nig) % gsz); u.pn = (wgid % nig) / gsz; }
        u.a = A + (size_t)u.pm * atile; u.b = B + (size_t)u.pn * btile; u.grow = 0; return true;
    }
};
struct SchedUp {
    const LAS int* tileE; int ntiles, G, c; const char* A; const char* B;
    __device__ __forceinline__ bool next(int i, Unit& u) const {
        const long L = (long)i * G + c; if (L >= 2L * ntiles) return false;
        const int tile = (int)(L >> 1); u.pn = (int)(L & 1); u.pm = tile; u.grow = tile * 256;
        const int e = tile < NSH_TILES ? 64 : tileE[tile - NSH_TILES];
        u.a = A; u.b = B + ((size_t)e * 512 + (size_t)u.pn * 256) * 1024; return true;
    }
};
struct SchedDown {
    const LAS int* tileE; int nt, toff, G, c; const char* A; const char* B;
    __device__ __forceinline__ bool next(int i, Unit& u) const {
        const long L = (long)i * G + c; if (L >= 4L * nt) return false;
        const int tile = (int)(L >> 2); u.pn = (int)(L & 3); u.pm = tile; u.grow = 0;
        const int e = tileE[toff + tile];
        u.a = A + (size_t)(256 * (toff + tile)) * DEXP; u.b = B + ((size_t)e * 1024 + (size_t)u.pn * 256) * DEXP; return true;
    }
};

struct EpiBiasAct {
    static constexpr bool PERM = true; static constexpr int NVM = 16;
    bf16* O; int ldc; const float* bias; unsigned long long modes; float* vpart;
    __device__ __forceinline__ void operator()(const f32x4 (&acc)[2][2][4][2], const Unit& u, int wr, int wc, int fr, int fq) const {
        asm volatile("" : "+v"(fr), "+v"(fq));
        const int row0 = u.pm * 256 + wr * 64 + fr, col0 = u.pn * 256 + wc * 32 + 8 * fq;
        f32x4 bv[2][2];
#pragma unroll
        for (int bj = 0; bj < 2; ++bj)
#pragma unroll
            for (int n = 0; n < 2; ++n) bv[bj][n] = *(const f32x4*)(bias + col0 + bj * 128 + 4 * n);
#pragma unroll
        for (int ai = 0; ai < 2; ++ai)
#pragma unroll
            for (int m = 0; m < 4; ++m) { bf16* rowp = O + (size_t)(row0 + ai * 128 + m * 16) * ldc + col0;
#pragma unroll
                for (int bj = 0; bj < 2; ++bj) { f32x4 v0 = acc[ai][bj][m][0] + bv[bj][0], v1 = acc[ai][bj][m][1] + bv[bj][1];
#pragma unroll
                    for (int j = 0; j < 4; ++j) { v0[j] = fast_sigmoid(v0[j]); v1[j] = fast_sigmoid(v1[j]); }
                    u32x4 w; w.x = cvt_pk_bf16(v0[0], v0[1]); w.y = cvt_pk_bf16(v0[2], v0[3]); w.z = cvt_pk_bf16(v1[0], v1[1]); w.w = cvt_pk_bf16(v1[2], v1[3]);
                    *(u32x4*)(rowp + bj * 128) = w; } }
    }
};
struct EpiZ {
    static constexpr bool PERM = true, PERM2 = true, PRE = true; static constexpr int NVM = 8;
    unsigned char* Z8; bf16* ZG; const float* bias; float* vpart; bool plain;
    __device__ __forceinline__ bool nvm16(const Unit& u) const { return u.pn >= 20 || (!plain && u.pn >= 8 && u.pn < 12); }
    __device__ __forceinline__ void operator()(const f32x4 (&acc)[2][2][4][2], const Unit& u, int wr, int wc, int fr, int fq) const {
        asm volatile("" : "+v"(fr), "+v"(fq));
        const int row0 = u.pm * 256 + wr * 64 + fr, cw = wc * 64 + 16 * fq;
        f32x4 bv[2][2];
#pragma unroll
        for (int bj = 0; bj < 2; ++bj)
#pragma unroll
            for (int n = 0; n < 2; ++n) bv[bj][n] = *(const f32x4*)(bias + u.pn * 256 + cw + 8 * bj + 4 * n);
        if (u.pn >= 20) {
            const int cg = 128 * (u.pn - 20) + wc * 32 + 8 * fq;
#pragma unroll
            for (int ai = 0; ai < 2; ++ai)
#pragma unroll
                for (int m = 0; m < 4; ++m) { bf16* rowp = ZG + (size_t)(row0 + ai * 128 + m * 16) * ZGP;
                    float rr[8], sb[8];
#pragma unroll
                    for (int n = 0; n < 2; ++n)
#pragma unroll
                        for (int j = 0; j < 4; ++j) { const float ea = __builtin_amdgcn_exp2f(-1.4426950408889634f * (acc[ai][0][m][n][j] + bv[0][n][j])), eb = __builtin_amdgcn_exp2f(-1.4426950408889634f * (acc[ai][1][m][n][j] + bv[1][n][j]));
                            sb[4 * n + j] = __builtin_amdgcn_rcpf(1.0f + eb); rr[4 * n + j] = (1.0f + eb) * __builtin_amdgcn_rcpf(1.0f + ea); }
                    u32x4 w; w.x = cvt_pk_bf16(rr[0], rr[1]); w.y = cvt_pk_bf16(rr[2], rr[3]); w.z = cvt_pk_bf16(rr[4], rr[5]); w.w = cvt_pk_bf16(rr[6], rr[7]);
                    *(u32x4*)(rowp + cg) = w;
                    w.x = cvt_pk_bf16(sb[0], sb[1]); w.y = cvt_pk_bf16(sb[2], sb[3]); w.z = cvt_pk_bf16(sb[4], sb[5]); w.w = cvt_pk_bf16(sb[6], sb[7]);
                    *(u32x4*)(rowp + 1024 + cg) = w; }
            return;
        }
        if (plain || (u.pn >= 4 && u.pn < 8) || (u.pn >= 12 && u.pn < 16)) body<0, false>(acc, u, row0, cw, wc, fq, bv);
        else if (u.pn < 4) body<1, false>(acc, u, row0, cw, wc, fq, bv);
        else if (u.pn < 12) body<1, true>(acc, u, row0, cw, wc, fq, bv);
        else body<2, false>(acc, u, row0, cw, wc, fq, bv);
    }
    template <int MODE, bool STAT>
    __device__ __forceinline__ void body(const f32x4 (&acc)[2][2][4][2], const Unit& u, int row0, int cw, int wc, int fq, const f32x4 (&bv)[2][2]) const {
        float* const sink = (float*)((char*)vpart - (WS_VPART - WS_DBG)) + 2 * (16 * fq + (row0 & 15));
#pragma unroll
        for (int ai = 0; ai < 2; ++ai)
#pragma unroll
            for (int m = 0; m < 4; ++m) { u32x4 o; float ps1 = 0.f, ps2 = 0.f;
#pragma unroll
                for (int bj = 0; bj < 2; ++bj) { f32x4 v0 = acc[ai][bj][m][0] + bv[bj][0], v1 = acc[ai][bj][m][1] + bv[bj][1];
                    if constexpr (MODE == 1) { const f32x8 g = gelu8((f32x8){v0[0], v0[1], v0[2], v0[3], v1[0], v1[1], v1[2], v1[3]}); v0 = (f32x4){g[0], g[1], g[2], g[3]}; v1 = (f32x4){g[4], g[5], g[6], g[7]}; }
                    else if constexpr (MODE == 2) {
#pragma unroll
                        for (int j = 0; j < 4; ++j) { v0[j] = fast_sigmoid(v0[j]); v1[j] = fast_sigmoid(v1[j]); } }
                    if constexpr (STAT) { ps1 += ((v0[0] + v0[1]) + (v0[2] + v0[3])) + ((v1[0] + v1[1]) + (v1[2] + v1[3])); ps2 += ((v0[0] * v0[0] + v0[1] * v0[1]) + (v0[2] * v0[2] + v0[3] * v0[3])) + ((v1[0] * v1[0] + v1[1] * v1[1]) + (v1[2] * v1[2] + v1[3] * v1[3])); }
                    o[2 * bj] = pk4_fp8x16(v0[0], v0[1], v0[2], v0[3]); o[2 * bj + 1] = pk4_fp8x16(v1[0], v1[1], v1[2], v1[3]); }
                *(u32x4*)(Z8 + (size_t)(row0 + ai * 128 + m * 16) * Z8W + u.pn * 256 + cw) = o;
                if constexpr (STAT) {
                    { const auto r = __builtin_amdgcn_permlane32_swap(__float_as_uint(ps1), __float_as_uint(ps1), false, false); ps1 = __uint_as_float(r[0]) + __uint_as_float(r[1]); }
                    { const auto r = __builtin_amdgcn_permlane16_swap(__float_as_uint(ps1), __float_as_uint(ps1), false, false); ps1 = __uint_as_float(r[0]) + __uint_as_float(r[1]); }
                    { const auto r = __builtin_amdgcn_permlane32_swap(__float_as_uint(ps2), __float_as_uint(ps2), false, false); ps2 = __uint_as_float(r[0]) + __uint_as_float(r[1]); }
                    { const auto r = __builtin_amdgcn_permlane16_swap(__float_as_uint(ps2), __float_as_uint(ps2), false, false); ps2 = __uint_as_float(r[0]) + __uint_as_float(r[1]); }
                    float* const dst = fq == 0 ? vpart + ((size_t)(row0 + ai * 128 + m * 16) * 16 + (u.pn - 8) * 4 + wc) * 2 : sink;
                    *(f32x2*)dst = (f32x2){ps1, ps2}; } }
    }
};
struct EpiOut8 {
    static constexpr bool PERM = true, PERM2 = true; static constexpr int NVM = 8;
    unsigned char* O; int ldc;
    __device__ __forceinline__ void operator()(const f32x4 (&acc)[2][2][4][2], const Unit& u, int wr, int wc, int fr, int fq) const {
        asm volatile("" : "+v"(fr), "+v"(fq));
        const int row0 = u.pm * 256 + wr * 64 + fr, col0 = u.pn * 256 + wc * 64 + 16 * fq;
        float sc256 = 256.f; asm volatile("" : "+s"(sc256));
#pragma unroll
        for (int ai = 0; ai < 2; ++ai)
#pragma unroll
            for (int m = 0; m < 4; ++m) { u32x4 o;
#pragma unroll
                for (int bj = 0; bj < 2; ++bj)
#pragma unroll
                    for (int n = 0; n < 2; ++n) { const f32x4 v = acc[ai][bj][m][n] * sc256;
                        int a = __builtin_amdgcn_cvt_pk_fp8_f32(v[0], v[1], 0, false); a = __builtin_amdgcn_cvt_pk_fp8_f32(v[2], v[3], a, true); o[2 * bj + n] = (unsigned)a; }
                *(u32x4*)(O + (size_t)(row0 + ai * 128 + m * 16) * ldc + col0) = o; }
    }
};
struct EpiGate {
    static constexpr bool PERM = true; static constexpr int NVM = 32;
    const bf16* gate; int ldg, gcol; const bf16* add; int lda_, acol; bf16* O; int ldo, ocol; bool o8;
    __device__ __forceinline__ void operator()(const f32x4 (&acc)[2][2][4][2], const Unit& u, int wr, int wc, int fr, int fq) const {
        asm volatile("" : "+v"(fr), "+v"(fq));
        const int row0 = u.pm * 256 + wr * 64 + fr, col0 = u.pn * 256 + wc * 32 + 8 * fq;
        u32x4 g[2][4][2];
#pragma unroll
        for (int ai = 0; ai < 2; ++ai)
#pragma unroll
            for (int m = 0; m < 4; ++m) { const size_t r = (size_t)(row0 + ai * 128 + m * 16);
#pragma unroll
                for (int bj = 0; bj < 2; ++bj) g[ai][m][bj] = *(const u32x4*)(gate + r * ldg + gcol + col0 + bj * 128); }
#pragma unroll
        for (int ai = 0; ai < 2; ++ai)
#pragma unroll
            for (int m = 0; m < 4; ++m) { const size_t r = (size_t)(row0 + ai * 128 + m * 16);
#pragma unroll
                for (int bj = 0; bj < 2; ++bj) { const int c = col0 + bj * 128; const u32x4 gg = g[ai][m][bj];
                    f32x4 v0 = acc[ai][bj][m][0], v1 = acc[ai][bj][m][1];
                    v0[0] *= bflo(gg.x); v0[1] *= bfhi(gg.x); v0[2] *= bflo(gg.y); v0[3] *= bfhi(gg.y);
                    v1[0] *= bflo(gg.z); v1[1] *= bfhi(gg.z); v1[2] *= bflo(gg.w); v1[3] *= bfhi(gg.w);
                    if (o8) *(u32x2*)((unsigned char*)(O + r * ldo + ocol) + c) = (u32x2){pk4_fp8x16(v0[0], v0[1], v0[2], v0[3]), pk4_fp8x16(v1[0], v1[1], v1[2], v1[3])};
                    else { u32x4 w; w.x = cvt_pk_bf16(v0[0], v0[1]); w.y = cvt_pk_bf16(v0[2], v0[3]); w.z = cvt_pk_bf16(v1[0], v1[1]); w.w = cvt_pk_bf16(v1[2], v1[3]);
                        *(u32x4*)(O + r * ldo + ocol + c) = w; } } }
    }
};
struct EpiResid {
    static constexpr bool PERM = true; static constexpr int NVM = 32;
    const float* xf; bf16* XR;
    __device__ __forceinline__ void operator()(const f32x4 (&acc)[2][2][4][2], const Unit& u, int wr, int wc, int fr, int fq) const {
        asm volatile("" : "+v"(fr), "+v"(fq));
        const int row0 = u.pm * 256 + wr * 64 + fr, col0 = u.pn * 256 + wc * 32 + 8 * fq;
        float alpha = ALPHA; asm volatile("" : "+s"(alpha));
        if (!xf) {
            u32x4 q[2][4][2];
#pragma unroll
            for (int ai = 0; ai < 2; ++ai)
#pragma unroll
                for (int m = 0; m < 4; ++m)
#pragma unroll
                    for (int bj = 0; bj < 2; ++bj) q[ai][m][bj] = __builtin_nontemporal_load((const u32x4*)(XR + (size_t)(row0 + ai * 128 + m * 16) * D + col0 + bj * 128));
#pragma unroll
            for (int ai = 0; ai < 2; ++ai)
#pragma unroll
                for (int m = 0; m < 4; ++m)
#pragma unroll
                    for (int bj = 0; bj < 2; ++bj) { const u32x4 qq = q[ai][m][bj];
                        const f32x4 r0 = (f32x4){bflo(qq.x), bfhi(qq.x), bflo(qq.y), bfhi(qq.y)} * alpha + acc[ai][bj][m][0], r1 = (f32x4){bflo(qq.z), bfhi(qq.z), bflo(qq.w), bfhi(qq.w)} * alpha + acc[ai][bj][m][1];
                        u32x4 w; w.x = cvt_pk_bf16(r0[0], r0[1]); w.y = cvt_pk_bf16(r0[2], r0[3]); w.z = cvt_pk_bf16(r1[0], r1[1]); w.w = cvt_pk_bf16(r1[2], r1[3]);
                        *(u32x4*)(XR + (size_t)(row0 + ai * 128 + m * 16) * D + col0 + bj * 128) = w; }
            return;
        }
#pragma unroll
        for (int ai = 0; ai < 2; ++ai)
#pragma unroll
            for (int mh = 0; mh < 2; ++mh) {
                f32x4 x[2][2][2];
#pragma unroll
                for (int m2 = 0; m2 < 2; ++m2) { const size_t off = (size_t)(row0 + ai * 128 + (2 * mh + m2) * 16) * D + col0;
#pragma unroll
                    for (int bj = 0; bj < 2; ++bj) {
                        if (xf) { x[m2][bj][0] = __builtin_nontemporal_load((const f32x4*)(xf + off + bj * 128)); x[m2][bj][1] = __builtin_nontemporal_load((const f32x4*)(xf + off + bj * 128 + 4)); }
                        else { const u32x4 q = *(const u32x4*)(XR + off + bj * 128); x[m2][bj][0] = (f32x4){bflo(q.x), bfhi(q.x), bflo(q.y), bfhi(q.y)}; x[m2][bj][1] = (f32x4){bflo(q.z), bfhi(q.z), bflo(q.w), bfhi(q.w)}; } } }
#pragma unroll
                for (int m2 = 0; m2 < 2; ++m2) { const size_t off = (size_t)(row0 + ai * 128 + (2 * mh + m2) * 16) * D + col0;
#pragma unroll
                    for (int bj = 0; bj < 2; ++bj) { const f32x4 r0 = x[m2][bj][0] * alpha + acc[ai][bj][2 * mh + m2][0], r1 = x[m2][bj][1] * alpha + acc[ai][bj][2 * mh + m2][1];
                        u32x4 w; w.x = cvt_pk_bf16(r0[0], r0[1]); w.y = cvt_pk_bf16(r0[2], r0[3]); w.z = cvt_pk_bf16(r1[0], r1[1]); w.w = cvt_pk_bf16(r1[2], r1[3]);
                        *(u32x4*)(XR + off + bj * 128) = w; } }
                asm volatile("" ::: "memory");
            }
    }
};
struct EpiMoeUp {
    static constexpr bool PERM = true; static constexpr int NVM = 16;
    bf16* HID; const float* SW; bf16* PBH;
    __device__ __forceinline__ void operator()(const f32x4 (&acc)[2][2][4][2], const Unit& u, int wr, int wc, int fr, int fq) const {
        asm volatile("" : "+v"(fr), "+v"(fq));
        const int rl0 = wr * 64 + fr, col0 = u.pn * 128 + wc * 32 + 8 * fq;
        float wv[2][4];
#pragma unroll
        for (int ai = 0; ai < 2; ++ai)
#pragma unroll
            for (int m = 0; m < 4; ++m) wv[ai][m] = SW[(size_t)u.grow + rl0 + ai * 128 + m * 16];
        if (u.pm < NSH_TILES) body<true>(acc, u, rl0, col0, wv); else body<false>(acc, u, rl0, col0, wv);
    }
    template <bool SH>
    __device__ __forceinline__ void body(const f32x4 (&acc)[2][2][4][2], const Unit& u, int rl0, int col0, const float (&wv)[2][4]) const {
#pragma unroll
        for (int ai = 0; ai < 2; ++ai)
#pragma unroll
            for (int m = 0; m < 4; ++m) { const size_t r = (size_t)u.grow + rl0 + ai * 128 + m * 16; const float w = wv[ai][m];
                float h[8];
#pragma unroll
                for (int n = 0; n < 2; ++n)
#pragma unroll
                    for (int j = 0; j < 4; ++j) { const float g = acc[ai][0][m][n][j], up = acc[ai][1][m][n][j]; h[4 * n + j] = g * fast_sigmoid(g) * up * w; }
                if constexpr (SH) *(u32x2*)((unsigned char*)PBH + r * 512 + 256 + col0) = (u32x2){pk4_fp8x16(h[0], h[1], h[2], h[3]), pk4_fp8x16(h[4], h[5], h[6], h[7])};
                else *(u32x2*)((unsigned char*)HID + (r - M) * DEXP + col0) = (u32x2){pk4_fp8x16(h[0], h[1], h[2], h[3]), pk4_fp8x16(h[4], h[5], h[6], h[7])}; }
    }
};
struct MidMulP {
    static constexpr bool ON = true;
    const bf16* Rp; int ld, cr;
    __device__ __forceinline__ void operator()(f32x4 (&acc)[2][2][4][2], const Unit& u, int wr, int wc, int fr, int fq) const {
        asm volatile("" : "+v"(fr), "+v"(fq));
        const char* base = (const char*)Rp + ((size_t)u.pm * 256 * ld + (size_t)u.pn * 256 + cr) * 2;
        const unsigned lo = (unsigned)((wr * 64 + fr) * ld + wc * 32 + 8 * fq) * 2u;
#pragma unroll
        for (int ai = 0; ai < 2; ++ai) {
            u32x4 g[4][2];
#pragma unroll
            for (int m = 0; m < 4; ++m) { const unsigned ro = lo + (unsigned)((ai * 128 + m * 16) * ld) * 2u;
#pragma unroll
                for (int bj = 0; bj < 2; ++bj) g[m][bj] = *(const u32x4*)(base + ro + (unsigned)(bj * 128) * 2u); }
#pragma unroll
            for (int m = 0; m < 4; ++m)
#pragma unroll
                for (int bj = 0; bj < 2; ++bj) { const u32x4 a = g[m][bj];
                    acc[ai][bj][m][0][0] *= bflo(a.x); acc[ai][bj][m][0][1] *= bfhi(a.x); acc[ai][bj][m][0][2] *= bflo(a.y); acc[ai][bj][m][0][3] *= bfhi(a.y);
                    acc[ai][bj][m][1][0] *= bflo(a.z); acc[ai][bj][m][1][1] *= bfhi(a.z); acc[ai][bj][m][1][2] *= bflo(a.w); acc[ai][bj][m][1][3] *= bfhi(a.w); }
            asm volatile("" ::: "memory");
        }
    }
};
struct MidMul {
    static constexpr bool ON = true;
    const bf16* G;
    __device__ __forceinline__ void operator()(f32x4 (&acc)[2][2][4][2], const Unit& u, int wr, int wc, int fr, int fq) const {
        asm volatile("" : "+v"(fr), "+v"(fq));
        const char* base = (const char*)G + ((size_t)u.pm * 256 * D + (size_t)u.pn * 256) * 2;
        const unsigned lo = (unsigned)((wr * 64 + fr) * D + wc * 32 + 4 * fq) * 2u;
#pragma unroll
        for (int ai = 0; ai < 2; ++ai)
#pragma unroll
            for (int mh = 0; mh < 2; ++mh) {
                u32x2 g[2][2][2];
#pragma unroll
                for (int m2 = 0; m2 < 2; ++m2) { const unsigned ro = lo + (unsigned)((ai * 128 + (2 * mh + m2) * 16) * D) * 2u;
#pragma unroll
                    for (int bj = 0; bj < 2; ++bj)
#pragma unroll
                        for (int n = 0; n < 2; ++n) g[m2][bj][n] = *(const u32x2*)(base + ro + (unsigned)(bj * 128 + n * 16) * 2u); }
#pragma unroll
                for (int m2 = 0; m2 < 2; ++m2)
#pragma unroll
                    for (int bj = 0; bj < 2; ++bj)
#pragma unroll
                        for (int n = 0; n < 2; ++n) { const u32x2 a = g[m2][bj][n]; const int m = 2 * mh + m2; acc[ai][bj][m][n][0] *= bflo(a.x); acc[ai][bj][m][n][1] *= bfhi(a.x); acc[ai][bj][m][n][2] *= bflo(a.y); acc[ai][bj][m][n][3] *= bfhi(a.y); }
                asm volatile("" ::: "memory");
            }
    }
};
}

struct KArgs { const float* in[27]; float* out; unsigned char* ws; int ph_lo, ph_hi, dbg, pad; };
enum { I_X = 0, I_P, I_WIN, I_BIN, I_SGG, I_SGB, I_WS, I_BS, I_MHG, I_WPA, I_WPB, I_WOUT, I_LN1G, I_LN1B, I_WR, I_BR, I_WGE, I_WUE, I_WDE, I_WGS, I_WUS, I_WDS, I_WPG, I_BPG, I_WP, I_LN2G, I_LN2B };
constexpr int NPH = 12;

struct Ctx {
    LAS unsigned char* lds; int vcu, G;
    float* out; unsigned char* ws;
};
#define WSP(T, off) ((T*)(C.ws + (off)))
#define INP(k) ((const float*)g8::uni_ptr((const char*)(*(const LAS unsigned long long*)(C.lds + LDS_PTRS + 8 * (k)))))
template <class T> __device__ __forceinline__ T* opq_ptr(T* p) { const unsigned long long v = (unsigned long long)p; unsigned lo = __builtin_amdgcn_readfirstlane((unsigned)v), hi = __builtin_amdgcn_readfirstlane((unsigned)(v >> 32));
    asm volatile("" : "+s"(lo), "+s"(hi)); return (T*)(GAS T*)(((unsigned long long)hi << 32) | lo); }
__device__ __forceinline__ int opq_int(int v) { int r = __builtin_amdgcn_readfirstlane(v); asm volatile("" : "+s"(r)); return r; }
#define CTX_LOCAL(Csrc) Ctx C = (Csrc); C.ws = opq_ptr(C.ws); C.out = opq_ptr(C.out); C.vcu = opq_int(C.vcu); C.G = opq_int(C.G)
#define PHASE_IDS() const int tid = fresh_tid(), lane = tid & 63, w = __builtin_amdgcn_readfirstlane(tid >> 6); (void)lane; (void)w

__device__ __forceinline__ void tr_item(const float* src, int ld, bf16* dst, int K, float scale, LAS float* scr, int lane, bool quant = false) {
    float tv[32];
    const char* sb = g8::uni_ptr((const char*)src); const unsigned o0 = (unsigned)((lane >> 5) * ld + (lane & 31)) * 4u;
#pragma unroll
    for (int i = 0; i < 32; ++i) tv[i] = *(const float*)(sb + o0 + (unsigned)(2 * i * ld) * 4u);
#pragma unroll
    for (int i = 0; i < 32; ++i) scr[(2 * i + (lane >> 5)) * 33 + (lane & 31)] = quant ? q8(tv[i] * scale, kf(256.f), kf(1.f / 256.f)) : tv[i] * scale;
    LDS_WAIT(); asm volatile("" ::: "memory");
    const int c = lane & 7;
#pragma unroll
    for (int j = 0; j < 4; ++j) { const int n = (lane >> 3) + 8 * j; const LAS float* s = scr + (8 * c) * 33 + n;
        u32x4 o; o.x = cvt_pk_bf16(s[0 * 33], s[1 * 33]); o.y = cvt_pk_bf16(s[2 * 33], s[3 * 33]);
        o.z = cvt_pk_bf16(s[4 * 33], s[5 * 33]); o.w = cvt_pk_bf16(s[6 * 33], s[7 * 33]);
        *(u32x4*)(dst + (size_t)n * K + 8 * c) = o; }
    LDS_WAIT(); asm volatile("" ::: "memory");
}
__device__ __forceinline__ void tr_item8(const float* src, int ld, unsigned char* dst, int K, float scale, LAS float* scr, int lane, int lanecol = -1) {
    const char* sb = g8::uni_ptr((const char*)src); const unsigned o0 = (unsigned)((lane >> 5) * ld + (lanecol >= 0 ? lanecol : (lane & 31))) * 4u;
#pragma unroll
    for (int hk = 0; hk < 2; ++hk) { float tv[32];
#pragma unroll
        for (int i = 0; i < 32; ++i) tv[i] = __builtin_nontemporal_load((const float*)(sb + o0 + (unsigned)((64 * hk + 2 * i) * ld) * 4u));
#pragma unroll
        for (int i = 0; i < 32; ++i) scr[(64 * hk + 2 * i + (lane >> 5)) * 33 + (lane & 31)] = tv[i] * (scale * kf(256.0f)); }
    LDS_WAIT(); asm volatile("" ::: "memory");
    const int c = lane & 7;
#pragma unroll
    for (int j = 0; j < 4; ++j) { const int n = (lane >> 3) + 8 * j; const LAS float* s = scr + (16 * c) * 33 + n;
        u32x4 o;
#pragma unroll
        for (int q = 0; q < 4; ++q) { int w = __builtin_amdgcn_cvt_pk_fp8_f32(s[(4 * q) * 33], s[(4 * q + 1) * 33], 0, false); w = __builtin_amdgcn_cvt_pk_fp8_f32(s[(4 * q + 2) * 33], s[(4 * q + 3) * 33], w, true); o[q] = (unsigned)w; }
        *(u32x4*)(dst + (size_t)n * K + 16 * c) = o; }
    LDS_WAIT(); asm volatile("" ::: "memory");
}
__device__ __forceinline__ int win_src_col(int dcol) {
    return dcol < 1024 ? dcol : dcol < 2048 ? 3072 + (dcol - 1024) : dcol < 3072 ? 1024 + (dcol - 2048) : dcol < 3584 ? 2048 + (dcol - 3072) : dcol < 4096 ? 2560 + (dcol - 3584)
         : dcol < 5120 ? 4096 + (dcol - 4096) : (((dcol - 5120) >> 3) & 1) ? 6152 + 128 * ((dcol - 5120) >> 8) + 32 * (((dcol - 5120) & 255) >> 6) + 8 * ((((dcol - 5120) & 255) >> 4) & 3) + ((dcol - 5120) & 7)
                                                                        : 5128 + 128 * ((dcol - 5120) >> 8) + 32 * (((dcol - 5120) & 255) >> 6) + 8 * ((((dcol - 5120) & 255) >> 4) & 3) + ((dcol - 5120) & 7);
}
__device__ __forceinline__ void emit_xb_gates(const f32x4 (&v)[4], int m, bf16* XB, float* IFp, const LAS float* wif, const float* bif, int lane) {
    float g[8];
#pragma unroll
    for (int q = 0; q < 8; ++q) g[q] = 0.f;
#pragma unroll
    for (int j = 0; j < 4; ++j) {
        { int w8 = __builtin_amdgcn_cvt_pk_fp8_f32(v[j][0] * 16.f, v[j][1] * 16.f, 0, false); w8 = __builtin_amdgcn_cvt_pk_fp8_f32(v[j][2] * 16.f, v[j][3] * 16.f, w8, true);
          *(int*)((unsigned char*)XB + (size_t)m * D + 256 * j + 4 * lane) = w8; }
#pragma unroll
        for (int e = 0; e < 4; ++e) { const int k = 256 * j + 4 * lane + e; const f32x4 w0 = *(const LAS f32x4*)(wif + k * 8), w1 = *(const LAS f32x4*)(wif + k * 8 + 4); const float x = v[j][e];
            g[0] += x * w0[0]; g[1] += x * w0[1]; g[2] += x * w0[2]; g[3] += x * w0[3]; g[4] += x * w1[0]; g[5] += x * w1[1]; g[6] += x * w1[2]; g[7] += x * w1[3]; }
    }
#pragma unroll
    for (int q = 0; q < 8; ++q) g[q] = wave_sum(g[q]);
    if (lane == 0) { *(f32x4*)(IFp + (size_t)m * 8) = (f32x4){g[0] + bif[0], g[1] + bif[1], g[2] + bif[2], g[3] + bif[3]}; *(f32x4*)(IFp + (size_t)m * 8 + 4) = (f32x4){g[4] + bif[4], g[5] + bif[5], g[6] + bif[6], g[7] + bif[7]}; }
}
__device__ __forceinline__ void load_wif(const Ctx& C0, int l, LAS float* wif) {
    CTX_LOCAL(C0);
    const float* win = INP(I_WIN) + (size_t)l * D * DIN;
    for (int i = fresh_tid(); i < 1024 * 8; i += 512) wif[i] = win[(size_t)(i >> 3) * DIN + 5120 + (i & 7)];
    __syncthreads();
}
__device__ __forceinline__ void phase_convert(const Ctx& C0, int l, bool with_x0) {
    CTX_LOCAL(C0);
    PHASE_IDS();
    const int gw = C.vcu * 8 + w, NGW = C.G * 8;
    LAS float* scr = (LAS float*)(C.lds + w * 16896);
    const float* win = INP(I_WIN) + (size_t)l * D * DIN;
    bf16* WinT = WSP(bf16, WS_WIN); bf16* W4 = WSP(bf16, WS_W4); bf16* UpT = WSP(bf16, WS_UPT); bf16* DnT = WSP(bf16, WS_DNT); bf16* WpT = WSP(bf16, WS_WPT);
    constexpr int N0 = 1792, N1 = 768 + 256, N2 = 65 * 128, N3 = 64 * 64 + 64, N4 = 64, NIT = N0 + N1 + N2 + N3 + N4;
    LAS float* scr8 = scr;
    for (int it = gw; it < NIT; it += NGW) {
        int r = it;
        if (r < N0) { const int kb = r / 224, nb = r % 224, dcol = 32 * nb; const int sc = win_src_col(dcol); const float sq = (dcol >= ZQ && dcol < ZK) ? kf(QSCALE) : 1.0f;
            tr_item8(win + (size_t)(128 * kb) * DIN, DIN, (unsigned char*)WinT + (size_t)dcol * D + 128 * kb, D, sq, scr8, lane, win_src_col(dcol + (lane & 31))); (void)sc; continue; }
        r -= N0;
        if (r < N1) {
            if (r < 512) { const int which = r >> 8, rr = r & 255, kb = rr >> 5, nb = rr & 31;
                tr_item8((which == 0 ? INP(I_WPA) : INP(I_WPB)) + (size_t)l * D * D + (size_t)(128 * kb) * D + 32 * nb, D, (unsigned char*)W4 + (size_t)(32 * nb) * 2048 + which * 1024 + 128 * kb, 2048, 1.0f, scr, lane); }
            else if (r < 768) { const int rr = r - 512, kb = rr >> 5, nb = rr & 31;
                tr_item8(INP(I_WOUT) + (size_t)l * D * D + (size_t)(128 * kb) * D + 32 * nb, D, (unsigned char*)(W4 + (size_t)2 * D * D) + (size_t)(32 * nb) * D + 128 * kb, D, 1.0f, scr, lane); }
            else { const int rr = r - 768, kb = rr >> 5, nb = rr & 31;
                tr_item8(INP(I_WPG) + (size_t)l * D * D + (size_t)(128 * kb) * D + 32 * nb, D, (unsigned char*)(W4 + (size_t)3 * D * D) + (size_t)(32 * nb) * D + 128 * kb, D, 1.0f, scr, lane); }
            continue; }
        r -= N1;
        if (r < N2) { const int e = r >> 7, rr = r & 127, isup = rr >> 6, r2 = rr & 63, kb = r2 >> 3, cb = r2 & 7;
            const float* src = e < 64 ? ((isup ? INP(I_WUE) : INP(I_WGE)) + ((size_t)l * 64 + e) * D * DEXP) : ((isup ? INP(I_WUS) : INP(I_WGS)) + (size_t)l * D * DEXP);
            const int drow = (cb >> 2) * 256 + isup * 128 + (cb & 3) * 32;
            tr_item8(src + (size_t)(128 * kb) * DEXP + 32 * cb, DEXP, (unsigned char*)UpT + ((size_t)e * 512 + drow) * D + 128 * kb, D, 1.0f, scr, lane); continue; }
        r -= N2;
        if (r < N3) {
            if (r < 64 * 64) { const int e = r >> 6, rr = r & 63, kb = rr >> 5, nb = rr & 31;
                tr_item8(INP(I_WDE) + ((size_t)l * 64 + e) * DEXP * D + (size_t)(128 * kb) * D + 32 * nb, D, (unsigned char*)DnT + (size_t)e * D * DEXP + (size_t)(32 * nb) * DEXP + 128 * kb, DEXP, 1.0f, scr, lane); }
            else { const int rr = r - 64 * 64, kb = rr >> 5, nb = rr & 31;
                tr_item8(INP(I_WDS) + (size_t)l * DEXP * D + (size_t)(128 * kb) * D + 32 * nb, D, (unsigned char*)WpT + (size_t)(32 * nb) * 512 + 256 + 128 * kb, 512, 1.0f, scr, lane); }
            continue; }
        r -= N3;
        { const int kb = r >> 5, nb = r & 31; const float* src = INP(I_WP) + (size_t)l * PD * D;
            tr_item8(src + (size_t)(128 * kb) * D + 32 * nb, D, (unsigned char*)WpT + (size_t)(32 * nb) * 512 + 128 * kb, 512, 1.0f, scr, lane); }
    }
    const int gt = C.vcu * 512 + tid, NGT = C.G * 512;
    {
        float* b1 = WSP(float, WS_BIAS1); const float* bin = INP(I_BIN) + (size_t)l * DIN;
        for (int j = gt; j < ZW; j += NGT) b1[j] = bin[win_src_col(j)] * ((j >= ZQ && j < ZK) ? kf(QSCALE) : 1.0f);
        bf16* wsb = WSP(bf16, WS_WSB); const float* wsf = INP(I_WS) + (size_t)l * 8 * 128 * 128;
        for (int j = gt; j < 8 * 128 * 128; j += NGT) { const int t = (j >> 7) & 127, s = j & 127; wsb[j] = ((s >> 6) <= (t >> 6)) ? f2bf(wsf[j]) : (bf16)0; }
    }
    if (with_x0) {
        __syncthreads();
        LAS float* wif = (LAS float*)C.lds;
        load_wif(C, 0, wif);
        const float* bif = INP(I_BIN) + 5120;
        for (int m = gw; m < M; m += NGW) { f32x4 v[4];
#pragma unroll
            for (int j = 0; j < 4; ++j) v[j] = *(const f32x4*)(INP(I_X) + (size_t)m * D + 256 * j + 4 * lane);
            emit_xb_gates(v, m, WSP(bf16, WS_XB), WSP(float, WS_IF), wif, bif, lane); }
    }
}

__device__ __forceinline__ void convert_pb(const Ctx& C0, int l) {
    CTX_LOCAL(C0);
    const int gt = C.vcu * 512 + fresh_tid(), NGT = C.G * 512;
    const f32x4* p4 = (const f32x4*)(INP(I_P) + (size_t)l * M * PD); unsigned char* o = WSP(unsigned char, WS_PBH);
    for (int j = gt; j < M * PD / 16; j += NGT) { const f32x4 a = __builtin_nontemporal_load(p4 + 4 * j), b = __builtin_nontemporal_load(p4 + 4 * j + 1), c = __builtin_nontemporal_load(p4 + 4 * j + 2), d = __builtin_nontemporal_load(p4 + 4 * j + 3);
        *(u32x4*)(o + (size_t)(j >> 4) * 512 + (j & 15) * 16) = (u32x4){pk4_fp8x16(a[0], a[1], a[2], a[3]), pk4_fp8x16(b[0], b[1], b[2], b[3]), pk4_fp8x16(c[0], c[1], c[2], c[3]), pk4_fp8x16(d[0], d[1], d[2], d[3])}; }
}
__device__ __forceinline__ void phase_gates(const Ctx& C0) {
    CTX_LOCAL(C0);
    PHASE_IDS();
    const int gw = C.vcu * 8 + w, NGW = C.G * 8;
    const float* IFp = WSP(float, WS_IF); float* BC = WSP(float, WS_BC); float* BL = WSP(float, WS_BL); float* GM = WSP(float, WS_GM);
    for (int task = gw; task < 32 * NCH; task += NGW) {
        const int bh = task >> 7, c = task & 127, b = bh >> 2, h = bh & 3; const size_t m = (size_t)b * SEQ + 64 * c + lane;
        const float ip = IFp[m * 8 + h], fp = IFp[m * 8 + 4 + h];
        const float lf = fminf(fp, 0.f) - __builtin_amdgcn_logf(1.0f + __builtin_amdgcn_exp2f(-fabsf(fp) * kf(1.4426950408889634f))) * kf(0.6931471805599453f);
        float v = lf;
#pragma unroll
        for (int o = 1; o < 64; o <<= 1) { const float t = shfl_idx(v, lane - o); if (lane >= o) v += t; }
        const float blast = rdlane(v, 63);
        const float gmax = wave_max(blast - v + ip);
        BC[m * 4 + h] = v;
        if (lane == 0) { BL[task] = blast; GM[task] = gmax; }
    }
}
__device__ __forceinline__ void mstate(const float* BL, const float* GM, int bh, int c, int lane, float& mc, float& mn) {
    const float bl0 = BL[bh * 128 + lane], bl1 = BL[bh * 128 + 64 + lane], gm0 = GM[bh * 128 + lane], gm1 = GM[bh * 128 + 64 + lane];
    float m = 0.f, prev = 0.f;
    for (int cc = 0; cc <= c; ++cc) {
        const float bl = __shfl(cc < 64 ? bl0 : bl1, cc & 63), gm = __shfl(cc < 64 ? gm0 : gm1, cc & 63);
        prev = m; m = fmaxf(bl + m, gm);
    }
    mc = prev; mn = m;
}

__device__ __forceinline__ void phase_sgu(const Ctx& C0, int l) {
    CTX_LOCAL(C0);
    PHASE_IDS();
    const unsigned char* Z8 = WSP(unsigned char, WS_Z); const float* VP = WSP(float, WS_VPART); unsigned char* AB8 = (unsigned char*)C.out;
    constexpr int PW = 272;
    LAS unsigned char* Wt = C.lds; LAS unsigned char* Vn = C.lds + 128 * PW; LAS float* Dt = (LAS float*)(C.lds + 2 * 128 * PW);
    LAS f32x2* Sst = (LAS f32x2*)(C.lds + 2 * 128 * PW + 128 * 132 * 4);
#define SGU_STATS(mrow, slot) do { if (tid < 128) { const f32x4* p_ = (const f32x4*)(VP + ((mrow) + tid) * 32); float s1_ = 0.f, s2_ = 0.f; \
        _Pragma("unroll") for (int k_ = 0; k_ < 8; ++k_) { const f32x4 q_ = p_[k_]; s1_ += q_[0] + q_[2]; s2_ += q_[1] + q_[3]; } \
        const float mean_ = s1_ * (1.0f / 1024.0f), var_ = fmaxf(s2_ * (1.0f / 1024.0f) - mean_ * mean_, 0.f); Sst[(slot) * 128 + tid] = (f32x2){mean_, __builtin_amdgcn_rsqf(var_ + kf(LN_EPS))}; } } while (0)
    const int ch = tid & 7, r0 = tid >> 3;
    const int chw = tid & 15, rw = tid >> 4;
    int gcur = -1; f32x4 gg[4], bb[4]; float bt[2];
    u32x4 pv[2]; int it = 0;
    int u = C.vcu;
    if (u < 4096) { const size_t m0 = (size_t)(u >> 3) * 128; const int g = u & 7;
#pragma unroll
        for (int i = 0; i < 2; ++i) pv[i] = *(const u32x4*)(Z8 + (m0 + r0 + 64 * i) * Z8W + ZV + 128 * g + 16 * ch);
        SGU_STATS(m0, 0); }
    __syncthreads();
    for (; u < 4096; u += C.G, ++it) {
        const int g = u & 7; const size_t m0 = (size_t)(u >> 3) * 128;
        if (g != gcur) {
            if (gcur >= 0) __syncthreads();
            gcur = g;
            const bf16* wsb = WSP(bf16, WS_WSB) + (size_t)g * 128 * 128;
#pragma unroll
            for (int i = 0; i < 4; ++i) *(LAS u32x4*)(Wt + (rw + 32 * i) * PW + chw * 16) = *(const u32x4*)(wsb + (rw + 32 * i) * 128 + chw * 8);
            const float* lng = INP(I_SGG) + (size_t)l * 1024 + 128 * g; const float* lnb = INP(I_SGB) + (size_t)l * 1024 + 128 * g; const float* bs = INP(I_BS) + (size_t)l * 1024 + 128 * g;
#pragma unroll
            for (int q = 0; q < 4; ++q) { gg[q] = *(const f32x4*)(lng + 16 * ch + 4 * q); bb[q] = *(const f32x4*)(lnb + 16 * ch + 4 * q); }
#pragma unroll
            for (int i = 0; i < 2; ++i) bt[i] = bs[r0 + 64 * i];
        }
#pragma unroll
        for (int i = 0; i < 2; ++i) { const f32x2 st = Sst[(it & 1) * 128 + r0 + 64 * i]; float x[16]; un16_fp8x16(pv[i], x);
#pragma unroll
            for (int q = 0; q < 4; ++q)
#pragma unroll
                for (int j = 0; j < 4; ++j) x[4 * q + j] = (x[4 * q + j] - st.x) * st.y * gg[q][j] + bb[q][j];
            bf16x16_to_lds(Vn + (r0 + 64 * i) * PW + ch * 32, x); }
        __syncthreads();
        const int un = u + C.G;
        if (un < 4096) { const size_t mn = (size_t)(un >> 3) * 128; const int gn = un & 7;
#pragma unroll
            for (int i = 0; i < 2; ++i) pv[i] = *(const u32x4*)(Z8 + (mn + r0 + 64 * i) * Z8W + ZV + 128 * gn + 16 * ch);
            SGU_STATS(mn, (it + 1) & 1); }
        u32x4 pu[2];
#pragma unroll
        for (int i = 0; i < 2; ++i) pu[i] = *(const u32x4*)(Z8 + (m0 + r0 + 64 * i) * Z8W + ZU + 128 * g + 16 * ch);
        f32x4 acc[8];
#pragma unroll
        for (int j = 0; j < 8; ++j) acc[j] = (f32x4){0.f, 0.f, 0.f, 0.f};
#pragma unroll
        for (int ks = 0; ks < 4; ++ks) { const bf16x8 a = frag_row(Wt, PW, 16 * w, 32 * ks, lane);
#pragma unroll
            for (int j = 0; j < 8; ++j) acc[j] = MFMA16(a, frag_tr(Vn, PW, 32 * ks, 16 * j, lane), acc[j]); }
#pragma unroll
        for (int j = 0; j < 8; ++j)
#pragma unroll
            for (int r = 0; r < 4; ++r) Dt[(16 * w + 4 * (lane >> 4) + r) * 132 + 16 * j + (lane & 15)] = acc[j][r];
        __syncthreads();
#pragma unroll
        for (int i = 0; i < 2; ++i) { const int t = r0 + 64 * i; const float bq = bt[i]; float uu[16]; un16_fp8x16(pu[i], uu); u32x4 o;
#pragma unroll
            for (int q = 0; q < 4; ++q) { const f32x4 d = *(const LAS f32x4*)(Dt + t * 132 + 16 * ch + 4 * q);
                o[q] = pk4_fp8x16(uu[4 * q] * (d[0] + bq), uu[4 * q + 1] * (d[1] + bq), uu[4 * q + 2] * (d[2] + bq), uu[4 * q + 3] * (d[3] + bq)); }
            *(u32x4*)(AB8 + (m0 + t) * 2048 + 128 * g + 16 * ch) = o; }
    }
    __syncthreads();
#undef SGU_STATS
}

__device__ __forceinline__ void phase_kv(const Ctx& C0) {
    CTX_LOCAL(C0);
    PHASE_IDS();
    const unsigned char* Z8 = WSP(unsigned char, WS_Z); const float* IFp = WSP(float, WS_IF); const float* BC = WSP(float, WS_BC); const float* BL = WSP(float, WS_BL); const float* GM = WSP(float, WS_GM);
    constexpr int PV = 528, PK = 272, PO = 144;
    LAS unsigned char* Vs = C.lds; LAS unsigned char* Ks = C.lds + 64 * PV; LAS unsigned char* Ot = C.lds + 64 * PV + 64 * PK;
    const int sv = tid >> 4, chv = tid & 15, sk = tid >> 3, chk = tid & 7;
    u32x4 pv[2], pk; float pbc, pif;
    int u = C.vcu;
    if (u < 4096) { const int bh = u >> 7, c = u & 127, b = bh >> 2, h = bh & 3; const size_t m0 = (size_t)b * SEQ + 64 * c;
#pragma unroll
        for (int i = 0; i < 2; ++i) pv[i] = *(const u32x4*)(Z8 + (m0 + sv + 32 * i) * Z8W + ZVM + 256 * h + 16 * chv);
        pk = *(const u32x4*)(Z8 + (m0 + sk) * Z8W + ZK + 128 * h + 16 * chk); pbc = BC[(m0 + sk) * 4 + h]; pif = IFp[(m0 + sk) * 8 + h]; }
    for (; u < 4096; u += C.G) {
        const int bh = u >> 7, c = u & 127;
        unsigned char* ST = WSP(unsigned char, WS_STATE) + (size_t)u * 32768; float* NK = WSP(float, WS_NK) + (size_t)u * 128;
        float mc, mn; mstate(BL, GM, bh, c, lane, mc, mn);
        const float blast = BL[u];
#pragma unroll
        for (int i = 0; i < 2; ++i) { float x[16]; un16_fp8x16(pv[i], x); bf16x16_to_lds(Vs + (sv + 32 * i) * PV + chv * 32, x); }
        { const float wgt = expf(blast - pbc + pif - mn); float x[16]; un16_fp8x16(pk, x);
#pragma unroll
          for (int j = 0; j < 16; ++j) x[j] *= wgt;
          bf16x16_to_lds(Ks + sk * PK + chk * 32, x); }
        __syncthreads();
        const int un = u + C.G;
        if (un < 4096) { const int bhn = un >> 7, cn = un & 127, bn = bhn >> 2, hn = bhn & 3; const size_t mn0 = (size_t)bn * SEQ + 64 * cn;
#pragma unroll
            for (int i = 0; i < 2; ++i) pv[i] = *(const u32x4*)(Z8 + (mn0 + sv + 32 * i) * Z8W + ZVM + 256 * hn + 16 * chv);
            pk = *(const u32x4*)(Z8 + (mn0 + sk) * Z8W + ZK + 128 * hn + 16 * chk); pbc = BC[(mn0 + sk) * 4 + hn]; pif = IFp[(mn0 + sk) * 8 + hn]; }
        if (tid < 128) { float sm = 0.f;
#pragma unroll
            for (int r = 0; r < 64; ++r) sm += bf2f(*(const LAS bf16*)(Ks + r * PK + tid * 2));
            NK[tid] = sm; }
        f32x4 acc[2][8];
#pragma unroll
        for (int i = 0; i < 2; ++i)
#pragma unroll
            for (int j = 0; j < 8; ++j) acc[i][j] = (f32x4){0.f, 0.f, 0.f, 0.f};
#pragma unroll
        for (int ks = 0; ks < 2; ++ks) {
            bf16x8 bfr[8];
#pragma unroll
            for (int j = 0; j < 8; ++j) bfr[j] = frag_tr(Ks, PK, 32 * ks, 16 * j, lane);
#pragma unroll
            for (int i = 0; i < 2; ++i) { const bf16x8 a = frag_tr(Vs, PV, 32 * ks, 32 * w + 16 * i, lane);
#pragma unroll
                for (int j = 0; j < 8; ++j) acc[i][j] = MFMA16(a, bfr[j], acc[i][j]); }
        }
#pragma unroll
        for (int i = 0; i < 2; ++i)
#pragma unroll
            for (int j = 0; j < 8; ++j) { const unsigned pw = pk4_fp8x4(acc[i][j][0], acc[i][j][1], acc[i][j][2], acc[i][j][3]);
#pragma unroll
                for (int r = 0; r < 4; ++r) *(LAS unsigned char*)(Ot + (32 * w + 16 * i + 4 * (lane >> 4) + r) * PO + 16 * j + (lane & 15)) = (unsigned char)(pw >> (8 * r)); }
        __syncthreads();
#pragma unroll
        for (int i = 0; i < 4; ++i) { const int idx = tid + 512 * i, v = idx >> 3, chq = idx & 7;
            *(u32x4*)(ST + v * 128 + 16 * chq) = *(const LAS u32x4*)(Ot + v * PO + chq * 16); }
    }
    __syncthreads();
}

__device__ __forceinline__ void phase_kvchain(const Ctx& C0) {
    CTX_LOCAL(C0);
    PHASE_IDS();
    const unsigned char* Z8 = WSP(unsigned char, WS_Z); const float* IFp = WSP(float, WS_IF); const float* BC = WSP(float, WS_BC);
    constexpr int PK = 272, PVS = 80, BUF = 64 * PK + 64 * PVS;
    const int sk = tid >> 3, chk = tid & 7;
    const int svr = (tid >> 1) & 63, svh = tid & 1;
    const int vi = w & 1, dj = 2 * (w >> 1);
    unsigned one2 = 0x41804180u; asm volatile("" : "+v"(one2));
    const bf16x8 ones = __builtin_bit_cast(bf16x8, (u32x4){one2, one2, one2, one2});
    __syncthreads();
    for (int item = C.vcu; item < 256; item += C.G) {
        const int bh = item >> 3, vs = item & 7, b = bh >> 2, h = bh & 3;
        const float* BL = WSP(float, WS_BL) + bh * 128; const float* GM = WSP(float, WS_GM) + bh * 128; float* MS = WSP(float, WS_MS) + bh * 129;
        unsigned char* ST = WSP(unsigned char, WS_STATE) + (size_t)bh * 128 * 32768 + (size_t)(32 * vs + 16 * vi + (lane & 15)) * 128 + 16 * dj + 4 * (lane >> 4);
        float* NK = WSP(float, WS_NK) + (size_t)bh * 128 * 128 + 16 * dj + 4 * (lane >> 4);
        const unsigned char* zk = Z8 + ((size_t)b * SEQ + sk) * Z8W + ZK + 128 * h + 16 * chk;
        const unsigned char* zv = Z8 + ((size_t)b * SEQ + svr) * Z8W + ZVM + 256 * h + 32 * vs + 16 * svh;
        const float* bcp = BC + ((size_t)b * SEQ + sk) * 4 + h; const float* ifp = IFp + ((size_t)b * SEQ + sk) * 8 + h;
        const float bl0 = BL[lane], bl1 = BL[64 + lane], gm0 = GM[lane], gm1 = GM[64 + lane];
        u32x4 rk[2], rv[2]; float rbc[2], rif[2]; rv[0] = rv[1] = (u32x4){0u, 0u, 0u, 0u};
        float mrun = 0.f, dcur = 0.f, dnxt = 0.f;
        f32x4 Cst[2] = {(f32x4){0.f, 0.f, 0.f, 0.f}, (f32x4){0.f, 0.f, 0.f, 0.f}}, Nst[2] = {(f32x4){0.f, 0.f, 0.f, 0.f}, (f32x4){0.f, 0.f, 0.f, 0.f}};
#define KVC_LOAD(R, c_) do { const size_t o_ = (size_t)(c_) * 64; rk[R] = *(const u32x4*)(zk + o_ * Z8W); if (tid < 128) rv[R] = *(const u32x4*)(zv + o_ * Z8W); rbc[R] = bcp[o_ * 4]; rif[R] = ifp[o_ * 8]; } while (0)
#define KVC_PREP(R, c_, decv) do { const int ci_ = (c_); const float bl_ = rdlane(ci_ < 64 ? bl0 : bl1, ci_ & 63), gm_ = rdlane(ci_ < 64 ? gm0 : gm1, ci_ & 63); \
            const float mn_ = fmaxf(bl_ + mrun, gm_); decv = fast_exp(bl_ + mrun - mn_); if (vs == 0 && tid == 0) MS[ci_] = mrun; mrun = mn_; \
            LAS unsigned char* kb_ = C.lds + (ci_ & 1) * BUF; \
            { const float wgt_ = fast_exp(bl_ - rbc[R] + rif[R] - mn_) * (1.0f / 256.0f); float x_[16]; un16_fp8raw(rk[R], x_); _Pragma("unroll") for (int j_ = 0; j_ < 16; ++j_) x_[j_] *= wgt_; bf16x16_to_lds(kb_ + sk * PK + chk * 32, x_); } \
            if (tid < 128) { float x_[16]; un16_fp8raw(rv[R], x_); bf16x16_to_lds(kb_ + 64 * PK + svr * PVS + svh * 32, x_); } } while (0)
#define KVC_STEP(cc_, R) do { const int cc = (cc_); \
            if (cc + 1 < 128) { KVC_PREP(R, cc + 1, dnxt); if (cc + 3 < 128) KVC_LOAD(R, cc + 3); } \
            const LAS unsigned char* kb = C.lds + (cc & 1) * BUF; const LAS unsigned char* vb = kb + 64 * PK; \
            f32x4 kv_[2] = {(f32x4){0.f, 0.f, 0.f, 0.f}, (f32x4){0.f, 0.f, 0.f, 0.f}}, nn_[2] = {(f32x4){0.f, 0.f, 0.f, 0.f}, (f32x4){0.f, 0.f, 0.f, 0.f}}; \
            _Pragma("unroll") for (int ks = 0; ks < 2; ++ks) { const bf16x8 bv = frag_tr(vb, PVS, 32 * ks, 16 * vi, lane); \
                _Pragma("unroll") for (int j = 0; j < 2; ++j) { const bf16x8 ak = frag_tr(kb, PK, 32 * ks, 16 * (dj + j), lane); kv_[j] = MFMA16(ak, bv, kv_[j]); if (vi == 0) nn_[j] = MFMA16(ak, ones, nn_[j]); } } \
            _Pragma("unroll") for (int j = 0; j < 2; ++j) { Cst[j] = Cst[j] * dcur + kv_[j]; *(unsigned*)(ST + (size_t)cc * 32768 + 16 * j) = pk4_fp8x4(Cst[j][0], Cst[j][1], Cst[j][2], Cst[j][3]); } \
            if (vi == 0) { _Pragma("unroll") for (int j = 0; j < 2; ++j) { Nst[j] = Nst[j] * dcur + nn_[j]; if (vs == 0 && (lane & 15) == 0) *(f32x4*)(NK + cc * 128 + 16 * j) = Nst[j]; } } \
            __syncthreads(); dcur = dnxt; } while (0)
        KVC_LOAD(0, 0);
        KVC_PREP(0, 0, dcur);
        KVC_LOAD(1, 1); KVC_LOAD(0, 2);
        __syncthreads();
#pragma unroll 1
        for (int c = 0; c < 128; c += 2) { KVC_STEP(c, 1); KVC_STEP(c + 1, 0); }
#undef KVC_LOAD
#undef KVC_PREP
#undef KVC_STEP
    }
}

__device__ __forceinline__ void phase_scan(const Ctx& C0, bool dry = false) {
    CTX_LOCAL(C0);
    for (int gt = C.vcu * 512 + fresh_tid(); gt < 32 * 4096; gt += C.G * 512) {
    const int bh = gt >> 12, e8 = gt & 4095;
    const float* BL = WSP(float, WS_BL) + bh * 128; const float* GM = WSP(float, WS_GM) + bh * 128; float* MS = WSP(float, WS_MS) + bh * 129;
    unsigned char* ST = WSP(unsigned char, WS_STATE) + (size_t)bh * 128 * 32768 + (size_t)e8 * 8; float* NK = WSP(float, WS_NK) + (size_t)bh * 128 * 128 + e8;
    float st[8]; float m = 0.f, nst = 0.f;
#pragma unroll
    for (int j = 0; j < 8; ++j) st[j] = 0.f;
    for (int c0 = 0; c0 < 128; c0 += 16) {
        u32x2 kv[16]; float nk[16];
#pragma unroll
        for (int i = 0; i < 16; ++i) { kv[i] = *(const u32x2*)(ST + (size_t)(c0 + i) * 32768); nk[i] = e8 < 128 ? NK[(c0 + i) * 128] : 0.f; }
#pragma unroll
        for (int i = 0; i < 16; ++i) { const int c = c0 + i; const float bl = BL[c], gm = GM[c]; const float mn = fmaxf(bl + m, gm), dec = expf(bl + m - mn);
            if (e8 == 0 && !dry) MS[c] = m;
            m = mn;
            const f32x4 k0 = un4_fp8x4(kv[i].x), k1 = un4_fp8x4(kv[i].y);
            st[0] = dec * st[0] + k0[0]; st[1] = dec * st[1] + k0[1]; st[2] = dec * st[2] + k0[2]; st[3] = dec * st[3] + k0[3];
            st[4] = dec * st[4] + k1[0]; st[5] = dec * st[5] + k1[1]; st[6] = dec * st[6] + k1[2]; st[7] = dec * st[7] + k1[3];
            const u32x2 o = (u32x2){pk4_fp8x4(st[0], st[1], st[2], st[3]), pk4_fp8x4(st[4], st[5], st[6], st[7])};
            if (dry) *(u32x2*)(WSP(unsigned char, WS_XB) + (size_t)bh * 1048576 + (size_t)(c & 31) * 32768 + (size_t)e8 * 8) = o; else *(u32x2*)(ST + (size_t)c * 32768) = o;
            if (e8 < 128) { nst = dec * nst + nk[i]; if (!dry) NK[c * 128] = nst; } }
    }
    }
}

__device__ __forceinline__ void phase_mlstm(const Ctx& C0, int l) {
    CTX_LOCAL(C0);
    PHASE_IDS();
    const unsigned char* Z8 = WSP(unsigned char, WS_Z); const float* IFp = WSP(float, WS_IF); const float* BC = WSP(float, WS_BC); const float* MS = WSP(float, WS_MS); unsigned char* AB8 = (unsigned char*)C.out;
    constexpr int PQ = 144, PV = 528, PC = 144, PP = 144;
    constexpr int OQ = 0, OK_ = 64 * PQ, OC = OK_ + 64 * PQ, OV = OC + 256 * PC, OP = OV + 64 * PV, OS = OP + 64 * PP;
    LAS unsigned char* Qs = C.lds + OQ; LAS unsigned char* Ks = C.lds + OK_; LAS unsigned char* Vs = C.lds + OV; LAS unsigned char* Cs = C.lds + OC; LAS unsigned char* Ps = C.lds + OP;
    LAS float* sA = (LAS float*)(C.lds + OS); LAS float* sPM = sA + 64; LAS float* sWI = sA + 128; LAS float* sEN = sA + 192; LAS float* sDN = sA + 256; LAS float* sN = sA + 320;
    constexpr int PH = 528;
    LAS unsigned char* Hs = C.lds + OS + 6144;
    LAS float* sG = (LAS float*)(C.lds + OS + 2048);
    { const float* mg_ = INP(I_MHG) + (size_t)l * 1024; for (int i = tid; i < 1024; i += 512) sG[i] = mg_[i]; }
    const int sq = tid >> 3, chq = tid & 7, sv = tid >> 4, chv = tid & 15;
    const int sc = tid >> 3, chc = tid & 7;
    u32x4 pq, pk, pv[2], pc[4]; float pn = 0.f, pbc = 0.f, pip = 0.f, pmc = 0.f;
#define MLSTM_PREFETCH(uu) do { const int bh_ = (uu) >> 7, c_ = (uu) & 127, b_ = bh_ >> 2, h_ = bh_ & 3; const size_t m_ = (size_t)b_ * SEQ + 64 * c_; \
        const unsigned char* st_ = WSP(unsigned char, WS_STATE) + (size_t)((uu) - 1) * 32768; \
        pq = *(const u32x4*)(Z8 + (m_ + sq) * Z8W + ZQ + 128 * h_ + 16 * chq); pk = *(const u32x4*)(Z8 + (m_ + sq) * Z8W + ZK + 128 * h_ + 16 * chq); \
        _Pragma("unroll") for (int i = 0; i < 2; ++i) pv[i] = *(const u32x4*)(Z8 + (m_ + sv + 32 * i) * Z8W + ZVM + 256 * h_ + 16 * chv); \
        _Pragma("unroll") for (int i = 0; i < 4; ++i) { pc[i] = (u32x4){0u, 0u, 0u, 0u}; if (c_ > 0) pc[i] = *(const u32x4*)(st_ + (sc + 64 * i) * 128 + 16 * chc); } \
        pn = (c_ > 0 && tid < 128) ? WSP(float, WS_NK)[(size_t)((uu) - 1) * 128 + (tid & 127)] : 0.f; \
        pbc = BC[(m_ + lane) * 4 + h_]; pip = IFp[(m_ + lane) * 8 + h_]; pmc = MS[bh_ * 129 + c_]; } while (0)
#define MLSTM_FILL() do { const float mc_ = pmc; \
        *(LAS u32x4*)(Qs + sq * PQ + chq * 16) = pq; *(LAS u32x4*)(Ks + sq * PQ + chq * 16) = pk; \
        _Pragma("unroll") for (int i = 0; i < 2; ++i) { float x[16]; un16_fp8x16(pv[i], x); bf16x16_to_lds(Vs + (sv + 32 * i) * PV + chv * 32, x); } \
        _Pragma("unroll") for (int i = 0; i < 4; ++i) *(LAS u32x4*)(Cs + (sc + 64 * i) * PC + chc * 16) = pc[i]; \
        if (tid < 128) sN[tid] = pn; \
        if (w == 0) { const float a = pip - pbc; float pm = a; \
            _Pragma("unroll") for (int o = 1; o < 64; o <<= 1) { const float t = shfl_idx(pm, lane - o); if (lane >= o) pm = fmaxf(pm, t); } \
            pm = fmaxf(pm, mc_); sA[lane] = a; sPM[lane] = pm; sWI[lane] = fast_exp(mc_ - pm); sEN[lane] = fast_exp(-pbc - pm); } } while (0)
    int u = C.vcu;
    if (u < 4096) { MLSTM_PREFETCH(u); MLSTM_FILL(); if (u + C.G < 4096) MLSTM_PREFETCH(u + C.G); }
    __syncthreads();
    for (; u < 4096; u += C.G) {
        const int bh = u >> 7, c = u & 127, b = bh >> 2, h = bh & 3; const size_t m0 = (size_t)b * SEQ + 64 * c; (void)c;
        const LAS float* mhg = sG + 256 * h;
        const int tf = tid >> 3, part = tid & 7;
        u32x4 po[2];
#pragma unroll
        for (int k8 = 0; k8 < 2; ++k8) po[k8] = *(const u32x4*)(Z8 + (m0 + tf) * Z8W + ZO + 256 * h + part * 32 + 16 * k8);
        {
            const int ti = w >> 1; f32x4 sa[2] = {(f32x4){0.f, 0.f, 0.f, 0.f}, (f32x4){0.f, 0.f, 0.f, 0.f}};
#pragma unroll
            for (int ks = 0; ks < 4; ++ks) { const long a = frag8(Qs, PQ, 16 * ti, 32 * ks, lane);
#pragma unroll
                for (int j = 0; j < 2; ++j) sa[j] = MFMA8(a, frag8(Ks, PQ, 16 * (2 * (w & 1) + j), 32 * ks, lane), sa[j]); }
#pragma unroll
            for (int j = 0; j < 2; ++j) { const int sc = 16 * (2 * (w & 1) + j) + (lane & 15); const float as = sA[sc];
#pragma unroll
                for (int r = 0; r < 4; ++r) { const int t = 16 * ti + 4 * (lane >> 4) + r; const float p = sc <= t ? sa[j][r] * (fast_exp(as - sPM[t]) * (1.0f / 256.0f)) : 0.f;
                    *(LAS bf16*)(Ps + t * PP + sc * 2) = f2bf(p); } }
        }
        __syncthreads();
        {
            const int t = tf;
            const u32x4 pr = *(const LAS u32x4*)(Ps + t * PP + part * 16);
            float ps = (bflo(pr.x) + bfhi(pr.x)) + (bflo(pr.y) + bfhi(pr.y)) + (bflo(pr.z) + bfhi(pr.z)) + (bflo(pr.w) + bfhi(pr.w));
            float qn = 0.f;
            { float qv[16]; un16_fp8x16(*(const LAS u32x4*)(Qs + t * PQ + part * 16), qv); const LAS float* nn = sN + part * 16;
#pragma unroll
              for (int i = 0; i < 16; ++i) qn += qv[i] * nn[i]; }
            ps = grp8_sum(ps);
            qn = grp8_sum(qn);
            if (part == 0) sDN[t] = fmaxf(fabsf(ps + sWI[t] * qn), sEN[t]);
        }
        f32x4 ac[4][2];
#pragma unroll
        for (int i = 0; i < 4; ++i)
#pragma unroll
            for (int j = 0; j < 2; ++j) ac[i][j] = (f32x4){0.f, 0.f, 0.f, 0.f};
#pragma unroll
        for (int ks = 0; ks < 4; ++ks) { long bc_[2];
#pragma unroll
            for (int j = 0; j < 2; ++j) bc_[j] = frag8(Cs, PC, 32 * w + 16 * j, 32 * ks, lane);
#pragma unroll
            for (int i = 0; i < 4; ++i) { const long a = frag8(Qs, PQ, 16 * i, 32 * ks, lane);
#pragma unroll
                for (int j = 0; j < 2; ++j) ac[i][j] = MFMA8(a, bc_[j], ac[i][j]); } }
#pragma unroll
        for (int i = 0; i < 4; ++i)
#pragma unroll
            for (int r = 0; r < 4; ++r) { const float wi = sWI[16 * i + 4 * (lane >> 4) + r] * (1.0f / 64.0f);
#pragma unroll
                for (int j = 0; j < 2; ++j) ac[i][j][r] *= wi; }
#pragma unroll
        for (int ks = 0; ks < 2; ++ks) { bf16x8 bv[2];
#pragma unroll
            for (int j = 0; j < 2; ++j) bv[j] = frag_tr(Vs, PV, 32 * ks, 32 * w + 16 * j, lane);
#pragma unroll
            for (int i = 0; i < 4; ++i) { const bf16x8 a = frag_row(Ps, PP, 16 * i, 32 * ks, lane);
#pragma unroll
                for (int j = 0; j < 2; ++j) ac[i][j] = MFMA16(a, bv[j], ac[i][j]); } }
#pragma unroll
        for (int i = 0; i < 4; ++i)
#pragma unroll
            for (int r = 0; r < 4; ++r) { const int t = 16 * i + 4 * (lane >> 4) + r;
#pragma unroll
                for (int j = 0; j < 2; ++j) *(LAS bf16*)(Hs + t * PH + (32 * w + 16 * j + (lane & 15)) * 2) = f2bf(ac[i][j][r]); }
        __syncthreads();
        {
            f32x4 hv[8]; float ss = 0.f; const float rd = __builtin_amdgcn_rcpf(sDN[tf]);
#pragma unroll
            for (int k8 = 0; k8 < 4; ++k8) { const u32x4 hq = *(const LAS u32x4*)(Hs + tf * PH + part * 64 + 16 * k8);
                hv[2 * k8] = (f32x4){bflo(hq.x), bfhi(hq.x), bflo(hq.y), bfhi(hq.y)} * rd; hv[2 * k8 + 1] = (f32x4){bflo(hq.z), bfhi(hq.z), bflo(hq.w), bfhi(hq.w)} * rd; }
#pragma unroll
            for (int k4 = 0; k4 < 8; ++k4) ss += hv[k4][0] * hv[k4][0] + hv[k4][1] * hv[k4][1] + hv[k4][2] * hv[k4][2] + hv[k4][3] * hv[k4][3];
            ss = grp8_sum(ss);
            const float rinv = __builtin_amdgcn_rsqf(ss * (1.0f / 256.0f) + kf(RMS_EPS));
#pragma unroll
            for (int k16 = 0; k16 < 2; ++k16) { const int v0 = part * 32 + 16 * k16; float og[16]; un16_fp8x16(po[k16], og); u32x4 o;
#pragma unroll
                for (int q = 0; q < 4; ++q) { const f32x4 gq = *(const LAS f32x4*)(mhg + v0 + 4 * q); const f32x4 xq = hv[4 * k16 + q];
                    o[q] = pk4_fp8x16(og[4 * q] * xq[0] * rinv * gq[0], og[4 * q + 1] * xq[1] * rinv * gq[1], og[4 * q + 2] * xq[2] * rinv * gq[2], og[4 * q + 3] * xq[3] * rinv * gq[3]); }
                *(u32x4*)(AB8 + (m0 + tf) * 2048 + 1024 + 256 * h + v0) = o; }
        }
        if (u + C.G < 4096) { MLSTM_FILL(); if (u + 2 * C.G < 4096) MLSTM_PREFETCH(u + 2 * C.G); }
        __syncthreads();
    }
#undef MLSTM_FILL
#undef MLSTM_PREFETCH
}

__device__ __forceinline__ void phase_ln1_router(const Ctx& C0, int l, bool dry = false) {
    CTX_LOCAL(C0);
    PHASE_IDS();
    bf16* X = WSP(bf16, WS_XR); bf16* XO = dry ? WSP(bf16, WS_GBUF) : X; bf16* XB = WSP(bf16, WS_XB); int* TOKE = WSP(int, WS_TOKE); float* TOKW = WSP(float, WS_TOKW); int* HIST = WSP(int, WS_HIST);
    const float* g1 = INP(I_LN1G) + (size_t)l * D; const float* b1 = INP(I_LN1B) + (size_t)l * D; const float* wr = INP(I_WR) + (size_t)l * D * NE; const float* br = INP(I_BR) + (size_t)l * NE;
    LAS float* Xt = (LAS float*)C.lds;
    LAS float* PART = (LAS float*)(C.lds + 16 * 1028 * 4);
    LAS int* hist = (LAS int*)(C.lds + 16 * 1028 * 4 + 8 * 16 * 64 * 4);
    LAS float* gb = (LAS float*)(C.lds + 16 * 1028 * 4 + 8 * 16 * 64 * 4 + 256);
    for (int i = tid; i < 1024; i += 512) { gb[i] = g1[i]; gb[1024 + i] = b1[i]; }
    __syncthreads();
    const float brl = br[lane];
    bf16x8 bh[4][4], bl[4][4];
#pragma unroll
    for (int ks = 0; ks < 4; ++ks)
#pragma unroll
        for (int et = 0; et < 4; ++et) { float f[8];
#pragma unroll
            for (int j = 0; j < 8; ++j) f[j] = wr[(size_t)(128 * w + 32 * ks + 8 * (lane >> 4) + j) * NE + 16 * et + (lane & 15)];
            u32x4 hh, ll;
#pragma unroll
            for (int q = 0; q < 4; ++q) { const unsigned hp = cvt_pk_bf16(f[2 * q], f[2 * q + 1]); hh[q] = hp; ll[q] = cvt_pk_bf16(f[2 * q] - bflo(hp), f[2 * q + 1] - bfhi(hp)); }
            bh[ks][et] = __builtin_bit_cast(bf16x8, hh); bl[ks][et] = __builtin_bit_cast(bf16x8, ll); }
    for (int blk = C.vcu; blk < M / 256; blk += C.G) {
        if (tid < 64) hist[tid] = 0;
        __syncthreads();
        u32x2 pre[2][4];
#pragma unroll
        for (int rr = 0; rr < 2; ++rr)
#pragma unroll
            for (int j = 0; j < 4; ++j) pre[rr][j] = *(const u32x2*)(X + ((size_t)blk * 256 + 2 * w + rr) * D + 256 * j + 4 * lane);
        for (int bt = 0; bt < 16; ++bt) {
            const size_t mb = (size_t)blk * 256 + bt * 16;
#pragma unroll
            for (int rr = 0; rr < 2; ++rr) { const int row = 2 * w + rr; const size_t m = mb + row; f32x4 v[4]; float s = 0.f;
#pragma unroll
                for (int j = 0; j < 4; ++j) { const u32x2 q = pre[rr][j]; v[j] = (f32x4){bflo(q.x), bfhi(q.x), bflo(q.y), bfhi(q.y)}; s += (v[j][0] + v[j][1]) + (v[j][2] + v[j][3]); }
                const float mean = wave_sum(s) * (1.0f / D); float q = 0.f;
#pragma unroll
                for (int j = 0; j < 4; ++j) { v[j] = v[j] - mean; q += (v[j][0] * v[j][0] + v[j][1] * v[j][1]) + (v[j][2] * v[j][2] + v[j][3] * v[j][3]); }
                const float rstd = __builtin_amdgcn_rsqf(wave_sum(q) * (1.0f / D) + kf(LN_EPS));
#pragma unroll
                for (int j = 0; j < 4; ++j) { const f32x4 y = v[j] * rstd * *(const LAS f32x4*)(gb + 256 * j + 4 * lane) + *(const LAS f32x4*)(gb + 1024 + 256 * j + 4 * lane);
                    { u32x2 o; o.x = cvt_pk_bf16(y[0], y[1]); o.y = cvt_pk_bf16(y[2], y[3]); *(u32x2*)(XO + m * D + 256 * j + 4 * lane) = o; } *(LAS f32x4*)(Xt + row * 1028 + 256 * j + 4 * lane) = y;
                    int w8 = __builtin_amdgcn_cvt_pk_fp8_f32(y[0] * 16.f, y[1] * 16.f, 0, false); w8 = __builtin_amdgcn_cvt_pk_fp8_f32(y[2] * 16.f, y[3] * 16.f, w8, true);
                    *(int*)((unsigned char*)XB + m * D + 256 * j + 4 * lane) = w8; } }
            __syncthreads();
            if (bt + 1 < 16) {
#pragma unroll
                for (int rr = 0; rr < 2; ++rr)
#pragma unroll
                    for (int j = 0; j < 4; ++j) pre[rr][j] = *(const u32x2*)(X + (mb + 16 + 2 * w + rr) * D + 256 * j + 4 * lane); }
            {
                f32x4 acc[4] = {(f32x4){0.f, 0.f, 0.f, 0.f}, (f32x4){0.f, 0.f, 0.f, 0.f}, (f32x4){0.f, 0.f, 0.f, 0.f}, (f32x4){0.f, 0.f, 0.f, 0.f}};
                const LAS float* xa = Xt + (lane & 15) * 1028 + 128 * w + 8 * (lane >> 4);
#pragma unroll
                for (int ks = 0; ks < 4; ++ks) { const f32x4 x0 = *(const LAS f32x4*)(xa + 32 * ks), x1 = *(const LAS f32x4*)(xa + 32 * ks + 4);
                    u32x4 hh, ll;
                    hh[0] = cvt_pk_bf16(x0[0], x0[1]); hh[1] = cvt_pk_bf16(x0[2], x0[3]); hh[2] = cvt_pk_bf16(x1[0], x1[1]); hh[3] = cvt_pk_bf16(x1[2], x1[3]);
                    ll[0] = cvt_pk_bf16(x0[0] - bflo(hh[0]), x0[1] - bfhi(hh[0])); ll[1] = cvt_pk_bf16(x0[2] - bflo(hh[1]), x0[3] - bfhi(hh[1]));
                    ll[2] = cvt_pk_bf16(x1[0] - bflo(hh[2]), x1[1] - bfhi(hh[2])); ll[3] = cvt_pk_bf16(x1[2] - bflo(hh[3]), x1[3] - bfhi(hh[3]));
                    const bf16x8 ah = __builtin_bit_cast(bf16x8, hh), al = __builtin_bit_cast(bf16x8, ll);
#pragma unroll
                    for (int et = 0; et < 4; ++et) { acc[et] = MFMA16(ah, bh[ks][et], acc[et]); acc[et] = MFMA16(ah, bl[ks][et], acc[et]); acc[et] = MFMA16(al, bh[ks][et], acc[et]); } }
#pragma unroll
                for (int et = 0; et < 4; ++et)
#pragma unroll
                    for (int r = 0; r < 4; ++r) PART[(w * 16 + 4 * (lane >> 4) + r) * 64 + 16 * et + (lane & 15)] = acc[et][r];
            }
            __syncthreads();
            {
                const float ninf = kf(-INFINITY); const int grp = lane >> 3;
                float score[2], sel[2], gs[2], cur[2], ssum[2]; int rank[2];
#pragma unroll
                for (int rr = 0; rr < 2; ++rr) { const int row = 2 * w + rr; float lg = 0.f;
#pragma unroll
                    for (int p = 0; p < 8; ++p) lg += PART[(p * 16 + row) * 64 + lane];
                    score[rr] = fast_sigmoid(lg); sel[rr] = score[rr] + brl; }
                float m1[2], s2[2];
#pragma unroll
                for (int rr = 0; rr < 2; ++rr) m1[rr] = grp8_max(sel[rr]);
#pragma unroll
                for (int rr = 0; rr < 2; ++rr) { const unsigned long long bm = __ballot(sel[rr] == m1[rr]); const unsigned gb = (unsigned)(bm >> (8 * grp)) & 0xffu; const int first = __builtin_ctz(gb);
                    s2[rr] = ((lane & 7) == first) ? ninf : sel[rr]; }
#pragma unroll
                for (int rr = 0; rr < 2; ++rr) gs[rr] = m1[rr] + grp8_max(s2[rr]);
#pragma unroll
                for (int rr = 0; rr < 2; ++rr) { int gc = 0;
#pragma unroll
                    for (int g2 = 0; g2 < 8; ++g2) { const float o = rdlane(gs[rr], 8 * g2); gc += (o > gs[rr] || (o == gs[rr] && g2 < grp)) ? 1 : 0; }
                    cur[rr] = gc < 4 ? sel[rr] : ninf; rank[rr] = TOPK; }
#pragma unroll
                for (int r = 0; r < TOPK; ++r) { float mx[2];
#pragma unroll
                    for (int rr = 0; rr < 2; ++rr) mx[rr] = wave_max(cur[rr]);
#pragma unroll
                    for (int rr = 0; rr < 2; ++rr) { const int idx = (int)__builtin_ctzll(__ballot(cur[rr] == mx[rr])); const bool hit = lane == idx; rank[rr] = hit ? r : rank[rr]; cur[rr] = hit ? ninf : cur[rr]; } }
#pragma unroll
                for (int rr = 0; rr < 2; ++rr) ssum[rr] = wave_sum(rank[rr] < TOPK ? score[rr] : 0.f);
#pragma unroll
                for (int rr = 0; rr < 2; ++rr) { const size_t m = mb + 2 * w + rr;
                    if (rank[rr] < TOPK) { TOKE[m * 8 + rank[rr]] = lane; TOKW[m * 8 + rank[rr]] = score[rr] * __builtin_amdgcn_rcpf(ssum[rr]) * ROUTE_SCALE; __hip_atomic_fetch_add(&hist[lane], 1, __ATOMIC_RELAXED, __HIP_MEMORY_SCOPE_WORKGROUP); } }
            }
        }
        __syncthreads();
        if (tid < 64) HIST[blk * 64 + tid] = hist[tid];
        __syncthreads();
    }
}

__device__ __forceinline__ void phase_sort(const Ctx& C0) {
    CTX_LOCAL(C0);
    PHASE_IDS();
    const int* HIST = WSP(int, WS_HIST); const int* TOKE = WSP(int, WS_TOKE); const float* TOKW = WSP(float, WS_TOKW);
    int* POS = WSP(int, WS_POS); int* STOK = WSP(int, WS_STOK); float* SW = WSP(float, WS_SW); int* TILEE = WSP(int, WS_TILEE); int* CNT = WSP(int, WS_CNT);
    LAS int* psum = (LAS int*)C.lds;
    LAS int* cntH = psum + 512;
    LAS int* ntile = cntH + 128;
    LAS int* rstart = ntile + 128;
    LAS int* ntl = rstart + 128;
    LAS int* cur = ntl + 16;
    LAS int* wcnt = cur + 64;
    { const int e = tid & 63, part = tid >> 6; int s = 0;
        for (int b2 = 32 * part; b2 < 32 * part + 32; ++b2) s += HIST[b2 * 64 + e];
        psum[part * 64 + e] = s; }
    __syncthreads();
    if (tid < 128) { const int hf = tid >> 6, e = tid & 63; const int cnt = psum[(4 * hf) * 64 + e] + psum[(4 * hf + 1) * 64 + e] + psum[(4 * hf + 2) * 64 + e] + psum[(4 * hf + 3) * 64 + e];
        cntH[tid] = cnt; ntile[tid] = (cnt + 255) >> 8; }
    __syncthreads();
    if (tid < 2) { int rs = 0; for (int e = 0; e < 64; ++e) { rstart[tid * 64 + e] = rs; rs += ntile[tid * 64 + e] * 256; } ntl[tid] = rs >> 8; }
    __syncthreads();
    const int NTL0 = ntl[0], NTL1 = ntl[1];
    if (C.vcu == 0) {
        if (tid == 0) { CNT[0] = NTL0; CNT[1] = NTL1; }
        if (tid < 128) { const int hf = tid >> 6, e = tid & 63; const int t0 = (hf ? NTL0 : 0) + (rstart[tid] >> 8), n = ntile[tid];
            for (int t = 0; t < n; ++t) TILEE[t0 + t] = e;
            const int base = M + (hf ? 256 * NTL0 : 0) + rstart[tid];
            int zi = 0; asm volatile("" : "+v"(zi));
#pragma unroll 1
            for (int r = cntH[tid]; r < n * 256; ++r) { STOK[base + r] = zi; SW[base + r] = __int_as_float(zi); } }
    }
    for (int blk = C.vcu; blk < M / 256; blk += C.G) {
        const int hf = blk >> 7;
        { const int e = tid & 63, part = tid >> 6; int s = 0; const int lo = 128 * hf + 16 * part; int hi = lo + 16; if (hi > blk) hi = blk;
            for (int b2 = lo; b2 < hi; ++b2) s += HIST[b2 * 64 + e];
            psum[part * 64 + e] = s; }
        __syncthreads();
        if (tid < 64) { int s = M + (hf ? 256 * NTL0 : 0) + rstart[hf * 64 + tid];
#pragma unroll
            for (int p = 0; p < 8; ++p) s += psum[p * 64 + tid];
            cur[tid] = s; }
        __syncthreads();
        for (int q = 0; q < 4; ++q) {
            const int pair = tid + 512 * q; const size_t idx = (size_t)blk * 2048 + pair; const int e = TOKE[idx];
            int rnk = 0, mycnt = 0;
            for (int ee = 0; ee < 64; ++ee) { const unsigned long long mk = __ballot(e == ee);
                if (e == ee) rnk = __popcll(mk & ((1ull << lane) - 1ull));
                if (lane == ee) mycnt = __popcll(mk); }
            wcnt[w * 64 + lane] = mycnt;
            __syncthreads();
            int pos = cur[e] + rnk;
            for (int w2 = 0; w2 < w; ++w2) pos += wcnt[w2 * 64 + e];
            STOK[pos] = (int)(idx >> 3); SW[pos] = TOKW[idx]; POS[idx] = pos;
            __syncthreads();
            if (tid < 64) { int a = 0;
#pragma unroll
                for (int w2 = 0; w2 < 8; ++w2) a += wcnt[w2 * 64 + tid];
                cur[tid] += a; }
            __syncthreads();
        }
        if (tid < 256) { const int r = blk * 256 + tid; STOK[r] = r; SW[r] = 1.0f; }
        __syncthreads();
    }
}

__device__ __forceinline__ void load_wif_wide(const Ctx& C0, int l, LAS float* wif) {
    CTX_LOCAL(C0);
    const float* win = INP(I_WIN) + (size_t)l * D * DIN;
    for (int i = fresh_tid(); i < 1024 * 8; i += 512) { const int k = i >> 3, g = i & 7; wif[(((k & 15) * 2 + (g >> 2)) * 64 + (k >> 4)) * 4 + (g & 3)] = win[(size_t)k * DIN + 5120 + g]; }
    __syncthreads();
}
__device__ __forceinline__ void phase_ln2(const Ctx& C0, int l, bool dry = false) {
    CTX_LOCAL(C0);
    PHASE_IDS();
    const int gw = C.vcu * 8 + w, NGW = C.G * 8;
    bf16* X = WSP(bf16, WS_XR); bf16* XO = dry ? WSP(bf16, WS_GBUF) : X; float* OUT = C.out; const int* POS = WSP(int, WS_POS); const unsigned char* OUTS = WSP(unsigned char, WS_OUTS);
    unsigned char* XB = WSP(unsigned char, WS_XB); float* IFp = WSP(float, WS_IF);
    const float* g2 = INP(I_LN2G) + (size_t)l * D; const float* b2 = INP(I_LN2B) + (size_t)l * D;
    const int obase = M;
    LAS float* wif = (LAS float*)C.lds;
    const bool nxt = l + 1 < DEPTH;
    if (nxt) load_wif_wide(C, l + 1, wif);
    const float bifl = (INP(I_BIN) + (size_t)(nxt ? l + 1 : l) * DIN + 5120)[(lane >> 1) & 7];
    f32x4 gv[4], bv[4];
#pragma unroll
    for (int q = 0; q < 4; ++q) { gv[q] = *(const f32x4*)(g2 + 16 * lane + 4 * q); bv[q] = *(const f32x4*)(b2 + 16 * lane + 4 * q); }
    const bool b3 = (lane & 8) != 0, b2_ = (lane & 4) != 0, b1 = (lane & 2) != 0;
    int npos[8]; u32x4 ov[8]; u32x4 xq[2];
    if (gw < M) {
#pragma unroll
        for (int k = 0; k < 8; ++k) npos[k] = POS[(size_t)gw * 8 + k] - obase;
#pragma unroll
        for (int k = 0; k < 8; ++k) ov[k] = __builtin_nontemporal_load((const u32x4*)(OUTS + (size_t)npos[k] * D + 16 * lane));
#pragma unroll
        for (int h2 = 0; h2 < 2; ++h2) xq[h2] = *(const u32x4*)(X + (size_t)gw * D + 16 * lane + 8 * h2);
        { const int mn = (gw + NGW < M) ? gw + NGW : gw;
#pragma unroll
          for (int k = 0; k < 8; ++k) npos[k] = POS[(size_t)mn * 8 + k] - obase; }
    }
    for (int m = gw; m < M; m += NGW) {
        f32x4 v[4]; u32x4 ovn[8]; u32x4 xqn[2];
        const int mnx = (m + NGW < M) ? m + NGW : m;
#pragma unroll
        for (int k = 0; k < 8; ++k) ovn[k] = __builtin_nontemporal_load((const u32x4*)(OUTS + (size_t)npos[k] * D + 16 * lane));
#pragma unroll
        for (int h2 = 0; h2 < 2; ++h2) xqn[h2] = *(const u32x4*)(X + (size_t)mnx * D + 16 * lane + 8 * h2);
        { const int mn2 = (m + 2 * NGW < M) ? m + 2 * NGW : mnx;
#pragma unroll
          for (int k = 0; k < 8; ++k) npos[k] = POS[(size_t)mn2 * 8 + k] - obase; }
#pragma unroll
        for (int h2 = 0; h2 < 2; ++h2) { const u32x4 q = xq[h2]; v[2 * h2] = (f32x4){bflo(q.x), bfhi(q.x), bflo(q.y), bfhi(q.y)}; v[2 * h2 + 1] = (f32x4){bflo(q.z), bfhi(q.z), bflo(q.w), bfhi(q.w)}; }
#pragma unroll
        for (int q = 0; q < 4; ++q) { f32x4 a = (f32x4){0.f, 0.f, 0.f, 0.f};
#pragma unroll
            for (int k = 0; k < 8; ++k) { const int w8 = (int)ov[k][q]; a[0] += __builtin_amdgcn_cvt_f32_fp8(w8, 0); a[1] += __builtin_amdgcn_cvt_f32_fp8(w8, 1); a[2] += __builtin_amdgcn_cvt_f32_fp8(w8, 2); a[3] += __builtin_amdgcn_cvt_f32_fp8(w8, 3); }
            v[q] = v[q] + a * (1.0f / 256.0f); }
        float s = 0.f;
#pragma unroll
        for (int q = 0; q < 4; ++q) s += (v[q][0] + v[q][1]) + (v[q][2] + v[q][3]);
        const float mean = wave_sum(s) * (1.0f / D); float qq = 0.f;
#pragma unroll
        for (int q = 0; q < 4; ++q) { v[q] = v[q] - mean; qq += (v[q][0] * v[q][0] + v[q][1] * v[q][1]) + (v[q][2] * v[q][2] + v[q][3] * v[q][3]); }
        const float rstd = __builtin_amdgcn_rsqf(wave_sum(qq) * (1.0f / D) + kf(LN_EPS));
#pragma unroll
        for (int q = 0; q < 4; ++q) v[q] = v[q] * rstd * gv[q] + bv[q];
        if (nxt) {
#pragma unroll
            for (int h2 = 0; h2 < 2; ++h2) { u32x4 o; o.x = cvt_pk_bf16(v[2 * h2][0], v[2 * h2][1]); o.y = cvt_pk_bf16(v[2 * h2][2], v[2 * h2][3]); o.z = cvt_pk_bf16(v[2 * h2 + 1][0], v[2 * h2 + 1][1]); o.w = cvt_pk_bf16(v[2 * h2 + 1][2], v[2 * h2 + 1][3]);
                __builtin_nontemporal_store(o, (u32x4*)(XO + (size_t)m * D + 16 * lane + 8 * h2)); }
            { u32x4 o;
#pragma unroll
              for (int q = 0; q < 4; ++q) { int w8 = __builtin_amdgcn_cvt_pk_fp8_f32(v[q][0] * 16.f, v[q][1] * 16.f, 0, false); w8 = __builtin_amdgcn_cvt_pk_fp8_f32(v[q][2] * 16.f, v[q][3] * 16.f, w8, true); o[q] = (unsigned)w8; }
              *(u32x4*)(XB + (size_t)m * D + 16 * lane) = o; }
            float g[8];
#pragma unroll
            for (int i = 0; i < 8; ++i) g[i] = 0.f;
#pragma unroll
            for (int q = 0; q < 4; ++q)
#pragma unroll
                for (int e = 0; e < 4; ++e) { const int kk = 4 * q + e; const f32x4 w0 = *(const LAS f32x4*)(wif + ((kk * 2) * 64 + lane) * 4), w1 = *(const LAS f32x4*)(wif + ((kk * 2 + 1) * 64 + lane) * 4); const float x = v[q][e];
                    g[0] += x * w0[0]; g[1] += x * w0[1]; g[2] += x * w0[2]; g[3] += x * w0[3]; g[4] += x * w1[0]; g[5] += x * w1[1]; g[6] += x * w1[2]; g[7] += x * w1[3]; }
            float h4[4], p2[2], r;
#pragma unroll
            for (int i = 0; i < 4; ++i) h4[i] = (b3 ? g[i + 4] : g[i]) + dppf<0x140>(b3 ? g[i] : g[i + 4]);
#pragma unroll
            for (int i = 0; i < 2; ++i) p2[i] = (b2_ ? h4[i + 2] : h4[i]) + dppf<0x141>(b2_ ? h4[i] : h4[i + 2]);
            r = (b1 ? p2[1] : p2[0]) + dppf<0x4E>(b1 ? p2[0] : p2[1]);
            r += dppf<0xB1>(r);
            { const auto t = __builtin_amdgcn_permlane32_swap(__float_as_uint(r), __float_as_uint(r), false, false); r = __uint_as_float(t[0]) + __uint_as_float(t[1]); }
            { const auto t = __builtin_amdgcn_permlane16_swap(__float_as_uint(r), __float_as_uint(r), false, false); r = __uint_as_float(t[0]) + __uint_as_float(t[1]); }
            if (lane < 16 && (lane & 1) == 0) IFp[(size_t)m * 8 + (lane >> 1)] = r + bifl;
        } else {
#pragma unroll
            for (int q = 0; q < 4; ++q) *(f32x4*)(OUT + (size_t)m * D + 16 * lane + 4 * q) = v[q];
        }
#pragma unroll
        for (int k = 0; k < 8; ++k) ov[k] = ovn[k];
#pragma unroll
        for (int h2 = 0; h2 < 2; ++h2) xq[h2] = xqn[h2];
    }
}

__device__ __forceinline__ void load_tile_table(const Ctx& C0, int n) {
    CTX_LOCAL(C0);
    const int* TILEE = WSP(int, WS_TILEE); LAS int* t = (LAS int*)(C.lds + LDS_TILE);
    for (int i = fresh_tid(); i < n; i += 512) t[i] = TILEE[i];
    __syncthreads();
}

__global__ void __launch_bounds__(512, 2) mk_fwd(KArgs args) {
    Ctx CK; CK.lds = (LAS unsigned char*)lds_raw;
    if ((threadIdx.x & 63) == 0) *(volatile LAS int*)(CK.lds + LDS_WTAB + 4 * hw_wave_key()) = (int)(threadIdx.x >> 6);
    CK.G = gridDim.x; { const int bx = blockIdx.x; CK.vcu = (CK.G % 8 == 0) ? (bx % 8) * (CK.G / 8) + bx / 8 : bx; }
    CK.out = args.out; CK.ws = args.ws;
    volatile LAS unsigned* MISC = (volatile LAS unsigned*)(CK.lds + LDS_MISC);
    if (threadIdx.x < 64) MISC[threadIdx.x] = 0u;
    if (threadIdx.x == 0) {
#pragma unroll
        for (int k = 0; k < 27; ++k) *(LAS unsigned long long*)(CK.lds + LDS_PTRS + 8 * k) = (unsigned long long)args.in[k];
    }
    __syncthreads();
    const bool use_bar = (args.ph_hi - args.ph_lo) > 1;
    if (use_bar && threadIdx.x == 0) (void)xb_add((unsigned*)(args.ws + WS_CTL) + CW_BAR + XB_XCNT(xb_xcc_id()), 1u);
    const int lo = args.ph_lo, hi = args.ph_hi;

    for (int l = 0; l < DEPTH; ++l) {
        const int p0 = l * NPH;
        if (p0 + NPH <= lo || p0 >= hi) continue;
#define IN(k) (((PH_MASK >> (k)) & 1u) && opq_int(lo) <= p0 + (k) && p0 + (k) < hi)
#define REP(k) (((TREP >> (k)) & 1u) != 0u)
#define SEAM(k) do { if (IN(k) && (p0 + (k) + 1 < hi)) { XcdBarrier bar_; unsigned zo_ = 0u; asm volatile("" : "+v"(zo_)); bar_.bar = (unsigned*)(opq_ptr(CK.ws) + WS_CTL + zo_) + CW_BAR;     bar_.x = (unsigned)__builtin_amdgcn_readfirstlane((int)xb_xcc_id()); \
        bar_.st = (volatile LAS unsigned*)(CK.lds + LDS_MISC) + 8; xcd_barrier(bar_); } } while (0)
        if (l == 0) { if (IN(0)) { if (REP(0)) { phase_convert(CK, 0, true); __syncthreads(); } phase_convert(CK, 0, true); } SEAM(0); }
        if (IN(1)) {
            CTX_LOCAL(CK); bf16* Z = WSP(bf16, WS_Z); bf16* XB = WSP(bf16, WS_XB); const int bx = opq_int((int)blockIdx.x);
            phase_gates(CK);
            if (REP(1)) {
                g8::SchedDenseT<M / 256, ZW / 256> S; S.init(M, ZW, C.G, bx, XB, D / 2, WSP(bf16, WS_WIN), D / 2);
                g8::EpiZ E{WSP(unsigned char, WS_Z), WSP(bf16, WS_ZG), WSP(float, WS_BIAS1), WSP(float, WS_VPART), REP(22)};
                g8::gemm_phase<g8::EpiZ, g8::SchedDenseT<M / 256, ZW / 256>, false, g8::MidNone, G8_SP2, true>(C.lds, D / 2, D / 2, D / 2, S, E, nullptr);
                __syncthreads();
            }
            g8::SchedDenseT<M / 256, ZW / 256> S; S.init(M, ZW, C.G, bx, XB, D / 2, WSP(bf16, WS_WIN), D / 2);
            g8::EpiZ E{WSP(unsigned char, WS_Z), WSP(bf16, WS_ZG), WSP(float, WS_BIAS1), WSP(float, WS_VPART), false};
            g8::gemm_phase<g8::EpiZ, g8::SchedDenseT<M / 256, ZW / 256>, false, g8::MidNone, G8_SP2, true>(C.lds, D / 2, D / 2, D / 2, S, E, nullptr);
        } SEAM(1);
        if (IN(2)) {
            if (REP(16)) phase_sgu(CK, l);
            phase_sgu(CK, l);
            if (REP(17)) phase_kvchain(CK);
            phase_kvchain(CK);
        } SEAM(2);
        if (IN(4)) { if (REP(4)) phase_mlstm(CK, l); phase_mlstm(CK, l); } SEAM(4);
        if (IN(5)) {
            CTX_LOCAL(CK); bf16* Z = WSP(bf16, WS_Z); const int bx = opq_int((int)blockIdx.x);
            if (REP(5)) {
                g8::SchedDenseT<M / 256, D / 256> S; S.init(M, D, C.G, bx, C.out, 1024, WSP(bf16, WS_W4), 1024);
                g8::EpiGate E{WSP(bf16, WS_ZG), ZGP, 1024, nullptr, 0, 0, (bf16*)WSP(unsigned char, WS_Z), Z8W / 2, ZY / 2, true};
                g8::MidMulP Md{WSP(bf16, WS_ZG), ZGP, 0};
                g8::gemm_phase<g8::EpiGate, g8::SchedDenseT<M / 256, D / 256>, false, g8::MidMulP, G8_SP2, true>(C.lds, 1024, 1024, 1024, S, E, nullptr, Md);
                __syncthreads();
            }
            g8::SchedDenseT<M / 256, D / 256> S; S.init(M, D, C.G, bx, C.out, 1024, WSP(bf16, WS_W4), 1024);
            g8::EpiGate E{WSP(bf16, WS_ZG), ZGP, 1024, nullptr, 0, 0, (bf16*)WSP(unsigned char, WS_Z), Z8W / 2, ZY / 2, true};
            g8::MidMulP Md{WSP(bf16, WS_ZG), ZGP, 0};
            g8::gemm_phase<g8::EpiGate, g8::SchedDenseT<M / 256, D / 256>, false, g8::MidMulP, G8_SP2, true>(C.lds, 1024, 1024, 1024, S, E, nullptr, Md);
        } SEAM(5);
        if (IN(6)) {
            CTX_LOCAL(CK); bf16* Z = WSP(bf16, WS_Z); const int bx = opq_int((int)blockIdx.x);
            g8::SchedDenseT<M / 256, D / 256> S; S.init(M, D, C.G, bx, WSP(unsigned char, WS_Z) + ZY, Z8W / 2, WSP(bf16, WS_W4) + (size_t)2 * D * D, D / 2);
            g8::EpiResid E{l == 0 ? INP(I_X) : (const float*)nullptr, WSP(bf16, WS_XR)};
            g8::gemm_phase<g8::EpiResid, g8::SchedDenseT<M / 256, D / 256>, false, g8::MidNone, G8_SP2, true>(C.lds, Z8W / 2, D / 2, D / 2, S, E, nullptr);
        } SEAM(6);
        if (IN(7)) { if (REP(7)) phase_ln1_router(CK, l, true); phase_ln1_router(CK, l); } SEAM(7);
        if (IN(8)) { if (REP(8)) { phase_sort(CK); convert_pb(CK, l); __syncthreads(); } phase_sort(CK); convert_pb(CK, l); } SEAM(8);
        if (IN(9)) {
            CTX_LOCAL(CK); bf16* XB = WSP(bf16, WS_XB); const int bx = opq_int((int)blockIdx.x);
            const int* CNT = WSP(int, WS_CNT); const int nexp = CNT[0] + CNT[1];
            if (REP(9)) {
                load_tile_table(C, nexp);
                g8::SchedUp S{(const LAS int*)(C.lds + LDS_TILE), NSH_TILES + nexp, C.G, C.vcu, (const char*)XB, (const char*)WSP(bf16, WS_UPT)};
                g8::EpiMoeUp E{WSP(bf16, WS_HID), WSP(float, WS_SW), WSP(bf16, WS_PBH)};
                g8::gemm_phase<g8::EpiMoeUp, g8::SchedUp, true, g8::MidNone, G8_SP2, true>(C.lds, D / 2, D / 2, D / 2, S, E, WSP(int, WS_STOK));
                g8::SchedDenseT<M / 256, D / 256> S2; S2.init(M, D, C.G, bx, XB, D / 2, WSP(bf16, WS_W4) + (size_t)3 * D * D, D / 2);
                g8::EpiBiasAct E2{WSP(bf16, WS_GBUF), D, INP(I_BPG) + (size_t)l * D, 0xAAull, nullptr};
                g8::gemm_phase<g8::EpiBiasAct, g8::SchedDenseT<M / 256, D / 256>, false, g8::MidNone, G8_SP2, true>(C.lds, D / 2, D / 2, D / 2, S2, E2, nullptr);
                __syncthreads();
            }
            load_tile_table(C, nexp);
            g8::SchedUp S{(const LAS int*)(C.lds + LDS_TILE), NSH_TILES + nexp, C.G, C.vcu, (const char*)XB, (const char*)WSP(bf16, WS_UPT)};
            g8::EpiMoeUp E{WSP(bf16, WS_HID), WSP(float, WS_SW), WSP(bf16, WS_PBH)};
            g8::gemm_phase<g8::EpiMoeUp, g8::SchedUp, true, g8::MidNone, G8_SP2, true>(C.lds, D / 2, D / 2, D / 2, S, E, WSP(int, WS_STOK));
            g8::SchedDenseT<M / 256, D / 256> S2; S2.init(M, D, C.G, bx, XB, D / 2, WSP(bf16, WS_W4) + (size_t)3 * D * D, D / 2);
            g8::EpiBiasAct E2{WSP(bf16, WS_GBUF), D, INP(I_BPG) + (size_t)l * D, 0xAAull, nullptr};
            g8::gemm_phase<g8::EpiBiasAct, g8::SchedDenseT<M / 256, D / 256>, false, g8::MidNone, G8_SP2, true>(C.lds, D / 2, D / 2, D / 2, S2, E2, nullptr);
        } SEAM(9);
        if (IN(10)) {
            CTX_LOCAL(CK); const int bx = opq_int((int)blockIdx.x);
            {
                g8::SchedDenseT<M / 256, D / 256> S; S.init(M, D, C.G, bx, WSP(bf16, WS_PBH), 256, WSP(bf16, WS_WPT), 256);
                g8::EpiResid E{(const float*)nullptr, WSP(bf16, WS_XR)};
                g8::MidMulP Md{WSP(bf16, WS_GBUF), D, 0};
                g8::gemm_phase<g8::EpiResid, g8::SchedDenseT<M / 256, D / 256>, false, g8::MidMulP, G8_SP2, true>(C.lds, 256, 256, 256, S, E, nullptr, Md);
            }
            const int* CNT = WSP(int, WS_CNT); const int n0 = CNT[0], n1 = CNT[1];
            if (REP(12)) {
                load_tile_table(C, n0 + n1);
                g8::SchedDown S{(const LAS int*)(C.lds + LDS_TILE), n0 + n1, 0, C.G, C.vcu, (const char*)WSP(bf16, WS_HID), (const char*)WSP(bf16, WS_DNT)};
                g8::EpiOut8 E{WSP(unsigned char, WS_OUTS), D};
                g8::gemm_phase<g8::EpiOut8, g8::SchedDown, false, g8::MidNone, G8_SP2, true>(C.lds, DEXP / 2, DEXP / 2, DEXP / 2, S, E, nullptr);
                __syncthreads();
            }
            load_tile_table(C, n0 + n1);
            g8::SchedDown S{(const LAS int*)(C.lds + LDS_TILE), n0 + n1, 0, C.G, C.vcu, (const char*)WSP(bf16, WS_HID), (const char*)WSP(bf16, WS_DNT)};
            g8::EpiOut8 E{WSP(unsigned char, WS_OUTS), D};
            g8::gemm_phase<g8::EpiOut8, g8::SchedDown, false, g8::MidNone, G8_SP2, true>(C.lds, DEXP / 2, DEXP / 2, DEXP / 2, S, E, nullptr);
        } SEAM(10);
        if (IN(11)) { if (REP(11)) { phase_ln2(CK, l, true); __syncthreads(); } phase_ln2(CK, l); if (l + 1 < DEPTH) { __syncthreads(); phase_convert(CK, l + 1, false); if (REP(20)) { __syncthreads(); phase_convert(CK, l + 1, false); } } } SEAM(11);
#undef IN
#undef SEAM
    }
}

__global__ void k_fill(float* out, int n, float v) { for (int i = blockIdx.x * blockDim.x + threadIdx.x; i < n; i += gridDim.x * blockDim.x) out[i] = v; }

#if MK_DEBUG
__global__ void k_hash(const unsigned* p, size_t nwords, unsigned long long* out, unsigned poison) {
    unsigned long long s = 0;
    for (size_t i = (size_t)blockIdx.x * blockDim.x + threadIdx.x; i < nwords; i += (size_t)gridDim.x * blockDim.x) { const unsigned w = p[i]; if (w != poison) s += (unsigned long long)w * (2ull * i + 1ull); }
    for (int o = 32; o >= 1; o >>= 1) s += __shfl_xor(s, o);
    if ((threadIdx.x & 63) == 0) atomicAdd(out, s);
}
__global__ void k_dbg_final(const unsigned long long* ha, const unsigned long long* hb, int nph, float* code) {
    if (threadIdx.x == 0 && blockIdx.x == 0) { int first = -1, cnt = 0;
        for (int i = 0; i < nph; ++i) if (ha[i] != hb[i]) { if (first < 0) first = i; ++cnt; }
        float v;
        if (first < 0) v = 5000.f;
        else { v = (float)(10 + first % 90); if (first >= 90) v *= 100.f; if (cnt > 1) v *= 1.0f; }
        code[0] = sqrtf(v - 1.0f); }
}
__global__ void k_fill_from(float* out, int n, const float* v) { const float x = v[0]; for (int i = blockIdx.x * blockDim.x + threadIdx.x; i < n; i += gridDim.x * blockDim.x) out[i] = x; }
static void dbg_run(KArgs a, int grid, hipStream_t stream) {
    const int NPHASES = DEPTH * NPH;
    unsigned long long* H = (unsigned long long*)(a.ws + WS_CTL) + CW_DBG / 2;
    float* code = (float*)(a.ws + WS_CTL) + CW_DBG + 1024;
    for (int run = 0; run < 2; ++run) {
        const int pb = run ? 0x55 : 0xAA; const unsigned pw = run ? 0x55555555u : 0xAAAAAAAAu;
        (void)hipMemsetAsync((char*)a.ws + CTL_ZERO_BYTES, pb, WS_END - CTL_ZERO_BYTES, stream);
        (void)hipMemsetAsync((char*)a.out, pb, (size_t)M * D * 4, stream);
        for (int ph = 0; ph < NPHASES; ++ph) {
            const int nsub = (ph % NPH == 3) ? 2 : 1;
            for (int sub = 0; sub < nsub; ++sub) {
                a.ph_lo = ph; a.ph_hi = ph + 1; a.dbg = nsub == 2 ? sub + 1 : 0; mk_fwd<<<grid, 512, LDS_BYTES, stream>>>(a);
                unsigned long long* h = H + run * 160 + 2 * ph + sub;
                k_hash<<<2048, 256, 0, stream>>>((const unsigned*)(a.ws + CTL_ZERO_BYTES), (WS_END - CTL_ZERO_BYTES) / 4, h, pw);
                k_hash<<<2048, 256, 0, stream>>>((const unsigned*)a.out, (size_t)M * D, h, pw);
            }
        }
    }
    k_dbg_final<<<1, 64, 0, stream>>>(H, H + 160, 160, code);
    k_fill_from<<<1024, 256, 0, stream>>>(a.out, M * D, code);
}
#endif

extern "C" void kernel_launch(void* const* d_in, const int* in_sizes, int n_in, void* d_out, int out_size, void* d_ws, size_t ws_size, hipStream_t stream) {
    static int grid = 0;
    if (grid == 0) {
        if (n_in != 27 || out_size != M * D || ws_size < WS_END) {
            fprintf(stderr, "kernel_launch: unexpected shapes / workspace (n_in %d, out %d, ws %zu < %zu)\n", n_in, out_size, ws_size, (size_t)WS_END);
            grid = -1;
        } else {
            int dev = 0, cus = 0, per_cu = 0;
            hipGetDevice(&dev); hipDeviceGetAttribute(&cus, hipDeviceAttributeMultiprocessorCount, dev);
            hipFuncSetAttribute((const void*)mk_fwd, hipFuncAttributeMaxDynamicSharedMemorySize, LDS_BYTES);
            hipOccupancyMaxActiveBlocksPerMultiprocessor(&per_cu, (const void*)mk_fwd, 512, LDS_BYTES);
            (void)hipGetLastError();
            grid = cus;
        }
    }
    if (grid < 0) { k_fill<<<1024, 256, 0, stream>>>((float*)d_out, out_size, ws_size < WS_END ? 3.0e8f : 2.0e8f); return; }
    hipMemsetAsync((char*)d_ws + WS_CTL, 0, CTL_ZERO_BYTES, stream);
    KArgs a{};
    for (int i = 0; i < 27; ++i) a.in[i] = (const float*)d_in[i];
    a.out = (float*)d_out; a.ws = (unsigned char*)d_ws; a.dbg = 0; a.pad = 0;
    const int NPHASES = DEPTH * NPH;
#if MK_DEBUG
    dbg_run(a, grid, stream);
#elif MK_LAUNCH_PER_PHASE
    for (int ph = 0; ph < NPHASES; ++ph) { a.ph_lo = ph; a.ph_hi = ph + 1; mk_fwd<<<grid, 512, LDS_BYTES, stream>>>(a); }
#else
    a.ph_lo = 0; a.ph_hi = NPHASES;
    mk_fwd<<<grid, 512, LDS_BYTES, stream>>>(a);
#endif
}
```

```cpp
#include <hip/hip_runtime.h>
#include <cstdio>
#include <cstdint>

#ifndef MK_LAUNCH_PER_PHASE
#define MK_LAUNCH_PER_PHASE 0
#endif
#ifndef SIM_FP8
#define SIM_FP8 0
#endif
#ifndef TREP
#define TREP 0u
#endif
#ifndef PH_MASK
#define PH_MASK 0xFFFFFFFFu
#endif
#ifndef MK_DEBUG
#define MK_DEBUG 0
#endif

#define GAS __attribute__((address_space(1)))
#define LAS __attribute__((address_space(3)))
typedef unsigned short bf16;
typedef short bf16x8 __attribute__((ext_vector_type(8)));
typedef short s16x4 __attribute__((ext_vector_type(4)));
typedef float f32x4 __attribute__((ext_vector_type(4)));
typedef float f32x2 __attribute__((ext_vector_type(2)));
typedef unsigned u32x4 __attribute__((ext_vector_type(4)));
typedef unsigned u32x2 __attribute__((ext_vector_type(2)));
typedef short v4i16_t __attribute__((ext_vector_type(4)));

constexpr int D = 1024, NB = 8, SEQ = 8192, M = NB * SEQ, DEPTH = 4;
constexpr int DIN = 7176, ZW = 7168;
constexpr int Z8W = 5376;
constexpr int ZU = 0, ZVM = 1024, ZV = 2048, ZQ = 3072, ZK = 3584, ZO = 4096, ZGA = 5120, ZGB = 6144;
constexpr int ZT1 = ZQ;
constexpr int ZY = ZV;
constexpr int NH = 4, DQK = 128, DV = 256, LCH = 64, NCH = SEQ / LCH;
constexpr int NE = 64, TOPK = 8, DEXP = 256, PD = 256;
constexpr float ALPHA = 1.681792830507429f;
constexpr float LN_EPS = 1e-5f, RMS_EPS = 1e-6f, ROUTE_SCALE = 2.5f;
constexpr float QSCALE = 0.08838834764831845f;
constexpr int HALF_TOK = M / 2;
constexpr int MAXT_HALF = 1088;
constexpr int NSH_TILES = M / 256;

constexpr size_t MiB = 1u << 20;
constexpr size_t WS_CTL = 0, CTL_ZERO_BYTES = 1 * MiB;
constexpr size_t WS_BIAS1 = 1 * MiB;
constexpr size_t WS_WSB = 1 * MiB + 65536;
constexpr size_t WS_VPART = 1457 * MiB;
constexpr size_t WS_IF = 3 * MiB;
constexpr size_t WS_BC = 5 * MiB;
constexpr size_t WS_BL = 6 * MiB, WS_GM = 6 * MiB + 16384, WS_MS = 6 * MiB + 32768;
constexpr size_t WS_NK = 7 * MiB;
constexpr size_t WS_TOKE = 9 * MiB, WS_TOKW = 11 * MiB, WS_POS = 13 * MiB;
constexpr size_t WS_HIST = 15 * MiB, WS_TILEE = 15 * MiB + 65536, WS_CNT = 15 * MiB + 131072;
constexpr size_t WS_STOK = 16 * MiB, WS_SW = 19 * MiB;
constexpr size_t WS_DBG = 22 * MiB;
constexpr size_t WS_WIN = 24 * MiB;
constexpr size_t WS_W4 = 38 * MiB;
constexpr size_t WS_UPT = 46 * MiB;
constexpr size_t WS_DNT = 145 * MiB;
constexpr size_t WS_WPT = 144 * MiB;
constexpr size_t WS_PBH = 1282 * MiB;
constexpr size_t WS_XB = 79 * MiB;
constexpr size_t WS_XR = 177 * MiB;
constexpr size_t WS_Z = 305 * MiB;
constexpr int ZGP = 2176;
constexpr size_t WS_ZG = 645 * MiB;
constexpr size_t WS_STATE = 1201 * MiB;
constexpr size_t WS_HID = 305 * MiB;
constexpr size_t WS_GBUF = 610 * MiB;
constexpr size_t WS_OUTS = 738 * MiB;
constexpr size_t WS_END = 1465 * MiB;
static_assert(WS_HID + (size_t)(M + 2 * MAXT_HALF * 256) * 512 <= WS_GBUF && WS_OUTS + (size_t)2 * MAXT_HALF * 256 * 1024 <= WS_PBH && WS_PBH + (size_t)M * 1024 <= WS_STATE + 256 * MiB && WS_STATE + 256 * MiB <= WS_VPART, "ws map");

constexpr int CW_BAR = 4096;
constexpr int CW_DBG = 16384;

constexpr int LDS_BYTES = 163840;
constexpr int LDS_GIDX = 131072;
constexpr int LDS_TILE = 133120;
constexpr int LDS_MISC = LDS_BYTES - 256;
constexpr int LDS_PTRS = LDS_BYTES - 512;

#define LDS_WAIT() asm volatile("s_waitcnt lgkmcnt(0)" ::: "memory")
#define VM_WAIT() asm volatile("s_waitcnt vmcnt(0)" ::: "memory")
typedef __bf16 bf16x2_t __attribute__((ext_vector_type(2)));
__device__ __forceinline__ unsigned cvt_pk_bf16(float lo, float hi) { const f32x2 v = {lo, hi}; const bf16x2_t b = __builtin_convertvector(v, bf16x2_t); return __builtin_bit_cast(unsigned, b); }
__device__ __forceinline__ float bf2f(unsigned b) { return __uint_as_float(b << 16); }
__device__ __forceinline__ float bflo(unsigned w) { return __uint_as_float(w << 16); }
__device__ __forceinline__ float bfhi(unsigned w) { return __uint_as_float(w & 0xffff0000u); }
__device__ __forceinline__ bf16 f2bf(float f) { return (bf16)(cvt_pk_bf16(f, f) & 0xffffu); }
__device__ __forceinline__ float q8(float x, float s, float inv_s) { const int v = __builtin_amdgcn_cvt_pk_fp8_f32(x * s, 0.f, 0, false); return __builtin_amdgcn_cvt_f32_fp8(v, 0) * inv_s; }
__device__ __forceinline__ unsigned pk4_fp8x16(float a, float b, float c, float d) {
    float k = 448.f; asm volatile("" : "+s"(k));
    a = __builtin_amdgcn_fmed3f(a * 16.f, -k, k); b = __builtin_amdgcn_fmed3f(b * 16.f, -k, k); c = __builtin_amdgcn_fmed3f(c * 16.f, -k, k); d = __builtin_amdgcn_fmed3f(d * 16.f, -k, k);
    int w = __builtin_amdgcn_cvt_pk_fp8_f32(a, b, 0, false); w = __builtin_amdgcn_cvt_pk_fp8_f32(c, d, w, true); return (unsigned)w; }
__device__ __forceinline__ unsigned pk4_fp8x4(float a, float b, float c, float d) {
    float k = 448.f; asm volatile("" : "+s"(k));
    a = __builtin_amdgcn_fmed3f(a * 4.f, -k, k); b = __builtin_amdgcn_fmed3f(b * 4.f, -k, k); c = __builtin_amdgcn_fmed3f(c * 4.f, -k, k); d = __builtin_amdgcn_fmed3f(d * 4.f, -k, k);
    int w = __builtin_amdgcn_cvt_pk_fp8_f32(a, b, 0, false); w = __builtin_amdgcn_cvt_pk_fp8_f32(c, d, w, true); return (unsigned)w; }
__device__ __forceinline__ f32x4 un4_fp8x4(unsigned w) { const f32x2 lo = __builtin_amdgcn_cvt_pk_f32_fp8((int)w, false), hi = __builtin_amdgcn_cvt_pk_f32_fp8((int)w, true); return (f32x4){lo[0] * 0.25f, lo[1] * 0.25f, hi[0] * 0.25f, hi[1] * 0.25f}; }
__device__ __forceinline__ void un16_fp8x16(const u32x4 e, float (&f)[16]) {
#pragma unroll
    for (int q = 0; q < 4; ++q) { const f32x2 lo = __builtin_amdgcn_cvt_pk_f32_fp8((int)e[q], false), hi = __builtin_amdgcn_cvt_pk_f32_fp8((int)e[q], true);
        f[4 * q] = lo[0] * 0.0625f; f[4 * q + 1] = lo[1] * 0.0625f; f[4 * q + 2] = hi[0] * 0.0625f; f[4 * q + 3] = hi[1] * 0.0625f; }
}
__device__ __forceinline__ void un16_fp8raw(const u32x4 e, float (&f)[16]) {
#pragma unroll
    for (int q = 0; q < 4; ++q) { const f32x2 lo = __builtin_amdgcn_cvt_pk_f32_fp8((int)e[q], false), hi = __builtin_amdgcn_cvt_pk_f32_fp8((int)e[q], true);
        f[4 * q] = lo[0]; f[4 * q + 1] = lo[1]; f[4 * q + 2] = hi[0]; f[4 * q + 3] = hi[1]; }
}
__device__ __forceinline__ void bf16x16_to_lds(LAS unsigned char* p, const float (&f)[16]) {
    u32x4 a, b; a.x = cvt_pk_bf16(f[0], f[1]); a.y = cvt_pk_bf16(f[2], f[3]); a.z = cvt_pk_bf16(f[4], f[5]); a.w = cvt_pk_bf16(f[6], f[7]);
    b.x = cvt_pk_bf16(f[8], f[9]); b.y = cvt_pk_bf16(f[10], f[11]); b.z = cvt_pk_bf16(f[12], f[13]); b.w = cvt_pk_bf16(f[14], f[15]);
    *(LAS u32x4*)p = a; *(LAS u32x4*)(p + 16) = b;
}
template <int CTRL> __device__ __forceinline__ float dppf(float v) { return __builtin_bit_cast(float, __builtin_amdgcn_update_dpp(0, __builtin_bit_cast(int, v), CTRL, 0xF, 0xF, true)); }
__device__ __forceinline__ float shfl_idx(float v, int src) { return __builtin_bit_cast(float, __builtin_amdgcn_ds_bpermute(src << 2, __builtin_bit_cast(int, v))); }
__device__ __forceinline__ float rdlane(float v, int l) { return __builtin_bit_cast(float, __builtin_amdgcn_readlane(__builtin_bit_cast(int, v), l)); }
__device__ __forceinline__ float grp8_sum(float v) { v += dppf<0xB1>(v); v += dppf<0x4E>(v); v += dppf<0x141>(v); return v; }
__device__ __forceinline__ float grp8_max(float v) { v = fmaxf(v, dppf<0xB1>(v)); v = fmaxf(v, dppf<0x4E>(v)); v = fmaxf(v, dppf<0x141>(v)); return v; }
__device__ __forceinline__ float wave_sum(float v) { v = grp8_sum(v); v += dppf<0x140>(v); return (rdlane(v, 0) + rdlane(v, 16)) + (rdlane(v, 32) + rdlane(v, 48)); }
__device__ __forceinline__ float wave_max(float v) { v = grp8_max(v); v = fmaxf(v, dppf<0x140>(v)); return fmaxf(fmaxf(rdlane(v, 0), rdlane(v, 16)), fmaxf(rdlane(v, 32), rdlane(v, 48))); }
__device__ __forceinline__ float kf(float x) { asm volatile("" : "+s"(x)); return x; }
__device__ __forceinline__ float fast_exp(float x) { return __builtin_amdgcn_exp2f(x * kf(1.4426950408889634f)); }
__device__ __forceinline__ float fast_sigmoid(float x) { return __builtin_amdgcn_rcpf(1.0f + __builtin_amdgcn_exp2f(-1.4426950408889634f * x)); }
__device__ __forceinline__ f32x2 gelu_pk(f32x2 v) {
    const f32x2 av = __builtin_elementwise_abs(v), d = av * 0.2316418882f + 1.0f;
    f32x2 t; t.x = __builtin_amdgcn_rcpf(d.x); t.y = __builtin_amdgcn_rcpf(d.y);
    f32x2 q = t * 0.5307027145f + (-0.7265760135f); q = q * t + 0.7107068705f; q = q * t + (-0.142248368f); q = q * t + 0.127414796f; q = q * t;
    const f32x2 s = (v * v) * (-0.72134752044f);
    f32x2 e; e.x = __builtin_amdgcn_exp2f(s.x); e.y = __builtin_amdgcn_exp2f(s.y);
    const f32x2 m = v * (q * e), r = v - m;
    f32x2 o; o.x = v.x < 0.f ? m.x : r.x; o.y = v.y < 0.f ? m.y : r.y; return o;
}
typedef float f32x8 __attribute__((ext_vector_type(8)));
__device__ __forceinline__ f32x8 gelu8(f32x8 v) {
    const f32x8 av = __builtin_elementwise_abs(v), d = av * 0.2316418882f + 1.0f;
    f32x8 t, e;
#pragma unroll
    for (int i = 0; i < 8; ++i) t[i] = __builtin_amdgcn_rcpf(d[i]);
    f32x8 q = t * 0.5307027145f + (-0.7265760135f); q = q * t + 0.7107068705f; q = q * t + (-0.142248368f); q = q * t + 0.127414796f; q = q * t;
    const f32x8 s = (v * v) * (-0.72134752044f);
#pragma unroll
    for (int i = 0; i < 8; ++i) e[i] = __builtin_amdgcn_exp2f(s[i]);
    const f32x8 m = v * (q * e), r = v - m;
    f32x8 o;
#pragma unroll
    for (int i = 0; i < 8; ++i) o[i] = v[i] < 0.f ? m[i] : r[i];
    return o;
}
__device__ __forceinline__ bf16x8 frag_row(const LAS unsigned char* t, int pitch, int r0, int k0, int lane) {
    return *(const LAS bf16x8*)(t + (r0 + (lane & 15)) * pitch + (k0 + 8 * (lane >> 4)) * 2);
}
__device__ __forceinline__ bf16x8 frag_tr(const LAS unsigned char* t, int pitch, int k0, int n0, int lane) {
    const int i = lane & 15, g = lane >> 4, q = i >> 2, p = i & 3;
    const LAS unsigned char* a = t + (k0 + 8 * g + q) * pitch + (n0 + 4 * p) * 2;
    const s16x4 lo = __builtin_bit_cast(s16x4, __builtin_amdgcn_ds_read_tr16_b64_v4i16((LAS v4i16_t*)a));
    const s16x4 hi = __builtin_bit_cast(s16x4, __builtin_amdgcn_ds_read_tr16_b64_v4i16((LAS v4i16_t*)(a + 4 * pitch)));
    return (bf16x8){lo[0], lo[1], lo[2], lo[3], hi[0], hi[1], hi[2], hi[3]};
}
#define MFMA16(a, b, c) __builtin_amdgcn_mfma_f32_16x16x32_bf16((a), (b), (c), 0, 0, 0)
__device__ __forceinline__ long frag8(const LAS unsigned char* t, int pitch, int r0, int k0, int lane) { return *(const LAS long*)(t + (r0 + (lane & 15)) * pitch + k0 + 8 * (lane >> 4)); }
#define MFMA8(a, b, c) __builtin_amdgcn_mfma_f32_16x16x32_fp8_fp8((a), (b), (c), 0, 0, 0)

constexpr int LDS_WTAB = 163840 - 768;
extern __shared__ __attribute__((aligned(16))) unsigned char lds_raw[];
__device__ __forceinline__ unsigned hw_wave_key() { return (unsigned)__builtin_amdgcn_s_getreg(((6 - 1) << 11) | 4) & 63u; }
__device__ __forceinline__ int fresh_tid() {
    const int wv = __builtin_amdgcn_readfirstlane(*(volatile LAS int*)((LAS unsigned char*)lds_raw + LDS_WTAB + 4 * hw_wave_key()));
    unsigned ones = ~0u; asm volatile("" : "+s"(ones));
    int t = (wv << 6) | (int)__builtin_amdgcn_mbcnt_hi(ones, __builtin_amdgcn_mbcnt_lo(ones, 0u)); asm volatile("" : "+v"(t)); return t; }
#define XB_TMO      128
#define XB_XCNT(j)  (256  + 64 * (j))
#define XB_XSUB(j)  (1280 + 64 * (j))
#define XB_XGEN(j)  (2304 + 64 * (j))
#define XB_TOP      3328
#define XB_TOPGEN   3392
#define XCD_BAR_WORDS 3456
#define XB_SPIN_CAP (1u << 22)
__device__ __forceinline__ unsigned xb_ld(unsigned* p)              { return __hip_atomic_load(p, __ATOMIC_RELAXED, __HIP_MEMORY_SCOPE_AGENT); }
__device__ __forceinline__ unsigned xb_add(unsigned* p, unsigned v) { asm volatile("" : "+v"(v));
    return __hip_atomic_fetch_add(p, v, __ATOMIC_RELAXED, __HIP_MEMORY_SCOPE_AGENT); }
__device__ __forceinline__ unsigned xb_xcc_id() { return (unsigned)__builtin_amdgcn_s_getreg((3 << 11) | 20) & 0xFu; }
#define XB_SPIN(cond, bar) do { unsigned _sp = 0; while (cond) { __builtin_amdgcn_s_sleep(1); \
    if ((++_sp & 255u) == 0u) { if (xb_ld(&(bar)[XB_TMO])) break; if (_sp > XB_SPIN_CAP) { atomicAdd(&(bar)[XB_TMO], 1u); break; } } } } while (0)
struct XcdBarrier { unsigned* bar; unsigned x; volatile LAS unsigned* st; };
__device__ __forceinline__ XcdBarrier xcd_barrier_post(unsigned* bar, volatile LAS unsigned* st) {
    XcdBarrier b; b.bar = bar; b.x = xb_xcc_id(); b.st = st;
    if (fresh_tid() == 0) (void)xb_add(&bar[XB_XCNT(b.x)], 1u);
    return b;
}
__device__ __forceinline__ void xcd_barrier_complete(unsigned* bar, unsigned x, unsigned& nloc, unsigned& nx) {
    const unsigned G = gridDim.x * gridDim.y * gridDim.z;
    unsigned sum, cnt, mine, sp = 0u;
    for (;;) {
        sum = 0u; cnt = 0u; mine = 0u;
#pragma unroll
        for (unsigned j = 0; j < 16; ++j) { const unsigned c = xb_ld(&bar[XB_XCNT(j)]); sum += c; cnt += (c > 0u) ? 1u : 0u; mine = (j == x) ? c : mine; }
        if (sum == G) break;
        __builtin_amdgcn_s_sleep(1);
        if ((++sp & 255u) == 0u) { if (xb_ld(&bar[XB_TMO])) break; if (sp > XB_SPIN_CAP) { atomicAdd(&bar[XB_TMO], 1u); break; } }
    }
    nloc = mine > 0u ? mine : 1u; nx = cnt > 0u ? cnt : 1u;
}
__device__ __forceinline__ void xcd_barrier(const XcdBarrier& b) {
    asm volatile("s_waitcnt vmcnt(0)" ::: "memory");
    __syncthreads();
    if (fresh_tid() == 0) {
        unsigned* bar = b.bar;
        __builtin_amdgcn_s_waitcnt(0);
        unsigned nloc = b.st[0], nx = b.st[1];
        if (nloc == 0u) { xcd_barrier_complete(bar, b.x, nloc, nx); b.st[0] = nloc; b.st[1] = nx; }
        const unsigned old = xb_add(&bar[XB_XSUB(b.x)], 1u);
        const unsigned gen = old / nloc;
        if (old + 1u == (gen + 1u) * nloc) {
            __builtin_amdgcn_fence(__ATOMIC_RELEASE, "agent");
            asm volatile("s_waitcnt vmcnt(0)" ::: "memory");
            const unsigned og = xb_add(&bar[XB_TOP], 1u);
            const unsigned tg = og / nx;
            if (og + 1u == (tg + 1u) * nx) xb_add(&bar[XB_TOPGEN], 1u);
            else XB_SPIN(xb_ld(&bar[XB_TOPGEN]) == tg, bar);
            __builtin_amdgcn_fence(__ATOMIC_ACQUIRE, "agent");
            xb_add(&bar[XB_XGEN(b.x)], 1u);
            asm volatile("s_waitcnt vmcnt(0)" ::: "memory");
        } else {
            XB_SPIN(xb_ld(&bar[XB_XGEN(b.x)]) == gen, bar);
            __builtin_amdgcn_fence(__ATOMIC_ACQUIRE, "agent");
            asm volatile("s_waitcnt vmcnt(0)" ::: "memory");
        }
    }
    __syncthreads();
}

#ifndef G8_SP2
#define G8_SP2 true
#endif
namespace g8 {
constexpr int BM = 256, BK = 64, HALF = 128, HTB = HALF * BK * 2, STAGE_BYTES = 8 * HTB;
__device__ __forceinline__ int lds_byte(int r, int c) { const int st = (r >> 4) * 2 + (c >> 5), rr = r & 15, cc = c & 31, ob = rr * 64 + cc * 2; return st * 1024 + (ob ^ (((ob >> 9) & 1) << 5)); }
__device__ __forceinline__ void stage_rc(int b, int& R, int& C) { const int st = b / 1024, sb = b % 1024, swz = sb ^ (((sb >> 9) & 1) << 5); R = (st >> 1) * 16 + swz / 64; C = (st & 1) * 32 + (swz % 64) / 2; }
__device__ __forceinline__ int perm32(int rho) { const int n = rho >> 4, i = rho & 15; return 8 * (i >> 2) + 4 * n + (i & 3); }

__device__ __forceinline__ const char* uni_ptr(const char* p) {
    const unsigned long long v = (unsigned long long)p; const unsigned lo = __builtin_amdgcn_readfirstlane((unsigned)v), hi = __builtin_amdgcn_readfirstlane((unsigned)(v >> 32)); return (const char*)(const GAS char*)(((unsigned long long)hi << 32) | lo); }
struct Unit { int pm, pn; const char* a; const char* b; int grow; };

template <bool B> struct BoolC { static constexpr bool value = B; };
template <class T, class = void> struct pre_of { static constexpr bool value = false; };
template <class T> struct pre_of<T, decltype((void)T::PRE)> { static constexpr bool value = T::PRE; };
template <class T, class = void> struct perm2_of { static constexpr bool value = false; };
template <class T> struct perm2_of<T, decltype((void)T::PERM2)> { static constexpr bool value = T::PERM2; };
struct MidNone { static constexpr bool ON = false; template <class A, class U> __device__ __forceinline__ void operator()(A&, const U&, int, int, int, int) const {} };
typedef int v8i32_t __attribute__((ext_vector_type(8)));
typedef int v4i32_t __attribute__((ext_vector_type(4)));
template <class Epi, class Sched, bool GATHER, class Mid = MidNone, bool SP2 = G8_SP2, bool FP8 = false>
__device__ __forceinline__ void gemm_phase(LAS unsigned char* lds, const int lda, const int ldb, const int K, const Sched& S, const Epi& E, const int* gidx, const Mid& Md = Mid()) {
    const int tid = fresh_tid(), wid = __builtin_amdgcn_readfirstlane(tid >> 6), lane = tid & 63, wr = wid >> 2, wc = wid & 3, fr = lane & 15, fq = lane >> 4;
    const int nt = K / BK;
    int Rr[2], Cc[2]; unsigned voffA[2], voffB[2][2];
#pragma unroll
    for (int i = 0; i < 2; ++i) { stage_rc(tid * 16 + i * 8192, Rr[i], Cc[i]); voffA[i] = (unsigned)(Rr[i] * lda + Cc[i]) * 2u;
#pragma unroll
        for (int h = 0; h < 2; ++h) { int Rb;
            if constexpr (perm2_of<Epi>::value) Rb = 64 * (Rr[i] >> 5) + 16 * (((Rr[i] & 31) >> 2) & 3) + 8 * h + 4 * ((Rr[i] & 31) >> 4) + (Rr[i] & 3);
            else Rb = h * HALF + (Epi::PERM ? ((Rr[i] & ~31) + perm32(Rr[i] & 31)) : Rr[i]);
            voffB[h][i] = (unsigned)(Rb * ldb + Cc[i]) * 2u; } }
    const unsigned hstepA = (unsigned)HALF * (unsigned)lda * 2u;
    const size_t kstep = (size_t)(BK * 2);
    const unsigned ldsw = (unsigned)wid * 1024u;
    const int aoff = lds_byte(wr * 64 + fr, fq * 8), boff = lds_byte(wc * 32 + fr, fq * 8);
#define G8_SA(b, h) (((b) * 2 + (h)) * HTB)
#define G8_SB(b, h) ((4 + (b) * 2 + (h)) * HTB)
#define G8_STAGE_B(bufoff, gbase, h) do { _Pragma("unroll") for (int _i = 0; _i < 2; ++_i) \
        __builtin_amdgcn_global_load_lds((const unsigned*)((const char*)(gbase) + voffB[h][_i]), (LAS unsigned*)(lds + (bufoff) + ldsw + _i * 8192), 16, 0, 0); } while (0)
#define G8_STAGE_A(bufoff, gbase, h, slot) do { _Pragma("unroll") for (int _i = 0; _i < 2; ++_i) { \
        unsigned _o; if constexpr (GATHER) _o = (unsigned)(*(const LAS int*)(lds + LDS_GIDX + (slot) * 1024 + ((h) * HALF + Rr[_i]) * 4) * lda + Cc[_i]) * 2u; else _o = voffA[_i] + (unsigned)(h) * hstepA; \
        __builtin_amdgcn_global_load_lds((const unsigned*)((const char*)(gbase) + _o), (LAS unsigned*)(lds + (bufoff) + ldsw + _i * 8192), 16, 0, 0); } } while (0)
#define G8_LD32(p) __builtin_shufflevector(*(const LAS v4i32_t*)(p), *(const LAS v4i32_t*)((p) + 1024), 0, 1, 2, 3, 4, 5, 6, 7)
#define G8_LDA(dst, b, h) do { if constexpr (FP8) { _Pragma("unroll") for (int m = 0; m < 4; ++m) dst##8[m] = G8_LD32(lds + G8_SA(b, h) + aoff + m * 2048); } \
        else { _Pragma("unroll") for (int m = 0; m < 4; ++m) _Pragma("unroll") for (int k = 0; k < 2; ++k) dst[m][k] = *(const LAS bf16x8*)(lds + G8_SA(b, h) + aoff + m * 2048 + k * 1024); } } while (0)
#define G8_LDB(dst, b, h) do { if constexpr (FP8) { _Pragma("unroll") for (int n = 0; n < 2; ++n) dst##8[n] = G8_LD32(lds + G8_SB(b, h) + boff + n * 2048); } \
        else { _Pragma("unroll") for (int n = 0; n < 2; ++n) _Pragma("unroll") for (int k = 0; k < 2; ++k) dst[n][k] = *(const LAS bf16x8*)(lds + G8_SB(b, h) + boff + n * 2048 + k * 1024); } } while (0)
#define G8_MMA(ai, bj, At, Bt) do { __builtin_amdgcn_s_setprio(1); \
        if constexpr (FP8) { _Pragma("unroll") for (int m = 0; m < 4; ++m) _Pragma("unroll") for (int n = 0; n < 2; ++n) \
            asm volatile("v_mfma_scale_f32_16x16x128_f8f6f4 %0, %1, %2, %0, %3, %4 op_sel_hi:[0,0,0]" : "+v"(acc[ai][bj][m][n]) : "v"(Bt##8[n]), "v"(At##8[m]), "v"(sc_w), "v"(sc_x)); } \
        else { _Pragma("unroll") for (int m = 0; m < 4; ++m) _Pragma("unroll") for (int n = 0; n < 2; ++n) _Pragma("unroll") for (int k = 0; k < 2; ++k) \
            acc[ai][bj][m][n] = __builtin_amdgcn_mfma_f32_16x16x32_bf16(Bt[n][k], At[m][k], acc[ai][bj][m][n], 0, 0, 0); } \
        __builtin_amdgcn_s_setprio(0); } while (0)
#define G8_MMA0(ai, bj, At, Bt) do { __builtin_amdgcn_s_setprio(1); \
        if constexpr (FP8) { _Pragma("unroll") for (int m = 0; m < 4; ++m) _Pragma("unroll") for (int n = 0; n < 2; ++n) \
            asm volatile("v_mfma_scale_f32_16x16x128_f8f6f4 %0, %1, %2, 0, %3, %4 op_sel_hi:[0,0,0]" : "+v"(acc[ai][bj][m][n]) : "v"(Bt##8[n]), "v"(At##8[m]), "v"(sc_w), "v"(sc_x)); } \
        else { _Pragma("unroll") for (int m = 0; m < 4; ++m) _Pragma("unroll") for (int n = 0; n < 2; ++n) _Pragma("unroll") for (int k = 0; k < 2; ++k) \
            acc[ai][bj][m][n] = __builtin_amdgcn_mfma_f32_16x16x32_bf16(Bt[n][k], At[m][k], acc[ai][bj][m][n], 0, 0, 0); } \
        __builtin_amdgcn_s_setprio(0); } while (0)
#define G8_MMAF(first, ai, bj, At, Bt) do { if constexpr (FP8 && (first)) G8_MMA0(ai, bj, At, Bt); else G8_MMA(ai, bj, At, Bt); } while (0)
#define G8_WAIT_V(n) asm volatile("s_waitcnt vmcnt(" #n ")" ::: "memory")
#define G8_WAIT_L(n) asm volatile("s_waitcnt lgkmcnt(" #n ")" ::: "memory")
#define G8_WAIT_VR do { if (fresh) { if constexpr (pre_of<Epi>::value) { if (prev16) G8_WAIT_V(24); else G8_WAIT_V(16); } else if constexpr (Epi::NVM == 16) G8_WAIT_V(24); else if constexpr (Epi::NVM == 32) G8_WAIT_V(40); else if constexpr (Epi::NVM == 8) G8_WAIT_V(16); else G8_WAIT_V(8); } else G8_WAIT_V(8); } while (0)
#define G8_BAR __builtin_amdgcn_s_barrier()
#define G8_SCHED __builtin_amdgcn_sched_barrier(0)
    Unit cur, nxt; int ui = 0; bool prev16 = false; (void)prev16;
    if (!S.next(0, cur)) return;
    f32x4 acc[2][2][4][2];
    {
#pragma unroll
    for (int a = 0; a < 2; ++a)
#pragma unroll
        for (int b = 0; b < 2; ++b)
#pragma unroll
            for (int m = 0; m < 4; ++m)
#pragma unroll
                for (int n = 0; n < 2; ++n) acc[a][b][m][n] = (f32x4){0.f, 0.f, 0.f, 0.f};
    }
    bf16x8 At[4][2], B0[2][2], B1[2][2]; v8i32_t At8[4], B08[2], B18[2];
    int sc_w = 0x77777777, sc_x = 0x7B7B7B7B; if constexpr (FP8) asm volatile("" : "+v"(sc_w), "+v"(sc_x));
    const char* cA = uni_ptr(cur.a); const char* cB = uni_ptr(cur.b);
    if constexpr (GATHER) {
        if (tid < 256) *(LAS int*)(lds + LDS_GIDX + tid * 4) = gidx[cur.grow + tid];
        __syncthreads();
    }
    if constexpr (SP2) {
        G8_STAGE_B(G8_SB(0, 0), cB, 0); G8_STAGE_B(G8_SB(0, 1), cB, 1); G8_STAGE_A(G8_SA(0, 0), cA, 0, 0); G8_STAGE_A(G8_SA(0, 1), cA, 1, 0);
        if (wr == 1) G8_BAR;
        G8_WAIT_V(2); G8_BAR;
        G8_STAGE_B(G8_SB(1, 0), cB + kstep, 0); G8_STAGE_A(G8_SA(1, 0), cA + kstep, 0, 0); G8_STAGE_B(G8_SB(1, 1), cB + kstep, 1);
        G8_WAIT_V(6); G8_BAR;
    } else {
    G8_STAGE_B(G8_SB(0, 0), cB, 0); G8_STAGE_A(G8_SA(0, 0), cA, 0, 0); G8_STAGE_B(G8_SB(0, 1), cB, 1); G8_STAGE_A(G8_SA(0, 1), cA, 1, 0);
    if (wr == 1) G8_BAR;
    G8_WAIT_V(4); G8_BAR;
    G8_STAGE_B(G8_SB(1, 0), cB + kstep, 0); G8_STAGE_A(G8_SA(1, 0), cA + kstep, 0, 0); G8_STAGE_B(G8_SB(1, 1), cB + kstep, 1);
    G8_WAIT_V(6); G8_BAR;
    }
#pragma unroll 1
    for (;;) {
        const bool has_next = S.next(ui + 1, nxt);
        const char* nA = has_next ? uni_ptr(nxt.a) : cA; const char* nB = has_next ? uni_ptr(nxt.b) : cB;
        if constexpr (GATHER) {
            if (has_next && wid == 0)
                __builtin_amdgcn_global_load_lds((const unsigned*)(gidx + nxt.grow) + lane * 4, (LAS unsigned*)(lds + LDS_GIDX + ((ui + 1) & 1) * 1024), 16, 0, 0);
        }
        auto trip = [&](const int t, auto first_c) __attribute__((always_inline)) {
            constexpr bool FIRST = decltype(first_c)::value;
            const bool last = (t == nt - 2);
            const char* a1 = cA + (size_t)(t + 1) * kstep;
            const char* a2 = last ? nA : cA + (size_t)(t + 2) * kstep; const char* b2 = last ? nB : cB + (size_t)(t + 2) * kstep;
            const char* a3 = a2 + kstep; const char* b3 = b2 + kstep;
            const int sl1 = ui & 1, sl2 = (last && has_next) ? ((ui + 1) & 1) : (ui & 1);
            const bool fresh = (FIRST || (!FP8 && t == 0)) && (ui > 0);
            if constexpr (Mid::ON) { if (t == (nt >> 1)) { G8_SCHED; if constexpr (FP8) asm volatile("s_nop 15\n\ts_nop 15" ::: "memory"); Md(acc, cur, wr, wc, fr, fq); if constexpr (FP8) asm volatile("s_nop 7" ::: "memory"); G8_SCHED; } }
            if constexpr (SP2) {
            if constexpr (GATHER) { if (!fresh) G8_STAGE_A(G8_SA(1, 1), a1, 1, sl1); } G8_LDB(B0, 0, 0); G8_LDB(B1, 0, 1); G8_SCHED; G8_LDA(At, 0, 0); if constexpr (!GATHER) { if (!fresh) G8_STAGE_A(G8_SA(1, 1), a1, 1, sl1); }
            G8_WAIT_VR; G8_WAIT_L(0); G8_BAR; G8_MMAF(FIRST, 0, 0, At, B0); G8_MMAF(FIRST, 0, 1, At, B1); G8_BAR; G8_SCHED;
            G8_LDA(At, 0, 1); G8_STAGE_B(G8_SB(0, 0), b2, 0); G8_STAGE_B(G8_SB(0, 1), b2, 1); G8_STAGE_A(G8_SA(0, 0), a2, 0, sl2);
            G8_WAIT_VR; G8_WAIT_L(0); G8_BAR; G8_MMAF(FIRST, 1, 0, At, B0); G8_MMAF(FIRST, 1, 1, At, B1); G8_BAR; G8_SCHED;
            if constexpr (GATHER) { G8_STAGE_A(G8_SA(0, 1), a2, 1, sl2); } G8_LDB(B0, 1, 0); G8_LDB(B1, 1, 1); G8_SCHED; G8_LDA(At, 1, 0); if constexpr (!GATHER) { G8_STAGE_A(G8_SA(0, 1), a2, 1, sl2); }
            G8_WAIT_VR; G8_WAIT_L(0); G8_BAR; G8_MMA(0, 0, At, B0); G8_MMA(0, 1, At, B1); G8_BAR; G8_SCHED;
            G8_LDA(At, 1, 1); G8_STAGE_B(G8_SB(1, 0), b3, 0); G8_STAGE_B(G8_SB(1, 1), b3, 1); G8_STAGE_A(G8_SA(1, 0), a3, 0, sl2);
            G8_WAIT_V(8); G8_WAIT_L(0); G8_BAR; G8_MMA(1, 0, At, B0); G8_MMA(1, 1, At, B1); G8_BAR; G8_SCHED;
            if (last && has_next) G8_STAGE_A(G8_SA(1, 1), a3, 1, sl2);
            } else {
            if constexpr (GATHER) { G8_STAGE_A(G8_SA(1, 1), a1, 1, sl1); } G8_LDB(B0, 0, 0); G8_SCHED; G8_LDA(At, 0, 0); if constexpr (!GATHER) { G8_STAGE_A(G8_SA(1, 1), a1, 1, sl1); }
            G8_WAIT_L(8); G8_BAR; G8_WAIT_L(0); G8_MMA(0, 0, At, B0); G8_BAR; G8_SCHED;
            G8_LDB(B1, 0, 1); G8_STAGE_B(G8_SB(0, 0), b2, 0);
            G8_BAR; G8_WAIT_L(0); G8_MMA(0, 1, At, B1); G8_BAR;
            if constexpr (GATHER) { G8_STAGE_A(G8_SA(0, 0), a2, 0, sl2); } G8_LDA(At, 0, 1); if constexpr (!GATHER) { G8_STAGE_A(G8_SA(0, 0), a2, 0, sl2); }
            G8_BAR; G8_WAIT_L(0); G8_MMA(1, 0, At, B0); G8_BAR; G8_SCHED;
            G8_STAGE_B(G8_SB(0, 1), b2, 1);
            G8_WAIT_V(6); G8_BAR; G8_MMA(1, 1, At, B1); G8_BAR;
            if constexpr (GATHER) { G8_STAGE_A(G8_SA(0, 1), a2, 1, sl2); } G8_LDB(B0, 1, 0); G8_SCHED; G8_LDA(At, 1, 0); if constexpr (!GATHER) { G8_STAGE_A(G8_SA(0, 1), a2, 1, sl2); }
            G8_WAIT_L(8); G8_BAR; G8_WAIT_L(0); G8_MMA(0, 0, At, B0); G8_BAR; G8_SCHED;
            G8_LDB(B1, 1, 1); G8_STAGE_B(G8_SB(1, 0), b3, 0);
            G8_BAR; G8_WAIT_L(0); G8_MMA(0, 1, At, B1); G8_BAR;
            if constexpr (GATHER) { G8_STAGE_A(G8_SA(1, 0), a3, 0, sl2); } G8_LDA(At, 1, 1); if constexpr (!GATHER) { G8_STAGE_A(G8_SA(1, 0), a3, 0, sl2); }
            G8_BAR; G8_WAIT_L(0); G8_MMA(1, 0, At, B0); G8_BAR; G8_SCHED;
            G8_STAGE_B(G8_SB(1, 1), b3, 1);
            G8_WAIT_V(6); G8_BAR; G8_MMA(1, 1, At, B1); G8_BAR;
            }
                };
        if constexpr (FP8) { trip(0, BoolC<true>());
#pragma unroll 1
            for (int t = 2; t < nt; t += 2) trip(t, BoolC<false>()); }
        else {
#pragma unroll 1
            for (int t = 0; t < nt; t += 2) trip(t, BoolC<false>()); }
        if (wr == 0) G8_BAR;
        if constexpr (FP8) asm volatile("s_nop 15\n\ts_nop 15" ::: "memory");
        E(acc, cur, wr, wc, fr, fq);
        if (!has_next) break;
#pragma unroll
        for (int a = 0; a < 2; ++a)
#pragma unroll
            for (int b = 0; b < 2; ++b)
#pragma unroll
                for (int m = 0; m < 4; ++m)
#pragma unroll
                    for (int n = 0; n < 2; ++n) {
                        if constexpr (!SP2 || !FP8) acc[a][b][m][n] = (f32x4){0.f, 0.f, 0.f, 0.f};
                        else asm volatile("" : "=v"(acc[a][b][m][n]));
                    }
        if constexpr (pre_of<Epi>::value) prev16 = E.nvm16(cur);
        cur = nxt; cA = nA; cB = nB; ++ui;
        if (wr == 1) G8_BAR;
    }
    G8_WAIT_V(0);
    G8_BAR;
#undef G8_SA
#undef G8_SB
#undef G8_STAGE_A
#undef G8_STAGE_B
#undef G8_LDA
#undef G8_LDB
#undef G8_MMA
#undef G8_MMA0
#undef G8_MMAF
#undef G8_LD32
#undef G8_WAIT_V
#undef G8_WAIT_VR
#undef G8_WAIT_L
#undef G8_BAR
#undef G8_SCHED
}

template <int NM, int NN>
struct SchedDenseT {
    static constexpr int nM = NM, nN = NN, nwg = NM * NN;
    int G, c; const char* A; const char* B; size_t atile, btile;
    __device__ __forceinline__ void init(int M_, int N_, int G_, int c_, const void* A_, size_t lda_elems, const void* B_, size_t ldb_elems) {
        (void)M_; (void)N_; G = G_; c = c_; A = (const char*)A_; B = (const char*)B_; atile = 256 * lda_elems * 2; btile = 256 * ldb_elems * 2; }
    __device__ __forceinline__ bool next(int i, Unit& u) const {
        const long L = (long)i * G + c; if (L >= nwg) return false;
        int wgid = (int)L; { constexpr int q = nwg / 8, r = nwg % 8; const int xcd = wgid % 8, off = wgid / 8; wgid = (xcd < r ? xcd * (q + 1) : r * (q + 1) + (xcd - r) * q) + off; }
        constexpr int nig = 8 * nN; const int gid = wgid / nig, fm = gid * 8, gsz = (nM - fm) < 8 ? (nM - fm) : 8;
        if constexpr (NM % 8 == 0) { u.pm = fm + ((wgid % nig) % 8); u.pn = (wgid % nig) / 8; } else { u.pm = fm + ((wgid % nig) % gsz); u.pn = (wgid % nig) / gsz; }
        u.a = A + (size_t)u.pm * atile; u.b = B + (size_t)u.pn * btile; u.grow = 0; return true;
    }
};
struct SchedUp {
    const LAS int* tileE; int ntiles, G, c; const char* A; const char* B;
    __device__ __forceinline__ bool next(int i, Unit& u) const {
        const long L = (long)i * G + c; if (L >= 2L * ntiles) return false;
        const int tile = (int)(L >> 1); u.pn = (int)(L & 1); u.pm = tile; u.grow = tile * 256;
        const int e = tile < NSH_TILES ? 64 : tileE[tile - NSH_TILES];
        u.a = A; u.b = B + ((size_t)e * 512 + (size_t)u.pn * 256) * 1024; return true;
    }
};
struct SchedDown {
    const LAS int* tileE; int nt, toff, G, c; const char* A; const char* B;
    __device__ __forceinline__ bool next(int i, Unit& u) const {
        const long L = (long)i * G + c; if (L >= 4L * nt) return false;
        const int tile = (int)(L >> 2); u.pn = (int)(L & 3); u.pm = tile; u.grow = 0;
        const int e = tileE[toff + tile];
        u.a = A + (size_t)(256 * (toff + tile)) * DEXP; u.b = B + ((size_t)e * 1024 + (size_t)u.pn * 256) * DEXP; return true;
    }
};

struct EpiBiasAct {
    static constexpr bool PERM = true; static constexpr int NVM = 16;
    bf16* O; int ldc; const float* bias; unsigned long long modes; float* vpart;
    __device__ __forceinline__ void operator()(const f32x4 (&acc)[2][2][4][2], const Unit& u, int wr, int wc, int fr, int fq) const {
        asm volatile("" : "+v"(fr), "+v"(fq));
        const int row0 = u.pm * 256 + wr * 64 + fr, col0 = u.pn * 256 + wc * 32 + 8 * fq;
        f32x4 bv[2][2];
#pragma unroll
        for (int bj = 0; bj < 2; ++bj)
#pragma unroll
            for (int n = 0; n < 2; ++n) bv[bj][n] = *(const f32x4*)(bias + col0 + bj * 128 + 4 * n);
#pragma unroll
        for (int ai = 0; ai < 2; ++ai)
#pragma unroll
            for (int m = 0; m < 4; ++m) { bf16* rowp = O + (size_t)(row0 + ai * 128 + m * 16) * ldc + col0;
#pragma unroll
                for (int bj = 0; bj < 2; ++bj) { f32x4 v0 = acc[ai][bj][m][0] + bv[bj][0], v1 = acc[ai][bj][m][1] + bv[bj][1];
#pragma unroll
                    for (int j = 0; j < 4; ++j) { v0[j] = fast_sigmoid(v0[j]); v1[j] = fast_sigmoid(v1[j]); }
                    u32x4 w; w.x = cvt_pk_bf16(v0[0], v0[1]); w.y = cvt_pk_bf16(v0[2], v0[3]); w.z = cvt_pk_bf16(v1[0], v1[1]); w.w = cvt_pk_bf16(v1[2], v1[3]);
                    *(u32x4*)(rowp + bj * 128) = w; } }
    }
};
struct EpiZ {
    static constexpr bool PERM = true, PERM2 = true, PRE = true; static constexpr int NVM = 8;
    unsigned char* Z8; bf16* ZG; const float* bias; float* vpart; bool plain;
    __device__ __forceinline__ bool nvm16(const Unit& u) const { return u.pn >= 20 || (!plain && u.pn >= 8 && u.pn < 12); }
    __device__ __forceinline__ void operator()(const f32x4 (&acc)[2][2][4][2], const Unit& u, int wr, int wc, int fr, int fq) const {
        asm volatile("" : "+v"(fr), "+v"(fq));
        const int row0 = u.pm * 256 + wr * 64 + fr, cw = wc * 64 + 16 * fq;
        f32x4 bv[2][2];
#pragma unroll
        for (int bj = 0; bj < 2; ++bj)
#pragma unroll
            for (int n = 0; n < 2; ++n) bv[bj][n] = *(const f32x4*)(bias + u.pn * 256 + cw + 8 * bj + 4 * n);
        if (u.pn >= 20) {
            const int cg = 128 * (u.pn - 20) + wc * 32 + 8 * fq;
#pragma unroll
            for (int ai = 0; ai < 2; ++ai)
#pragma unroll
                for (int m = 0; m < 4; ++m) { bf16* rowp = ZG + (size_t)(row0 + ai * 128 + m * 16) * ZGP;
                    float rr[8], sb[8];
#pragma unroll
                    for (int n = 0; n < 2; ++n)
#pragma unroll
                        for (int j = 0; j < 4; ++j) { const float ea = __builtin_amdgcn_exp2f(-1.4426950408889634f * (acc[ai][0][m][n][j] + bv[0][n][j])), eb = __builtin_amdgcn_exp2f(-1.4426950408889634f * (acc[ai][1][m][n][j] + bv[1][n][j]));
                            sb[4 * n + j] = __builtin_amdgcn_rcpf(1.0f + eb); rr[4 * n + j] = (1.0f + eb) * __builtin_amdgcn_rcpf(1.0f + ea); }
                    u32x4 w; w.x = cvt_pk_bf16(rr[0], rr[1]); w.y = cvt_pk_bf16(rr[2], rr[3]); w.z = cvt_pk_bf16(rr[4], rr[5]); w.w = cvt_pk_bf16(rr[6], rr[7]);
                    *(u32x4*)(rowp + cg) = w;
                    w.x = cvt_pk_bf16(sb[0], sb[1]); w.y = cvt_pk_bf16(sb[2], sb[3]); w.z = cvt_pk_bf16(sb[4], sb[5]); w.w = cvt_pk_bf16(sb[6], sb[7]);
                    *(u32x4*)(rowp + 1024 + cg) = w; }
            return;
        }
        if (plain || (u.pn >= 4 && u.pn < 8) || (u.pn >= 12 && u.pn < 16)) body<0, false>(acc, u, row0, cw, wc, fq, bv);
        else if (u.pn < 4) body<1, false>(acc, u, row0, cw, wc, fq, bv);
        else if (u.pn < 12) body<1, true>(acc, u, row0, cw, wc, fq, bv);
        else body<2, false>(acc, u, row0, cw, wc, fq, bv);
    }
    template <int MODE, bool STAT>
    __device__ __forceinline__ void body(const f32x4 (&acc)[2][2][4][2], const Unit& u, int row0, int cw, int wc, int fq, const f32x4 (&bv)[2][2]) const {
        float* const sink = (float*)((char*)vpart - (WS_VPART - WS_DBG)) + 2 * (16 * fq + (row0 & 15));
#pragma unroll
        for (int ai = 0; ai < 2; ++ai)
#pragma unroll
            for (int m = 0; m < 4; ++m) { u32x4 o; float ps1 = 0.f, ps2 = 0.f;
#pragma unroll
                for (int bj = 0; bj < 2; ++bj) { f32x4 v0 = acc[ai][bj][m][0] + bv[bj][0], v1 = acc[ai][bj][m][1] + bv[bj][1];
                    if constexpr (MODE == 1) { const f32x8 g = gelu8((f32x8){v0[0], v0[1], v0[2], v0[3], v1[0], v1[1], v1[2], v1[3]}); v0 = (f32x4){g[0], g[1], g[2], g[3]}; v1 = (f32x4){g[4], g[5], g[6], g[7]}; }
                    else if constexpr (MODE == 2) {
#pragma unroll
                        for (int j = 0; j < 4; ++j) { v0[j] = fast_sigmoid(v0[j]); v1[j] = fast_sigmoid(v1[j]); } }
                    if constexpr (STAT) { ps1 += ((v0[0] + v0[1]) + (v0[2] + v0[3])) + ((v1[0] + v1[1]) + (v1[2] + v1[3])); ps2 += ((v0[0] * v0[0] + v0[1] * v0[1]) + (v0[2] * v0[2] + v0[3] * v0[3])) + ((v1[0] * v1[0] + v1[1] * v1[1]) + (v1[2] * v1[2] + v1[3] * v1[3])); }
                    o[2 * bj] = pk4_fp8x16(v0[0], v0[1], v0[2], v0[3]); o[2 * bj + 1] = pk4_fp8x16(v1[0], v1[1], v1[2], v1[3]); }
                *(u32x4*)(Z8 + (size_t)(row0 + ai * 128 + m * 16) * Z8W + u.pn * 256 + cw) = o;
                if constexpr (STAT) {
                    { const auto r = __builtin_amdgcn_permlane32_swap(__float_as_uint(ps1), __float_as_uint(ps1), false, false); ps1 = __uint_as_float(r[0]) + __uint_as_float(r[1]); }
                    { const auto r = __builtin_amdgcn_permlane16_swap(__float_as_uint(ps1), __float_as_uint(ps1), false, false); ps1 = __uint_as_float(r[0]) + __uint_as_float(r[1]); }
                    { const auto r = __builtin_amdgcn_permlane32_swap(__float_as_uint(ps2), __float_as_uint(ps2), false, false); ps2 = __uint_as_float(r[0]) + __uint_as_float(r[1]); }
                    { const auto r = __builtin_amdgcn_permlane16_swap(__float_as_uint(ps2), __float_as_uint(ps2), false, false); ps2 = __uint_as_float(r[0]) + __uint_as_float(r[1]); }
                    float* const dst = fq == 0 ? vpart + ((size_t)(row0 + ai * 128 + m * 16) * 16 + (u.pn - 8) * 4 + wc) * 2 : sink;
                    *(f32x2*)dst = (f32x2){ps1, ps2}; } }
    }
};
struct EpiOut8 {
    static constexpr bool PERM = true, PERM2 = true; static constexpr int NVM = 8;
    unsigned char* O; int ldc;
    __device__ __forceinline__ void operator()(const f32x4 (&acc)[2][2][4][2], const Unit& u, int wr, int wc, int fr, int fq) const {
        asm volatile("" : "+v"(fr), "+v"(fq));
        const int row0 = u.pm * 256 + wr * 64 + fr, col0 = u.pn * 256 + wc * 64 + 16 * fq;
        float sc256 = 256.f; asm volatile("" : "+s"(sc256));
#pragma unroll
        for (int ai = 0; ai < 2; ++ai)
#pragma unroll
            for (int m = 0; m < 4; ++m) { u32x4 o;
#pragma unroll
                for (int bj = 0; bj < 2; ++bj)
#pragma unroll
                    for (int n = 0; n < 2; ++n) { const f32x4 v = acc[ai][bj][m][n] * sc256;
                        int a = __builtin_amdgcn_cvt_pk_fp8_f32(v[0], v[1], 0, false); a = __builtin_amdgcn_cvt_pk_fp8_f32(v[2], v[3], a, true); o[2 * bj + n] = (unsigned)a; }
                *(u32x4*)(O + (size_t)(row0 + ai * 128 + m * 16) * ldc + col0) = o; }
    }
};
struct EpiGate {
    static constexpr bool PERM = true; static constexpr int NVM = 32;
    const bf16* gate; int ldg, gcol; const bf16* add; int lda_, acol; bf16* O; int ldo, ocol; bool o8;
    __device__ __forceinline__ void operator()(const f32x4 (&acc)[2][2][4][2], const Unit& u, int wr, int wc, int fr, int fq) const {
        asm volatile("" : "+v"(fr), "+v"(fq));
        const int row0 = u.pm * 256 + wr * 64 + fr, col0 = u.pn * 256 + wc * 32 + 8 * fq;
        u32x4 g[2][4][2];
#pragma unroll
        for (int ai = 0; ai < 2; ++ai)
#pragma unroll
            for (int m = 0; m < 4; ++m) { const size_t r = (size_t)(row0 + ai * 128 + m * 16);
#pragma unroll
                for (int bj = 0; bj < 2; ++bj) g[ai][m][bj] = *(const u32x4*)(gate + r * ldg + gcol + col0 + bj * 128); }
#pragma unroll
        for (int ai = 0; ai < 2; ++ai)
#pragma unroll
            for (int m = 0; m < 4; ++m) { const size_t r = (size_t)(row0 + ai * 128 + m * 16);
#pragma unroll
                for (int bj = 0; bj < 2; ++bj) { const int c = col0 + bj * 128; const u32x4 gg = g[ai][m][bj];
                    f32x4 v0 = acc[ai][bj][m][0], v1 = acc[ai][bj][m][1];
                    v0[0] *= bflo(gg.x); v0[1] *= bfhi(gg.x); v0[2] *= bflo(gg.y); v0[3] *= bfhi(gg.y);
                    v1[0] *= bflo(gg.z); v1[1] *= bfhi(gg.z); v1[2] *= bflo(gg.w); v1[3] *= bfhi(gg.w);
                    if (o8) *(u32x2*)((unsigned char*)(O + r * ldo + ocol) + c) = (u32x2){pk4_fp8x16(v0[0], v0[1], v0[2], v0[3]), pk4_fp8x16(v1[0], v1[1], v1[2], v1[3])};
                    else { u32x4 w; w.x = cvt_pk_bf16(v0[0], v0[1]); w.y = cvt_pk_bf16(v0[2], v0[3]); w.z = cvt_pk_bf16(v1[0], v1[1]); w.w = cvt_pk_bf16(v1[2], v1[3]);
                        *(u32x4*)(O + r * ldo + ocol + c) = w; } } }
    }
};
struct EpiResid {
    static constexpr bool PERM = true; static constexpr int NVM = 32;
    const float* xf; bf16* XR;
    __device__ __forceinline__ void operator()(const f32x4 (&acc)[2][2][4][2], const Unit& u, int wr, int wc, int fr, int fq) const {
        asm volatile("" : "+v"(fr), "+v"(fq));
        const int row0 = u.pm * 256 + wr * 64 + fr, col0 = u.pn * 256 + wc * 32 + 8 * fq;
        float alpha = ALPHA; asm volatile("" : "+s"(alpha));
        if (!xf) {
            u32x4 q[2][4][2];
#pragma unroll
            for (int ai = 0; ai < 2; ++ai)
#pragma unroll
                for (int m = 0; m < 4; ++m)
#pragma unroll
                    for (int bj = 0; bj < 2; ++bj) q[ai][m][bj] = __builtin_nontemporal_load((const u32x4*)(XR + (size_t)(row0 + ai * 128 + m * 16) * D + col0 + bj * 128));
#pragma unroll
            for (int ai = 0; ai < 2; ++ai)
#pragma unroll
                for (int m = 0; m < 4; ++m)
#pragma unroll
                    for (int bj = 0; bj < 2; ++bj) { const u32x4 qq = q[ai][m][bj];
                        const f32x4 r0 = (f32x4){bflo(qq.x), bfhi(qq.x), bflo(qq.y), bfhi(qq.y)} * alpha + acc[ai][bj][m][0], r1 = (f32x4){bflo(qq.z), bfhi(qq.z), bflo(qq.w), bfhi(qq.w)} * alpha + acc[ai][bj][m][1];
                        u32x4 w; w.x = cvt_pk_bf16(r0[0], r0[1]); w.y = cvt_pk_bf16(r0[2], r0[3]); w.z = cvt_pk_bf16(r1[0], r1[1]); w.w = cvt_pk_bf16(r1[2], r1[3]);
                        *(u32x4*)(XR + (size_t)(row0 + ai * 128 + m * 16) * D + col0 + bj * 128) = w; }
            return;
        }
#pragma unroll
        for (int ai = 0; ai < 2; ++ai)
#pragma unroll
            for (int mh = 0; mh < 2; ++mh) {
                f32x4 x[2][2][2];
#pragma unroll
                for (int m2 = 0; m2 < 2; ++m2) { const size_t off = (size_t)(row0 + ai * 128 + (2 * mh + m2) * 16) * D + col0;
#pragma unroll
                    for (int bj = 0; bj < 2; ++bj) {
                        if (xf) { x[m2][bj][0] = __builtin_nontemporal_load((const f32x4*)(xf + off + bj * 128)); x[m2][bj][1] = __builtin_nontemporal_load((const f32x4*)(xf + off + bj * 128 + 4)); }
                        else { const u32x4 q = *(const u32x4*)(XR + off + bj * 128); x[m2][bj][0] = (f32x4){bflo(q.x), bfhi(q.x), bflo(q.y), bfhi(q.y)}; x[m2][bj][1] = (f32x4){bflo(q.z), bfhi(q.z), bflo(q.w), bfhi(q.w)}; } } }
#pragma unroll
                for (int m2 = 0; m2 < 2; ++m2) { const size_t off = (size_t)(row0 + ai * 128 + (2 * mh + m2) * 16) * D + col0;
#pragma unroll
                    for (int bj = 0; bj < 2; ++bj) { const f32x4 r0 = x[m2][bj][0] * alpha + acc[ai][bj][2 * mh + m2][0], r1 = x[m2][bj][1] * alpha + acc[ai][bj][2 * mh + m2][1];
                        u32x4 w; w.x = cvt_pk_bf16(r0[0], r0[1]); w.y = cvt_pk_bf16(r0[2], r0[3]); w.z = cvt_pk_bf16(r1[0], r1[1]); w.w = cvt_pk_bf16(r1[2], r1[3]);
                        *(u32x4*)(XR + off + bj * 128) = w; } }
                asm volatile("" ::: "memory");
            }
    }
};
struct EpiMoeUp {
    static constexpr bool PERM = true; static constexpr int NVM = 16;
    bf16* HID; const float* SW; bf16* PBH;
    __device__ __forceinline__ void operator()(const f32x4 (&acc)[2][2][4][2], const Unit& u, int wr, int wc, int fr, int fq) const {
        asm volatile("" : "+v"(fr), "+v"(fq));
        const int rl0 = wr * 64 + fr, col0 = u.pn * 128 + wc * 32 + 8 * fq;
        float wv[2][4];
#pragma unroll
        for (int ai = 0; ai < 2; ++ai)
#pragma unroll
            for (int m = 0; m < 4; ++m) wv[ai][m] = SW[(size_t)u.grow + rl0 + ai * 128 + m * 16];
        if (u.pm < NSH_TILES) body<true>(acc, u, rl0, col0, wv); else body<false>(acc, u, rl0, col0, wv);
    }
    template <bool SH>
    __device__ __forceinline__ void body(const f32x4 (&acc)[2][2][4][2], const Unit& u, int rl0, int col0, const float (&wv)[2][4]) const {
#pragma unroll
        for (int ai = 0; ai < 2; ++ai)
#pragma unroll
            for (int m = 0; m < 4; ++m) { const size_t r = (size_t)u.grow + rl0 + ai * 128 + m * 16; const float w = wv[ai][m];
                float h[8];
#pragma unroll
                for (int n = 0; n < 2; ++n)
#pragma unroll
                    for (int j = 0; j < 4; ++j) { const float g = acc[ai][0][m][n][j], up = acc[ai][1][m][n][j]; h[4 * n + j] = g * fast_sigmoid(g) * up * w; }
                if constexpr (SH) *(u32x2*)((unsigned char*)PBH + r * 512 + 256 + col0) = (u32x2){pk4_fp8x16(h[0], h[1], h[2], h[3]), pk4_fp8x16(h[4], h[5], h[6], h[7])};
                else *(u32x2*)((unsigned char*)HID + (r - M) * DEXP + col0) = (u32x2){pk4_fp8x16(h[0], h[1], h[2], h[3]), pk4_fp8x16(h[4], h[5], h[6], h[7])}; }
    }
};
struct MidMulP {
    static constexpr bool ON = true;
    const bf16* Rp; int ld, cr;
    __device__ __forceinline__ void operator()(f32x4 (&acc)[2][2][4][2], const Unit& u, int wr, int wc, int fr, int fq) const {
        asm volatile("" : "+v"(fr), "+v"(fq));
        const char* base = (const char*)Rp + ((size_t)u.pm * 256 * ld + (size_t)u.pn * 256 + cr) * 2;
        const unsigned lo = (unsigned)((wr * 64 + fr) * ld + wc * 32 + 8 * fq) * 2u;
#pragma unroll
        for (int ai = 0; ai < 2; ++ai) {
            u32x4 g[4][2];
#pragma unroll
            for (int m = 0; m < 4; ++m) { const unsigned ro = lo + (unsigned)((ai * 128 + m * 16) * ld) * 2u;
#pragma unroll
                for (int bj = 0; bj < 2; ++bj) g[m][bj] = *(const u32x4*)(base + ro + (unsigned)(bj * 128) * 2u); }
#pragma unroll
            for (int m = 0; m < 4; ++m)
#pragma unroll
                for (int bj = 0; bj < 2; ++bj) { const u32x4 a = g[m][bj];
                    acc[ai][bj][m][0][0] *= bflo(a.x); acc[ai][bj][m][0][1] *= bfhi(a.x); acc[ai][bj][m][0][2] *= bflo(a.y); acc[ai][bj][m][0][3] *= bfhi(a.y);
                    acc[ai][bj][m][1][0] *= bflo(a.z); acc[ai][bj][m][1][1] *= bfhi(a.z); acc[ai][bj][m][1][2] *= bflo(a.w); acc[ai][bj][m][1][3] *= bfhi(a.w); }
            asm volatile("" ::: "memory");
        }
    }
};
struct MidMul {
    static constexpr bool ON = true;
    const bf16* G;
    __device__ __forceinline__ void operator()(f32x4 (&acc)[2][2][4][2], const Unit& u, int wr, int wc, int fr, int fq) const {
        asm volatile("" : "+v"(fr), "+v"(fq));
        const char* base = (const char*)G + ((size_t)u.pm * 256 * D + (size_t)u.pn * 256) * 2;
        const unsigned lo = (unsigned)((wr * 64 + fr) * D + wc * 32 + 4 * fq) * 2u;
#pragma unroll
        for (int ai = 0; ai < 2; ++ai)
#pragma unroll
            for (int mh = 0; mh < 2; ++mh) {
                u32x2 g[2][2][2];
#pragma unroll
                for (int m2 = 0; m2 < 2; ++m2) { const unsigned ro = lo + (unsigned)((ai * 128 + (2 * mh + m2) * 16) * D) * 2u;
#pragma unroll
                    for (int bj = 0; bj < 2; ++bj)
#pragma unroll
                        for (int n = 0; n < 2; ++n) g[m2][bj][n] = *(const u32x2*)(base + ro + (unsigned)(bj * 128 + n * 16) * 2u); }
#pragma unroll
                for (int m2 = 0; m2 < 2; ++m2)
#pragma unroll
                    for (int bj = 0; bj < 2; ++bj)
#pragma unroll
                        for (int n = 0; n < 2; ++n) { const u32x2 a = g[m2][bj][n]; const int m = 2 * mh + m2; acc[ai][bj][m][n][0] *= bflo(a.x); acc[ai][bj][m][n][1] *= bfhi(a.x); acc[ai][bj][m][n][2] *= bflo(a.y); acc[ai][bj][m][n][3] *= bfhi(a.y); }
                asm volatile("" ::: "memory");
            }
    }
};
}

struct KArgs { const float* in[27]; float* out; unsigned char* ws; int ph_lo, ph_hi, dbg, pad; };
enum { I_X = 0, I_P, I_WIN, I_BIN, I_SGG, I_SGB, I_WS, I_BS, I_MHG, I_WPA, I_WPB, I_WOUT, I_LN1G, I_LN1B, I_WR, I_BR, I_WGE, I_WUE, I_WDE, I_WGS, I_WUS, I_WDS, I_WPG, I_BPG, I_WP, I_LN2G, I_LN2B };
constexpr int NPH = 12;

struct Ctx {
    LAS unsigned char* lds; int vcu, G;
    float* out; unsigned char* ws;
};
#define WSP(T, off) ((T*)(C.ws + (off)))
#define INP(k) ((const float*)g8::uni_ptr((const char*)(*(const LAS unsigned long long*)(C.lds + LDS_PTRS + 8 * (k)))))
template <class T> __device__ __forceinline__ T* opq_ptr(T* p) { const unsigned long long v = (unsigned long long)p; unsigned lo = __builtin_amdgcn_readfirstlane((unsigned)v), hi = __builtin_amdgcn_readfirstlane((unsigned)(v >> 32));
    asm volatile("" : "+s"(lo), "+s"(hi)); return (T*)(GAS T*)(((unsigned long long)hi << 32) | lo); }
__device__ __forceinline__ int opq_int(int v) { int r = __builtin_amdgcn_readfirstlane(v); asm volatile("" : "+s"(r)); return r; }
#define CTX_LOCAL(Csrc) Ctx C = (Csrc); C.ws = opq_ptr(C.ws); C.out = opq_ptr(C.out); C.vcu = opq_int(C.vcu); C.G = opq_int(C.G)
#define PHASE_IDS() const int tid = fresh_tid(), lane = tid & 63, w = __builtin_amdgcn_readfirstlane(tid >> 6); (void)lane; (void)w

__device__ __forceinline__ void tr_item(const float* src, int ld, bf16* dst, int K, float scale, LAS float* scr, int lane, bool quant = false) {
    float tv[32];
    const char* sb = g8::uni_ptr((const char*)src); const unsigned o0 = (unsigned)((lane >> 5) * ld + (lane & 31)) * 4u;
#pragma unroll
    for (int i = 0; i < 32; ++i) tv[i] = *(const float*)(sb + o0 + (unsigned)(2 * i * ld) * 4u);
#pragma unroll
    for (int i = 0; i < 32; ++i) scr[(2 * i + (lane >> 5)) * 33 + (lane & 31)] = quant ? q8(tv[i] * scale, kf(256.f), kf(1.f / 256.f)) : tv[i] * scale;
    LDS_WAIT(); asm volatile("" ::: "memory");
    const int c = lane & 7;
#pragma unroll
    for (int j = 0; j < 4; ++j) { const int n = (lane >> 3) + 8 * j; const LAS float* s = scr + (8 * c) * 33 + n;
        u32x4 o; o.x = cvt_pk_bf16(s[0 * 33], s[1 * 33]); o.y = cvt_pk_bf16(s[2 * 33], s[3 * 33]);
        o.z = cvt_pk_bf16(s[4 * 33], s[5 * 33]); o.w = cvt_pk_bf16(s[6 * 33], s[7 * 33]);
        *(u32x4*)(dst + (size_t)n * K + 8 * c) = o; }
    LDS_WAIT(); asm volatile("" ::: "memory");
}
__device__ __forceinline__ void tr_item8(const float* src, int ld, unsigned char* dst, int K, float scale, LAS float* scr, int lane, int lanecol = -1) {
    const char* sb = g8::uni_ptr((const char*)src); const unsigned o0 = (unsigned)((lane >> 5) * ld + (lanecol >= 0 ? lanecol : (lane & 31))) * 4u;
#pragma unroll
    for (int hk = 0; hk < 2; ++hk) { float tv[32];
#pragma unroll
        for (int i = 0; i < 32; ++i) tv[i] = __builtin_nontemporal_load((const float*)(sb + o0 + (unsigned)((64 * hk + 2 * i) * ld) * 4u));
#pragma unroll
        for (int i = 0; i < 32; ++i) scr[(64 * hk + 2 * i + (lane >> 5)) * 33 + (lane & 31)] = tv[i] * (scale * kf(256.0f)); }
    LDS_WAIT(); asm volatile("" ::: "memory");
    const int c = lane & 7;
#pragma unroll
    for (int j = 0; j < 4; ++j) { const int n = (lane >> 3) + 8 * j; const LAS float* s = scr + (16 * c) * 33 + n;
        u32x4 o;
#pragma unroll
        for (int q = 0; q < 4; ++q) { int w = __builtin_amdgcn_cvt_pk_fp8_f32(s[(4 * q) * 33], s[(4 * q + 1) * 33], 0, false); w = __builtin_amdgcn_cvt_pk_fp8_f32(s[(4 * q + 2) * 33], s[(4 * q + 3) * 33], w, true); o[q] = (unsigned)w; }
        *(u32x4*)(dst + (size_t)n * K + 16 * c) = o; }
    LDS_WAIT(); asm volatile("" ::: "memory");
}
__device__ __forceinline__ int win_src_col(int dcol) {
    return dcol < 1024 ? dcol : dcol < 2048 ? 3072 + (dcol - 1024) : dcol < 3072 ? 1024 + (dcol - 2048) : dcol < 3584 ? 2048 + (dcol - 3072) : dcol < 4096 ? 2560 + (dcol - 3584)
         : dcol < 5120 ? 4096 + (dcol - 4096) : (((dcol - 5120) >> 3) & 1) ? 6152 + 128 * ((dcol - 5120) >> 8) + 32 * (((dcol - 5120) & 255) >> 6) + 8 * ((((dcol - 5120) & 255) >> 4) & 3) + ((dcol - 5120) & 7)
                                                                        : 5128 + 128 * ((dcol - 5120) >> 8) + 32 * (((dcol - 5120) & 255) >> 6) + 8 * ((((dcol - 5120) & 255) >> 4) & 3) + ((dcol - 5120) & 7);
}
__device__ __forceinline__ void emit_xb_gates(const f32x4 (&v)[4], int m, bf16* XB, float* IFp, const LAS float* wif, const float* bif, int lane) {
    float g[8];
#pragma unroll
    for (int q = 0; q < 8; ++q) g[q] = 0.f;
#pragma unroll
    for (int j = 0; j < 4; ++j) {
        { int w8 = __builtin_amdgcn_cvt_pk_fp8_f32(v[j][0] * 16.f, v[j][1] * 16.f, 0, false); w8 = __builtin_amdgcn_cvt_pk_fp8_f32(v[j][2] * 16.f, v[j][3] * 16.f, w8, true);
          *(int*)((unsigned char*)XB + (size_t)m * D + 256 * j + 4 * lane) = w8; }
#pragma unroll
        for (int e = 0; e < 4; ++e) { const int k = 256 * j + 4 * lane + e; const f32x4 w0 = *(const LAS f32x4*)(wif + k * 8), w1 = *(const LAS f32x4*)(wif + k * 8 + 4); const float x = v[j][e];
            g[0] += x * w0[0]; g[1] += x * w0[1]; g[2] += x * w0[2]; g[3] += x * w0[3]; g[4] += x * w1[0]; g[5] += x * w1[1]; g[6] += x * w1[2]; g[7] += x * w1[3]; }
    }
#pragma unroll
    for (int q = 0; q < 8; ++q) g[q] = wave_sum(g[q]);
    if (lane == 0) { *(f32x4*)(IFp + (size_t)m * 8) = (f32x4){g[0] + bif[0], g[1] + bif[1], g[2] + bif[2], g[3] + bif[3]}; *(f32x4*)(IFp + (size_t)m * 8 + 4) = (f32x4){g[4] + bif[4], g[5] + bif[5], g[6] + bif[6], g[7] + bif[7]}; }
}
__device__ __forceinline__ void load_wif(const Ctx& C0, int l, LAS float* wif) {
    CTX_LOCAL(C0);
    const float* win = INP(I_WIN) + (size_t)l * D * DIN;
    for (int i = fresh_tid(); i < 1024 * 8; i += 512) wif[i] = win[(size_t)(i >> 3) * DIN + 5120 + (i & 7)];
    __syncthreads();
}
__device__ __forceinline__ void phase_convert(const Ctx& C0, int l, bool with_x0) {
    CTX_LOCAL(C0);
    PHASE_IDS();
    const int gw = C.vcu * 8 + w, NGW = C.G * 8;
    LAS float* scr = (LAS float*)(C.lds + w * 16896);
    const float* win = INP(I_WIN) + (size_t)l * D * DIN;
    bf16* WinT = WSP(bf16, WS_WIN); bf16* W4 = WSP(bf16, WS_W4); bf16* UpT = WSP(bf16, WS_UPT); bf16* DnT = WSP(bf16, WS_DNT); bf16* WpT = WSP(bf16, WS_WPT);
    constexpr int N0 = 1792, N1 = 768 + 256, N2 = 65 * 128, N3 = 64 * 64 + 64, N4 = 64, NIT = N0 + N1 + N2 + N3 + N4;
    LAS float* scr8 = scr;
    for (int it = gw; it < NIT; it += NGW) {
        int r = it;
        if (r < N0) { const int kb = r / 224, nb = r % 224, dcol = 32 * nb; const int sc = win_src_col(dcol); const float sq = (dcol >= ZQ && dcol < ZK) ? kf(QSCALE) : 1.0f;
            tr_item8(win + (size_t)(128 * kb) * DIN, DIN, (unsigned char*)WinT + (size_t)dcol * D + 128 * kb, D, sq, scr8, lane, win_src_col(dcol + (lane & 31))); (void)sc; continue; }
        r -= N0;
        if (r < N1) {
            if (r < 512) { const int which = r >> 8, rr = r & 255, kb = rr >> 5, nb = rr & 31;
                tr_item8((which == 0 ? INP(I_WPA) : INP(I_WPB)) + (size_t)l * D * D + (size_t)(128 * kb) * D + 32 * nb, D, (unsigned char*)W4 + (size_t)(32 * nb) * 2048 + which * 1024 + 128 * kb, 2048, 1.0f, scr, lane); }
            else if (r < 768) { const int rr = r - 512, kb = rr >> 5, nb = rr & 31;
                tr_item8(INP(I_WOUT) + (size_t)l * D * D + (size_t)(128 * kb) * D + 32 * nb, D, (unsigned char*)(W4 + (size_t)2 * D * D) + (size_t)(32 * nb) * D + 128 * kb, D, 1.0f, scr, lane); }
            else { const int rr = r - 768, kb = rr >> 5, nb = rr & 31;
                tr_item8(INP(I_WPG) + (size_t)l * D * D + (size_t)(128 * kb) * D + 32 * nb, D, (unsigned char*)(W4 + (size_t)3 * D * D) + (size_t)(32 * nb) * D + 128 * kb, D, 1.0f, scr, lane); }
            continue; }
        r -= N1;
        if (r < N2) { const int e = r >> 7, rr = r & 127, isup = rr >> 6, r2 = rr & 63, kb = r2 >> 3, cb = r2 & 7;
            const float* src = e < 64 ? ((isup ? INP(I_WUE) : INP(I_WGE)) + ((size_t)l * 64 + e) * D * DEXP) : ((isup ? INP(I_WUS) : INP(I_WGS)) + (size_t)l * D * DEXP);
            const int drow = (cb >> 2) * 256 + isup * 128 + (cb & 3) * 32;
            tr_item8(src + (size_t)(128 * kb) * DEXP + 32 * cb, DEXP, (unsigned char*)UpT + ((size_t)e * 512 + drow) * D + 128 * kb, D, 1.0f, scr, lane); continue; }
        r -= N2;
        if (r < N3) {
            if (r < 64 * 64) { const int e = r >> 6, rr = r & 63, kb = rr >> 5, nb = rr & 31;
                tr_item8(INP(I_WDE) + ((size_t)l * 64 + e) * DEXP * D + (size_t)(128 * kb) * D + 32 * nb, D, (unsigned char*)DnT + (size_t)e * D * DEXP + (size_t)(32 * nb) * DEXP + 128 * kb, DEXP, 1.0f, scr, lane); }
            else { const int rr = r - 64 * 64, kb = rr >> 5, nb = rr & 31;
                tr_item8(INP(I_WDS) + (size_t)l * DEXP * D + (size_t)(128 * kb) * D + 32 * nb, D, (unsigned char*)WpT + (size_t)(32 * nb) * 512 + 256 + 128 * kb, 512, 1.0f, scr, lane); }
            continue; }
        r -= N3;
        { const int kb = r >> 5, nb = r & 31; const float* src = INP(I_WP) + (size_t)l * PD * D;
            tr_item8(src + (size_t)(128 * kb) * D + 32 * nb, D, (unsigned char*)WpT + (size_t)(32 * nb) * 512 + 128 * kb, 512, 1.0f, scr, lane); }
    }
    const int gt = C.vcu * 512 + tid, NGT = C.G * 512;
    {
        float* b1 = WSP(float, WS_BIAS1); const float* bin = INP(I_BIN) + (size_t)l * DIN;
        for (int j = gt; j < ZW; j += NGT) b1[j] = bin[win_src_col(j)] * ((j >= ZQ && j < ZK) ? kf(QSCALE) : 1.0f);
        bf16* wsb = WSP(bf16, WS_WSB); const float* wsf = INP(I_WS) + (size_t)l * 8 * 128 * 128;
        for (int j = gt; j < 8 * 128 * 128; j += NGT) { const int t = (j >> 7) & 127, s = j & 127; wsb[j] = ((s >> 6) <= (t >> 6)) ? f2bf(wsf[j]) : (bf16)0; }
    }
    if (with_x0) {
        __syncthreads();
        LAS float* wif = (LAS float*)C.lds;
        load_wif(C, 0, wif);
        const float* bif = INP(I_BIN) + 5120;
        for (int m = gw; m < M; m += NGW) { f32x4 v[4];
#pragma unroll
            for (int j = 0; j < 4; ++j) v[j] = __builtin_nontemporal_load((const f32x4*)(INP(I_X) + (size_t)m * D + 256 * j + 4 * lane));
            emit_xb_gates(v, m, WSP(bf16, WS_XB), WSP(float, WS_IF), wif, bif, lane); }
    }
}

__device__ __forceinline__ void convert_pb(const Ctx& C0, int l) {
    CTX_LOCAL(C0);
    const int gt = C.vcu * 512 + fresh_tid(), NGT = C.G * 512;
    const f32x4* p4 = (const f32x4*)(INP(I_P) + (size_t)l * M * PD); unsigned char* o = WSP(unsigned char, WS_PBH);
    for (int j = gt; j < M * PD / 16; j += NGT) { const f32x4 a = __builtin_nontemporal_load(p4 + 4 * j), b = __builtin_nontemporal_load(p4 + 4 * j + 1), c = __builtin_nontemporal_load(p4 + 4 * j + 2), d = __builtin_nontemporal_load(p4 + 4 * j + 3);
        *(u32x4*)(o + (size_t)(j >> 4) * 512 + (j & 15) * 16) = (u32x4){pk4_fp8x16(a[0], a[1], a[2], a[3]), pk4_fp8x16(b[0], b[1], b[2], b[3]), pk4_fp8x16(c[0], c[1], c[2], c[3]), pk4_fp8x16(d[0], d[1], d[2], d[3])}; }
}
__device__ __forceinline__ void phase_gates(const Ctx& C0) {
    CTX_LOCAL(C0);
    PHASE_IDS();
    const int gw = C.vcu * 8 + w, NGW = C.G * 8;
    const float* IFp = WSP(float, WS_IF); float* BC = WSP(float, WS_BC); float* BL = WSP(float, WS_BL); float* GM = WSP(float, WS_GM);
    for (int task = gw; task < 32 * NCH; task += NGW) {
        const int bh = task >> 7, c = task & 127, b = bh >> 2, h = bh & 3; const size_t m = (size_t)b * SEQ + 64 * c + lane;
        const float ip = IFp[m * 8 + h], fp = IFp[m * 8 + 4 + h];
        const float lf = fminf(fp, 0.f) - __builtin_amdgcn_logf(1.0f + __builtin_amdgcn_exp2f(-fabsf(fp) * kf(1.4426950408889634f))) * kf(0.6931471805599453f);
        float v = lf;
#pragma unroll
        for (int o = 1; o < 64; o <<= 1) { const float t = shfl_idx(v, lane - o); if (lane >= o) v += t; }
        const float blast = rdlane(v, 63);
        const float gmax = wave_max(blast - v + ip);
        BC[m * 4 + h] = v;
        if (lane == 0) { BL[task] = blast; GM[task] = gmax; }
    }
}
__device__ __forceinline__ void mstate(const float* BL, const float* GM, int bh, int c, int lane, float& mc, float& mn) {
    const float bl0 = BL[bh * 128 + lane], bl1 = BL[bh * 128 + 64 + lane], gm0 = GM[bh * 128 + lane], gm1 = GM[bh * 128 + 64 + lane];
    float m = 0.f, prev = 0.f;
    for (int cc = 0; cc <= c; ++cc) {
        const float bl = __shfl(cc < 64 ? bl0 : bl1, cc & 63), gm = __shfl(cc < 64 ? gm0 : gm1, cc & 63);
        prev = m; m = fmaxf(bl + m, gm);
    }
    mc = prev; mn = m;
}

__device__ __forceinline__ void phase_sgu(const Ctx& C0, int l) {
    CTX_LOCAL(C0);
    PHASE_IDS();
    const unsigned char* Z8 = WSP(unsigned char, WS_Z); const float* VP = WSP(float, WS_VPART); unsigned char* AB8 = (unsigned char*)C.out;
    constexpr int PW = 272;
    LAS unsigned char* Wt = C.lds; LAS unsigned char* Vn = C.lds + 128 * PW; LAS float* Dt = (LAS float*)(C.lds + 2 * 128 * PW);
    LAS f32x2* Sst = (LAS f32x2*)(C.lds + 2 * 128 * PW + 128 * 132 * 4);
#define SGU_STATS(mrow, slot) do { if (tid < 128) { const f32x4* p_ = (const f32x4*)(VP + ((mrow) + tid) * 32); float s1_ = 0.f, s2_ = 0.f; \
        _Pragma("unroll") for (int k_ = 0; k_ < 8; ++k_) { const f32x4 q_ = p_[k_]; s1_ += q_[0] + q_[2]; s2_ += q_[1] + q_[3]; } \
        const float mean_ = s1_ * (1.0f / 1024.0f), var_ = fmaxf(s2_ * (1.0f / 1024.0f) - mean_ * mean_, 0.f); Sst[(slot) * 128 + tid] = (f32x2){mean_, __builtin_amdgcn_rsqf(var_ + kf(LN_EPS))}; } } while (0)
    const int ch = tid & 7, r0 = tid >> 3;
    const int chw = tid & 15, rw = tid >> 4;
    int gcur = -1; f32x4 gg[4], bb[4]; float bt[2];
    u32x4 pv[2]; int it = 0;
    int u = C.vcu;
    if (u < 4096) { const size_t m0 = (size_t)(u >> 3) * 128; const int g = u & 7;
#pragma unroll
        for (int i = 0; i < 2; ++i) pv[i] = *(const u32x4*)(Z8 + (m0 + r0 + 64 * i) * Z8W + ZV + 128 * g + 16 * ch);
        SGU_STATS(m0, 0); }
    __syncthreads();
    for (; u < 4096; u += C.G, ++it) {
        const int g = u & 7; const size_t m0 = (size_t)(u >> 3) * 128;
        if (g != gcur) {
            if (gcur >= 0) __syncthreads();
            gcur = g;
            const bf16* wsb = WSP(bf16, WS_WSB) + (size_t)g * 128 * 128;
#pragma unroll
            for (int i = 0; i < 4; ++i) *(LAS u32x4*)(Wt + (rw + 32 * i) * PW + chw * 16) = *(const u32x4*)(wsb + (rw + 32 * i) * 128 + chw * 8);
            const float* lng = INP(I_SGG) + (size_t)l * 1024 + 128 * g; const float* lnb = INP(I_SGB) + (size_t)l * 1024 + 128 * g; const float* bs = INP(I_BS) + (size_t)l * 1024 + 128 * g;
#pragma unroll
            for (int q = 0; q < 4; ++q) { gg[q] = *(const f32x4*)(lng + 16 * ch + 4 * q); bb[q] = *(const f32x4*)(lnb + 16 * ch + 4 * q); }
#pragma unroll
            for (int i = 0; i < 2; ++i) bt[i] = bs[r0 + 64 * i];
        }
#pragma unroll
        for (int i = 0; i < 2; ++i) { const f32x2 st = Sst[(it & 1) * 128 + r0 + 64 * i]; float x[16]; un16_fp8x16(pv[i], x);
#pragma unroll
            for (int q = 0; q < 4; ++q)
#pragma unroll
                for (int j = 0; j < 4; ++j) x[4 * q + j] = (x[4 * q + j] - st.x) * st.y * gg[q][j] + bb[q][j];
            bf16x16_to_lds(Vn + (r0 + 64 * i) * PW + ch * 32, x); }
        __syncthreads();
        const int un = u + C.G;
        if (un < 4096) { const size_t mn = (size_t)(un >> 3) * 128; const int gn = un & 7;
#pragma unroll
            for (int i = 0; i < 2; ++i) pv[i] = *(const u32x4*)(Z8 + (mn + r0 + 64 * i) * Z8W + ZV + 128 * gn + 16 * ch);
            SGU_STATS(mn, (it + 1) & 1); }
        u32x4 pu[2];
#pragma unroll
        for (int i = 0; i < 2; ++i) pu[i] = *(const u32x4*)(Z8 + (m0 + r0 + 64 * i) * Z8W + ZU + 128 * g + 16 * ch);
        f32x4 acc[8];
#pragma unroll
        for (int j = 0; j < 8; ++j) acc[j] = (f32x4){0.f, 0.f, 0.f, 0.f};
#pragma unroll
        for (int ks = 0; ks < 4; ++ks) { const bf16x8 a = frag_row(Wt, PW, 16 * w, 32 * ks, lane);
#pragma unroll
            for (int j = 0; j < 8; ++j) acc[j] = MFMA16(a, frag_tr(Vn, PW, 32 * ks, 16 * j, lane), acc[j]); }
#pragma unroll
        for (int j = 0; j < 8; ++j)
#pragma unroll
            for (int r = 0; r < 4; ++r) Dt[(16 * w + 4 * (lane >> 4) + r) * 132 + 16 * j + (lane & 15)] = acc[j][r];
        __syncthreads();
#pragma unroll
        for (int i = 0; i < 2; ++i) { const int t = r0 + 64 * i; const float bq = bt[i]; float uu[16]; un16_fp8x16(pu[i], uu); u32x4 o;
#pragma unroll
            for (int q = 0; q < 4; ++q) { const f32x4 d = *(const LAS f32x4*)(Dt + t * 132 + 16 * ch + 4 * q);
                o[q] = pk4_fp8x16(uu[4 * q] * (d[0] + bq), uu[4 * q + 1] * (d[1] + bq), uu[4 * q + 2] * (d[2] + bq), uu[4 * q + 3] * (d[3] + bq)); }
            *(u32x4*)(AB8 + (m0 + t) * 2048 + 128 * g + 16 * ch) = o; }
    }
    __syncthreads();
#undef SGU_STATS
}

__device__ __forceinline__ void phase_kv(const Ctx& C0) {
    CTX_LOCAL(C0);
    PHASE_IDS();
    const unsigned char* Z8 = WSP(unsigned char, WS_Z); const float* IFp = WSP(float, WS_IF); const float* BC = WSP(float, WS_BC); const float* BL = WSP(float, WS_BL); const float* GM = WSP(float, WS_GM);
    constexpr int PV = 528, PK = 272, PO = 144;
    LAS unsigned char* Vs = C.lds; LAS unsigned char* Ks = C.lds + 64 * PV; LAS unsigned char* Ot = C.lds + 64 * PV + 64 * PK;
    const int sv = tid >> 4, chv = tid & 15, sk = tid >> 3, chk = tid & 7;
    u32x4 pv[2], pk; float pbc, pif;
    int u = C.vcu;
    if (u < 4096) { const int bh = u >> 7, c = u & 127, b = bh >> 2, h = bh & 3; const size_t m0 = (size_t)b * SEQ + 64 * c;
#pragma unroll
        for (int i = 0; i < 2; ++i) pv[i] = *(const u32x4*)(Z8 + (m0 + sv + 32 * i) * Z8W + ZVM + 256 * h + 16 * chv);
        pk = *(const u32x4*)(Z8 + (m0 + sk) * Z8W + ZK + 128 * h + 16 * chk); pbc = BC[(m0 + sk) * 4 + h]; pif = IFp[(m0 + sk) * 8 + h]; }
    for (; u < 4096; u += C.G) {
        const int bh = u >> 7, c = u & 127;
        unsigned char* ST = WSP(unsigned char, WS_STATE) + (size_t)u * 32768; float* NK = WSP(float, WS_NK) + (size_t)u * 128;
        float mc, mn; mstate(BL, GM, bh, c, lane, mc, mn);
        const float blast = BL[u];
#pragma unroll
        for (int i = 0; i < 2; ++i) { float x[16]; un16_fp8x16(pv[i], x); bf16x16_to_lds(Vs + (sv + 32 * i) * PV + chv * 32, x); }
        { const float wgt = expf(blast - pbc + pif - mn); float x[16]; un16_fp8x16(pk, x);
#pragma unroll
          for (int j = 0; j < 16; ++j) x[j] *= wgt;
          bf16x16_to_lds(Ks + sk * PK + chk * 32, x); }
        __syncthreads();
        const int un = u + C.G;
        if (un < 4096) { const int bhn = un >> 7, cn = un & 127, bn = bhn >> 2, hn = bhn & 3; const size_t mn0 = (size_t)bn * SEQ + 64 * cn;
#pragma unroll
            for (int i = 0; i < 2; ++i) pv[i] = *(const u32x4*)(Z8 + (mn0 + sv + 32 * i) * Z8W + ZVM + 256 * hn + 16 * chv);
            pk = *(const u32x4*)(Z8 + (mn0 + sk) * Z8W + ZK + 128 * hn + 16 * chk); pbc = BC[(mn0 + sk) * 4 + hn]; pif = IFp[(mn0 + sk) * 8 + hn]; }
        if (tid < 128) { float sm = 0.f;
#pragma unroll
            for (int r = 0; r < 64; ++r) sm += bf2f(*(const LAS bf16*)(Ks + r * PK + tid * 2));
            NK[tid] = sm; }
        f32x4 acc[2][8];
#pragma unroll
        for (int i = 0; i < 2; ++i)
#pragma unroll
            for (int j = 0; j < 8; ++j) acc[i][j] = (f32x4){0.f, 0.f, 0.f, 0.f};
#pragma unroll
        for (int ks = 0; ks < 2; ++ks) {
            bf16x8 bfr[8];
#pragma unroll
            for (int j = 0; j < 8; ++j) bfr[j] = frag_tr(Ks, PK, 32 * ks, 16 * j, lane);
#pragma unroll
            for (int i = 0; i < 2; ++i) { const bf16x8 a = frag_tr(Vs, PV, 32 * ks, 32 * w + 16 * i, lane);
#pragma unroll
                for (int j = 0; j < 8; ++j) acc[i][j] = MFMA16(a, bfr[j], acc[i][j]); }
        }
#pragma unroll
        for (int i = 0; i < 2; ++i)
#pragma unroll
            for (int j = 0; j < 8; ++j) { const unsigned pw = pk4_fp8x4(acc[i][j][0], acc[i][j][1], acc[i][j][2], acc[i][j][3]);
#pragma unroll
                for (int r = 0; r < 4; ++r) *(LAS unsigned char*)(Ot + (32 * w + 16 * i + 4 * (lane >> 4) + r) * PO + 16 * j + (lane & 15)) = (unsigned char)(pw >> (8 * r)); }
        __syncthreads();
#pragma unroll
        for (int i = 0; i < 4; ++i) { const int idx = tid + 512 * i, v = idx >> 3, chq = idx & 7;
            *(u32x4*)(ST + v * 128 + 16 * chq) = *(const LAS u32x4*)(Ot + v * PO + chq * 16); }
    }
    __syncthreads();
}

__device__ __forceinline__ void phase_kvchain(const Ctx& C0) {
    CTX_LOCAL(C0);
    PHASE_IDS();
    const unsigned char* Z8 = WSP(unsigned char, WS_Z); const float* IFp = WSP(float, WS_IF); const float* BC = WSP(float, WS_BC);
    constexpr int PK = 272, PVS = 80, BUF = 64 * PK + 64 * PVS;
    const int sk = tid >> 3, chk = tid & 7;
    const int svr = (tid >> 1) & 63, svh = tid & 1;
    const int vi = w & 1, dj = 2 * (w >> 1);
    unsigned one2 = 0x41804180u; asm volatile("" : "+v"(one2));
    const bf16x8 ones = __builtin_bit_cast(bf16x8, (u32x4){one2, one2, one2, one2});
    __syncthreads();
    for (int item = C.vcu; item < 256; item += C.G) {
        const int bh = item >> 3, vs = item & 7, b = bh >> 2, h = bh & 3;
        const float* BL = WSP(float, WS_BL) + bh * 128; const float* GM = WSP(float, WS_GM) + bh * 128; float* MS = WSP(float, WS_MS) + bh * 129;
        unsigned char* ST = WSP(unsigned char, WS_STATE) + (size_t)bh * 128 * 32768 + (size_t)(32 * vs + 16 * vi + (lane & 15)) * 128 + 16 * dj + 4 * (lane >> 4);
        float* NK = WSP(float, WS_NK) + (size_t)bh * 128 * 128 + 16 * dj + 4 * (lane >> 4);
        const unsigned char* zk = Z8 + ((size_t)b * SEQ + sk) * Z8W + ZK + 128 * h + 16 * chk;
        const unsigned char* zv = Z8 + ((size_t)b * SEQ + svr) * Z8W + ZVM + 256 * h + 32 * vs + 16 * svh;
        const float* bcp = BC + ((size_t)b * SEQ + sk) * 4 + h; const float* ifp = IFp + ((size_t)b * SEQ + sk) * 8 + h;
        const float bl0 = BL[lane], bl1 = BL[64 + lane], gm0 = GM[lane], gm1 = GM[64 + lane];
        u32x4 rk[2], rv[2]; float rbc[2], rif[2]; rv[0] = rv[1] = (u32x4){0u, 0u, 0u, 0u};
        float mrun = 0.f, dcur = 0.f, dnxt = 0.f;
        f32x4 Cst[2] = {(f32x4){0.f, 0.f, 0.f, 0.f}, (f32x4){0.f, 0.f, 0.f, 0.f}}, Nst[2] = {(f32x4){0.f, 0.f, 0.f, 0.f}, (f32x4){0.f, 0.f, 0.f, 0.f}};
#define KVC_LOAD(R, c_) do { const size_t o_ = (size_t)(c_) * 64; rk[R] = *(const u32x4*)(zk + o_ * Z8W); if (tid < 128) rv[R] = *(const u32x4*)(zv + o_ * Z8W); rbc[R] = bcp[o_ * 4]; rif[R] = ifp[o_ * 8]; } while (0)
#define KVC_PREP(R, c_, decv) do { const int ci_ = (c_); const float bl_ = rdlane(ci_ < 64 ? bl0 : bl1, ci_ & 63), gm_ = rdlane(ci_ < 64 ? gm0 : gm1, ci_ & 63); \
            const float mn_ = fmaxf(bl_ + mrun, gm_); decv = fast_exp(bl_ + mrun - mn_); if (vs == 0 && tid == 0) MS[ci_] = mrun; mrun = mn_; \
            LAS unsigned char* kb_ = C.lds + (ci_ & 1) * BUF; \
            { const float wgt_ = fast_exp(bl_ - rbc[R] + rif[R] - mn_) * (1.0f / 256.0f); float x_[16]; un16_fp8raw(rk[R], x_); _Pragma("unroll") for (int j_ = 0; j_ < 16; ++j_) x_[j_] *= wgt_; bf16x16_to_lds(kb_ + sk * PK + chk * 32, x_); } \
            if (tid < 128) { float x_[16]; un16_fp8raw(rv[R], x_); bf16x16_to_lds(kb_ + 64 * PK + svr * PVS + svh * 32, x_); } } while (0)
#define KVC_STEP(cc_, R) do { const int cc = (cc_); \
            if (cc + 1 < 128) { KVC_PREP(R, cc + 1, dnxt); if (cc + 3 < 128) KVC_LOAD(R, cc + 3); } \
            const LAS unsigned char* kb = C.lds + (cc & 1) * BUF; const LAS unsigned char* vb = kb + 64 * PK; \
            f32x4 kv_[2] = {(f32x4){0.f, 0.f, 0.f, 0.f}, (f32x4){0.f, 0.f, 0.f, 0.f}}, nn_[2] = {(f32x4){0.f, 0.f, 0.f, 0.f}, (f32x4){0.f, 0.f, 0.f, 0.f}}; \
            _Pragma("unroll") for (int ks = 0; ks < 2; ++ks) { const bf16x8 bv = frag_tr(vb, PVS, 32 * ks, 16 * vi, lane); \
                _Pragma("unroll") for (int j = 0; j < 2; ++j) { const bf16x8 ak = frag_tr(kb, PK, 32 * ks, 16 * (dj + j), lane); kv_[j] = MFMA16(ak, bv, kv_[j]); if (vi == 0) nn_[j] = MFMA16(ak, ones, nn_[j]); } } \
            _Pragma("unroll") for (int j = 0; j < 2; ++j) { Cst[j] = Cst[j] * dcur + kv_[j]; *(unsigned*)(ST + (size_t)cc * 32768 + 16 * j) = pk4_fp8x4(Cst[j][0], Cst[j][1], Cst[j][2], Cst[j][3]); } \
            if (vi == 0) { _Pragma("unroll") for (int j = 0; j < 2; ++j) { Nst[j] = Nst[j] * dcur + nn_[j]; if (vs == 0 && (lane & 15) == 0) *(f32x4*)(NK + cc * 128 + 16 * j) = Nst[j]; } } \
            __syncthreads(); dcur = dnxt; } while (0)
        KVC_LOAD(0, 0);
        KVC_PREP(0, 0, dcur);
        KVC_LOAD(1, 1); KVC_LOAD(0, 2);
        __syncthreads();
#pragma unroll 1
        for (int c = 0; c < 128; c += 2) { KVC_STEP(c, 1); KVC_STEP(c + 1, 0); }
#undef KVC_LOAD
#undef KVC_PREP
#undef KVC_STEP
    }
}

__device__ __forceinline__ void phase_scan(const Ctx& C0, bool dry = false) {
    CTX_LOCAL(C0);
    for (int gt = C.vcu * 512 + fresh_tid(); gt < 32 * 4096; gt += C.G * 512) {
    const int bh = gt >> 12, e8 = gt & 4095;
    const float* BL = WSP(float, WS_BL) + bh * 128; const float* GM = WSP(float, WS_GM) + bh * 128; float* MS = WSP(float, WS_MS) + bh * 129;
    unsigned char* ST = WSP(unsigned char, WS_STATE) + (size_t)bh * 128 * 32768 + (size_t)e8 * 8; float* NK = WSP(float, WS_NK) + (size_t)bh * 128 * 128 + e8;
    float st[8]; float m = 0.f, nst = 0.f;
#pragma unroll
    for (int j = 0; j < 8; ++j) st[j] = 0.f;
    for (int c0 = 0; c0 < 128; c0 += 16) {
        u32x2 kv[16]; float nk[16];
#pragma unroll
        for (int i = 0; i < 16; ++i) { kv[i] = *(const u32x2*)(ST + (size_t)(c0 + i) * 32768); nk[i] = e8 < 128 ? NK[(c0 + i) * 128] : 0.f; }
#pragma unroll
        for (int i = 0; i < 16; ++i) { const int c = c0 + i; const float bl = BL[c], gm = GM[c]; const float mn = fmaxf(bl + m, gm), dec = expf(bl + m - mn);
            if (e8 == 0 && !dry) MS[c] = m;
            m = mn;
            const f32x4 k0 = un4_fp8x4(kv[i].x), k1 = un4_fp8x4(kv[i].y);
            st[0] = dec * st[0] + k0[0]; st[1] = dec * st[1] + k0[1]; st[2] = dec * st[2] + k0[2]; st[3] = dec * st[3] + k0[3];
            st[4] = dec * st[4] + k1[0]; st[5] = dec * st[5] + k1[1]; st[6] = dec * st[6] + k1[2]; st[7] = dec * st[7] + k1[3];
            const u32x2 o = (u32x2){pk4_fp8x4(st[0], st[1], st[2], st[3]), pk4_fp8x4(st[4], st[5], st[6], st[7])};
            if (dry) *(u32x2*)(WSP(unsigned char, WS_XB) + (size_t)bh * 1048576 + (size_t)(c & 31) * 32768 + (size_t)e8 * 8) = o; else *(u32x2*)(ST + (size_t)c * 32768) = o;
            if (e8 < 128) { nst = dec * nst + nk[i]; if (!dry) NK[c * 128] = nst; } }
    }
    }
}

__device__ __forceinline__ void phase_mlstm(const Ctx& C0, int l) {
    CTX_LOCAL(C0);
    PHASE_IDS();
    const unsigned char* Z8 = WSP(unsigned char, WS_Z); const float* IFp = WSP(float, WS_IF); const float* BC = WSP(float, WS_BC); const float* MS = WSP(float, WS_MS); unsigned char* AB8 = (unsigned char*)C.out;
    constexpr int PQ = 144, PV = 528, PC = 144, PP = 144;
    constexpr int OQ = 0, OK_ = 64 * PQ, OC = OK_ + 64 * PQ, OV = OC + 256 * PC, OP = OV + 64 * PV, OS = OP + 64 * PP;
    LAS unsigned char* Qs = C.lds + OQ; LAS unsigned char* Ks = C.lds + OK_; LAS unsigned char* Vs = C.lds + OV; LAS unsigned char* Cs = C.lds + OC; LAS unsigned char* Ps = C.lds + OP;
    LAS float* sA = (LAS float*)(C.lds + OS); LAS float* sPM = sA + 64; LAS float* sWI = sA + 128; LAS float* sEN = sA + 192; LAS float* sDN = sA + 256; LAS float* sN = sA + 320;
    constexpr int PH = 528;
    LAS unsigned char* Hs = C.lds + OS + 6144;
    LAS float* sG = (LAS float*)(C.lds + OS + 2048);
    { const float* mg_ = INP(I_MHG) + (size_t)l * 1024; for (int i = tid; i < 1024; i += 512) sG[i] = mg_[i]; }
    const int sq = tid >> 3, chq = tid & 7, sv = tid >> 4, chv = tid & 15;
    const int sc = tid >> 3, chc = tid & 7;
    u32x4 pq, pk, pv[2], pc[4]; float pn = 0.f, pbc = 0.f, pip = 0.f, pmc = 0.f;
#define MLSTM_PREFETCH(uu) do { const int bh_ = (uu) >> 7, c_ = (uu) & 127, b_ = bh_ >> 2, h_ = bh_ & 3; const size_t m_ = (size_t)b_ * SEQ + 64 * c_; \
        const unsigned char* st_ = WSP(unsigned char, WS_STATE) + (size_t)((uu) - 1) * 32768; \
        pq = *(const u32x4*)(Z8 + (m_ + sq) * Z8W + ZQ + 128 * h_ + 16 * chq); pk = *(const u32x4*)(Z8 + (m_ + sq) * Z8W + ZK + 128 * h_ + 16 * chq); \
        _Pragma("unroll") for (int i = 0; i < 2; ++i) pv[i] = *(const u32x4*)(Z8 + (m_ + sv + 32 * i) * Z8W + ZVM + 256 * h_ + 16 * chv); \
        _Pragma("unroll") for (int i = 0; i < 4; ++i) { pc[i] = (u32x4){0u, 0u, 0u, 0u}; if (c_ > 0) pc[i] = *(const u32x4*)(st_ + (sc + 64 * i) * 128 + 16 * chc); } \
        pn = (c_ > 0 && tid < 128) ? WSP(float, WS_NK)[(size_t)((uu) - 1) * 128 + (tid & 127)] : 0.f; \
        pbc = BC[(m_ + lane) * 4 + h_]; pip = IFp[(m_ + lane) * 8 + h_]; pmc = MS[bh_ * 129 + c_]; } while (0)
#define MLSTM_FILL() do { const float mc_ = pmc; \
        *(LAS u32x4*)(Qs + sq * PQ + chq * 16) = pq; *(LAS u32x4*)(Ks + sq * PQ + chq * 16) = pk; \
        _Pragma("unroll") for (int i = 0; i < 2; ++i) { float x[16]; un16_fp8x16(pv[i], x); bf16x16_to_lds(Vs + (sv + 32 * i) * PV + chv * 32, x); } \
        _Pragma("unroll") for (int i = 0; i < 4; ++i) *(LAS u32x4*)(Cs + (sc + 64 * i) * PC + chc * 16) = pc[i]; \
        if (tid < 128) sN[tid] = pn; \
        if (w == 0) { const float a = pip - pbc; float pm = a; \
            _Pragma("unroll") for (int o = 1; o < 64; o <<= 1) { const float t = shfl_idx(pm, lane - o); if (lane >= o) pm = fmaxf(pm, t); } \
            pm = fmaxf(pm, mc_); sA[lane] = a; sPM[lane] = pm; sWI[lane] = fast_exp(mc_ - pm); sEN[lane] = fast_exp(-pbc - pm); } } while (0)
    int u = C.vcu;
    if (u < 4096) { MLSTM_PREFETCH(u); MLSTM_FILL(); if (u + C.G < 4096) MLSTM_PREFETCH(u + C.G); }
    __syncthreads();
    for (; u < 4096; u += C.G) {
        const int bh = u >> 7, c = u & 127, b = bh >> 2, h = bh & 3; const size_t m0 = (size_t)b * SEQ + 64 * c; (void)c;
        const LAS float* mhg = sG + 256 * h;
        const int tf = tid >> 3, part = tid & 7;
        u32x4 po[2];
#pragma unroll
        for (int k8 = 0; k8 < 2; ++k8) po[k8] = *(const u32x4*)(Z8 + (m0 + tf) * Z8W + ZO + 256 * h + part * 32 + 16 * k8);
        {
            const int ti = w >> 1; f32x4 sa[2] = {(f32x4){0.f, 0.f, 0.f, 0.f}, (f32x4){0.f, 0.f, 0.f, 0.f}};
#pragma unroll
            for (int ks = 0; ks < 4; ++ks) { const long a = frag8(Qs, PQ, 16 * ti, 32 * ks, lane);
#pragma unroll
                for (int j = 0; j < 2; ++j) sa[j] = MFMA8(a, frag8(Ks, PQ, 16 * (2 * (w & 1) + j), 32 * ks, lane), sa[j]); }
#pragma unroll
            for (int j = 0; j < 2; ++j) { const int sc = 16 * (2 * (w & 1) + j) + (lane & 15); const float as = sA[sc];
#pragma unroll
                for (int r = 0; r < 4; ++r) { const int t = 16 * ti + 4 * (lane >> 4) + r; const float p = sc <= t ? sa[j][r] * (fast_exp(as - sPM[t]) * (1.0f / 256.0f)) : 0.f;
                    *(LAS bf16*)(Ps + t * PP + sc * 2) = f2bf(p); } }
        }
        __syncthreads();
        {
            const int t = tf;
            const u32x4 pr = *(const LAS u32x4*)(Ps + t * PP + part * 16);
            float ps = (bflo(pr.x) + bfhi(pr.x)) + (bflo(pr.y) + bfhi(pr.y)) + (bflo(pr.z) + bfhi(pr.z)) + (bflo(pr.w) + bfhi(pr.w));
            float qn = 0.f;
            { float qv[16]; un16_fp8x16(*(const LAS u32x4*)(Qs + t * PQ + part * 16), qv); const LAS float* nn = sN + part * 16;
#pragma unroll
              for (int i = 0; i < 16; ++i) qn += qv[i] * nn[i]; }
            ps = grp8_sum(ps);
            qn = grp8_sum(qn);
            if (part == 0) sDN[t] = fmaxf(fabsf(ps + sWI[t] * qn), sEN[t]);
        }
        f32x4 ac[4][2];
#pragma unroll
        for (int i = 0; i < 4; ++i)
#pragma unroll
            for (int j = 0; j < 2; ++j) ac[i][j] = (f32x4){0.f, 0.f, 0.f, 0.f};
#pragma unroll
        for (int ks = 0; ks < 4; ++ks) { long bc_[2];
#pragma unroll
            for (int j = 0; j < 2; ++j) bc_[j] = frag8(Cs, PC, 32 * w + 16 * j, 32 * ks, lane);
#pragma unroll
            for (int i = 0; i < 4; ++i) { const long a = frag8(Qs, PQ, 16 * i, 32 * ks, lane);
#pragma unroll
                for (int j = 0; j < 2; ++j) ac[i][j] = MFMA8(a, bc_[j], ac[i][j]); } }
#pragma unroll
        for (int i = 0; i < 4; ++i)
#pragma unroll
            for (int r = 0; r < 4; ++r) { const float wi = sWI[16 * i + 4 * (lane >> 4) + r] * (1.0f / 64.0f);
#pragma unroll
                for (int j = 0; j < 2; ++j) ac[i][j][r] *= wi; }
#pragma unroll
        for (int ks = 0; ks < 2; ++ks) { bf16x8 bv[2];
#pragma unroll
            for (int j = 0; j < 2; ++j) bv[j] = frag_tr(Vs, PV, 32 * ks, 32 * w + 16 * j, lane);
#pragma unroll
            for (int i = 0; i < 4; ++i) { const bf16x8 a = frag_row(Ps, PP, 16 * i, 32 * ks, lane);
#pragma unroll
                for (int j = 0; j < 2; ++j) ac[i][j] = MFMA16(a, bv[j], ac[i][j]); } }
#pragma unroll
        for (int i = 0; i < 4; ++i)
#pragma unroll
            for (int r = 0; r < 4; ++r) { const int t = 16 * i + 4 * (lane >> 4) + r;
#pragma unroll
                for (int j = 0; j < 2; ++j) *(LAS bf16*)(Hs + t * PH + (32 * w + 16 * j + (lane & 15)) * 2) = f2bf(ac[i][j][r]); }
        __syncthreads();
        {
            f32x4 hv[8]; float ss = 0.f; const float rd = __builtin_amdgcn_rcpf(sDN[tf]);
#pragma unroll
            for (int k8 = 0; k8 < 4; ++k8) { const u32x4 hq = *(const LAS u32x4*)(Hs + tf * PH + part * 64 + 16 * k8);
                hv[2 * k8] = (f32x4){bflo(hq.x), bfhi(hq.x), bflo(hq.y), bfhi(hq.y)} * rd; hv[2 * k8 + 1] = (f32x4){bflo(hq.z), bfhi(hq.z), bflo(hq.w), bfhi(hq.w)} * rd; }
#pragma unroll
            for (int k4 = 0; k4 < 8; ++k4) ss += hv[k4][0] * hv[k4][0] + hv[k4][1] * hv[k4][1] + hv[k4][2] * hv[k4][2] + hv[k4][3] * hv[k4][3];
            ss = grp8_sum(ss);
            const float rinv = __builtin_amdgcn_rsqf(ss * (1.0f / 256.0f) + kf(RMS_EPS));
#pragma unroll
            for (int k16 = 0; k16 < 2; ++k16) { const int v0 = part * 32 + 16 * k16; float og[16]; un16_fp8x16(po[k16], og); u32x4 o;
#pragma unroll
                for (int q = 0; q < 4; ++q) { const f32x4 gq = *(const LAS f32x4*)(mhg + v0 + 4 * q); const f32x4 xq = hv[4 * k16 + q];
                    o[q] = pk4_fp8x16(og[4 * q] * xq[0] * rinv * gq[0], og[4 * q + 1] * xq[1] * rinv * gq[1], og[4 * q + 2] * xq[2] * rinv * gq[2], og[4 * q + 3] * xq[3] * rinv * gq[3]); }
                *(u32x4*)(AB8 + (m0 + tf) * 2048 + 1024 + 256 * h + v0) = o; }
        }
        if (u + C.G < 4096) { MLSTM_FILL(); if (u + 2 * C.G < 4096) MLSTM_PREFETCH(u + 2 * C.G); }
        __syncthreads();
    }
#undef MLSTM_FILL
#undef MLSTM_PREFETCH
}

__device__ __forceinline__ void phase_ln1_router(const Ctx& C0, int l, bool dry = false) {
    CTX_LOCAL(C0);
    PHASE_IDS();
    bf16* X = WSP(bf16, WS_XR); bf16* XO = dry ? WSP(bf16, WS_GBUF) : X; bf16* XB = WSP(bf16, WS_XB); int* TOKE = WSP(int, WS_TOKE); float* TOKW = WSP(float, WS_TOKW); int* HIST = WSP(int, WS_HIST);
    const float* g1 = INP(I_LN1G) + (size_t)l * D; const float* b1 = INP(I_LN1B) + (size_t)l * D; const float* wr = INP(I_WR) + (size_t)l * D * NE; const float* br = INP(I_BR) + (size_t)l * NE;
    LAS float* Xt = (LAS float*)C.lds;
    LAS float* PART = (LAS float*)(C.lds + 16 * 1028 * 4);
    LAS int* hist = (LAS int*)(C.lds + 16 * 1028 * 4 + 8 * 16 * 64 * 4);
    LAS float* gb = (LAS float*)(C.lds + 16 * 1028 * 4 + 8 * 16 * 64 * 4 + 256);
    for (int i = tid; i < 1024; i += 512) { gb[i] = g1[i]; gb[1024 + i] = b1[i]; }
    __syncthreads();
    const float brl = br[lane];
    bf16x8 bh[4][4], bl[4][4];
#pragma unroll
    for (int ks = 0; ks < 4; ++ks)
#pragma unroll
        for (int et = 0; et < 4; ++et) { float f[8];
#pragma unroll
            for (int j = 0; j < 8; ++j) f[j] = wr[(size_t)(128 * w + 32 * ks + 8 * (lane >> 4) + j) * NE + 16 * et + (lane & 15)];
            u32x4 hh, ll;
#pragma unroll
            for (int q = 0; q < 4; ++q) { const unsigned hp = cvt_pk_bf16(f[2 * q], f[2 * q + 1]); hh[q] = hp; ll[q] = cvt_pk_bf16(f[2 * q] - bflo(hp), f[2 * q + 1] - bfhi(hp)); }
            bh[ks][et] = __builtin_bit_cast(bf16x8, hh); bl[ks][et] = __builtin_bit_cast(bf16x8, ll); }
    for (int blk = C.vcu; blk < M / 256; blk += C.G) {
        if (tid < 64) hist[tid] = 0;
        __syncthreads();
        u32x2 pre[2][4];
#pragma unroll
        for (int rr = 0; rr < 2; ++rr)
#pragma unroll
            for (int j = 0; j < 4; ++j) pre[rr][j] = *(const u32x2*)(X + ((size_t)blk * 256 + 2 * w + rr) * D + 256 * j + 4 * lane);
        for (int bt = 0; bt < 16; ++bt) {
            const size_t mb = (size_t)blk * 256 + bt * 16;
#pragma unroll
            for (int rr = 0; rr < 2; ++rr) { const int row = 2 * w + rr; const size_t m = mb + row; f32x4 v[4]; float s = 0.f;
#pragma unroll
                for (int j = 0; j < 4; ++j) { const u32x2 q = pre[rr][j]; v[j] = (f32x4){bflo(q.x), bfhi(q.x), bflo(q.y), bfhi(q.y)}; s += (v[j][0] + v[j][1]) + (v[j][2] + v[j][3]); }
                const float mean = wave_sum(s) * (1.0f / D); float q = 0.f;
#pragma unroll
                for (int j = 0; j < 4; ++j) { v[j] = v[j] - mean; q += (v[j][0] * v[j][0] + v[j][1] * v[j][1]) + (v[j][2] * v[j][2] + v[j][3] * v[j][3]); }
                const float rstd = __builtin_amdgcn_rsqf(wave_sum(q) * (1.0f / D) + kf(LN_EPS));
#pragma unroll
                for (int j = 0; j < 4; ++j) { const f32x4 y = v[j] * rstd * *(const LAS f32x4*)(gb + 256 * j + 4 * lane) + *(const LAS f32x4*)(gb + 1024 + 256 * j + 4 * lane);
                    { u32x2 o; o.x = cvt_pk_bf16(y[0], y[1]); o.y = cvt_pk_bf16(y[2], y[3]); *(u32x2*)(XO + m * D + 256 * j + 4 * lane) = o; } *(LAS f32x4*)(Xt + row * 1028 + 256 * j + 4 * lane) = y;
                    int w8 = __builtin_amdgcn_cvt_pk_fp8_f32(y[0] * 16.f, y[1] * 16.f, 0, false); w8 = __builtin_amdgcn_cvt_pk_fp8_f32(y[2] * 16.f, y[3] * 16.f, w8, true);
                    *(int*)((unsigned char*)XB + m * D + 256 * j + 4 * lane) = w8; } }
            __syncthreads();
            if (bt + 1 < 16) {
#pragma unroll
                for (int rr = 0; rr < 2; ++rr)
#pragma unroll
                    for (int j = 0; j < 4; ++j) pre[rr][j] = *(const u32x2*)(X + (mb + 16 + 2 * w + rr) * D + 256 * j + 4 * lane); }
            {
                f32x4 acc[4] = {(f32x4){0.f, 0.f, 0.f, 0.f}, (f32x4){0.f, 0.f, 0.f, 0.f}, (f32x4){0.f, 0.f, 0.f, 0.f}, (f32x4){0.f, 0.f, 0.f, 0.f}};
                const LAS float* xa = Xt + (lane & 15) * 1028 + 128 * w + 8 * (lane >> 4);
#pragma unroll
                for (int ks = 0; ks < 4; ++ks) { const f32x4 x0 = *(const LAS f32x4*)(xa + 32 * ks), x1 = *(const LAS f32x4*)(xa + 32 * ks + 4);
                    u32x4 hh, ll;
                    hh[0] = cvt_pk_bf16(x0[0], x0[1]); hh[1] = cvt_pk_bf16(x0[2], x0[3]); hh[2] = cvt_pk_bf16(x1[0], x1[1]); hh[3] = cvt_pk_bf16(x1[2], x1[3]);
                    ll[0] = cvt_pk_bf16(x0[0] - bflo(hh[0]), x0[1] - bfhi(hh[0])); ll[1] = cvt_pk_bf16(x0[2] - bflo(hh[1]), x0[3] - bfhi(hh[1]));
                    ll[2] = cvt_pk_bf16(x1[0] - bflo(hh[2]), x1[1] - bfhi(hh[2])); ll[3] = cvt_pk_bf16(x1[2] - bflo(hh[3]), x1[3] - bfhi(hh[3]));
                    const bf16x8 ah = __builtin_bit_cast(bf16x8, hh), al = __builtin_bit_cast(bf16x8, ll);
#pragma unroll
                    for (int et = 0; et < 4; ++et) { acc[et] = MFMA16(ah, bh[ks][et], acc[et]); acc[et] = MFMA16(ah, bl[ks][et], acc[et]); acc[et] = MFMA16(al, bh[ks][et], acc[et]); } }
#pragma unroll
                for (int et = 0; et < 4; ++et)
#pragma unroll
                    for (int r = 0; r < 4; ++r) PART[(w * 16 + 4 * (lane >> 4) + r) * 64 + 16 * et + (lane & 15)] = acc[et][r];
            }
            __syncthreads();
            {
                const float ninf = kf(-INFINITY); const int grp = lane >> 3;
                float score[2], sel[2], gs[2], cur[2], ssum[2]; int rank[2];
#pragma unroll
                for (int rr = 0; rr < 2; ++rr) { const int row = 2 * w + rr; float lg = 0.f;
#pragma unroll
                    for (int p = 0; p < 8; ++p) lg += PART[(p * 16 + row) * 64 + lane];
                    score[rr] = fast_sigmoid(lg); sel[rr] = score[rr] + brl; }
                float m1[2], s2[2];
#pragma unroll
                for (int rr = 0; rr < 2; ++rr) m1[rr] = grp8_max(sel[rr]);
#pragma unroll
                for (int rr = 0; rr < 2; ++rr) { const unsigned long long bm = __ballot(sel[rr] == m1[rr]); const unsigned gb = (unsigned)(bm >> (8 * grp)) & 0xffu; const int first = __builtin_ctz(gb);
                    s2[rr] = ((lane & 7) == first) ? ninf : sel[rr]; }
#pragma unroll
                for (int rr = 0; rr < 2; ++rr) gs[rr] = m1[rr] + grp8_max(s2[rr]);
#pragma unroll
                for (int rr = 0; rr < 2; ++rr) { int gc = 0;
#pragma unroll
                    for (int g2 = 0; g2 < 8; ++g2) { const float o = rdlane(gs[rr], 8 * g2); gc += (o > gs[rr] || (o == gs[rr] && g2 < grp)) ? 1 : 0; }
                    cur[rr] = gc < 4 ? sel[rr] : ninf; rank[rr] = TOPK; }
#pragma unroll
                for (int r = 0; r < TOPK; ++r) { float mx[2];
#pragma unroll
                    for (int rr = 0; rr < 2; ++rr) mx[rr] = wave_max(cur[rr]);
#pragma unroll
                    for (int rr = 0; rr < 2; ++rr) { const int idx = (int)__builtin_ctzll(__ballot(cur[rr] == mx[rr])); const bool hit = lane == idx; rank[rr] = hit ? r : rank[rr]; cur[rr] = hit ? ninf : cur[rr]; } }
#pragma unroll
                for (int rr = 0; rr < 2; ++rr) ssum[rr] = wave_sum(rank[rr] < TOPK ? score[rr] : 0.f);
#pragma unroll
                for (int rr = 0; rr < 2; ++rr) { const size_t m = mb + 2 * w + rr;
                    if (rank[rr] < TOPK) { TOKE[m * 8 + rank[rr]] = lane; TOKW[m * 8 + rank[rr]] = score[rr] * __builtin_amdgcn_rcpf(ssum[rr]) * ROUTE_SCALE; __hip_atomic_fetch_add(&hist[lane], 1, __ATOMIC_RELAXED, __HIP_MEMORY_SCOPE_WORKGROUP); } }
            }
        }
        __syncthreads();
        if (tid < 64) HIST[blk * 64 + tid] = hist[tid];
        __syncthreads();
    }
}

__device__ __forceinline__ void phase_sort(const Ctx& C0) {
    CTX_LOCAL(C0);
    PHASE_IDS();
    const int* HIST = WSP(int, WS_HIST); const int* TOKE = WSP(int, WS_TOKE); const float* TOKW = WSP(float, WS_TOKW);
    int* POS = WSP(int, WS_POS); int* STOK = WSP(int, WS_STOK); float* SW = WSP(float, WS_SW); int* TILEE = WSP(int, WS_TILEE); int* CNT = WSP(int, WS_CNT);
    LAS int* psum = (LAS int*)C.lds;
    LAS int* cntH = psum + 512;
    LAS int* ntile = cntH + 128;
    LAS int* rstart = ntile + 128;
    LAS int* ntl = rstart + 128;
    LAS int* cur = ntl + 16;
    LAS int* wcnt = cur + 64;
    { const int e = tid & 63, part = tid >> 6; int s = 0;
        for (int b2 = 32 * part; b2 < 32 * part + 32; ++b2) s += HIST[b2 * 64 + e];
        psum[part * 64 + e] = s; }
    __syncthreads();
    if (tid < 128) { const int hf = tid >> 6, e = tid & 63; const int cnt = psum[(4 * hf) * 64 + e] + psum[(4 * hf + 1) * 64 + e] + psum[(4 * hf + 2) * 64 + e] + psum[(4 * hf + 3) * 64 + e];
        cntH[tid] = cnt; ntile[tid] = (cnt + 255) >> 8; }
    __syncthreads();
    if (tid < 2) { int rs = 0; for (int e = 0; e < 64; ++e) { rstart[tid * 64 + e] = rs; rs += ntile[tid * 64 + e] * 256; } ntl[tid] = rs >> 8; }
    __syncthreads();
    const int NTL0 = ntl[0], NTL1 = ntl[1];
    if (C.vcu == 0) {
        if (tid == 0) { CNT[0] = NTL0; CNT[1] = NTL1; }
        if (tid < 128) { const int hf = tid >> 6, e = tid & 63; const int t0 = (hf ? NTL0 : 0) + (rstart[tid] >> 8), n = ntile[tid];
            for (int t = 0; t < n; ++t) TILEE[t0 + t] = e;
            const int base = M + (hf ? 256 * NTL0 : 0) + rstart[tid];
            int zi = 0; asm volatile("" : "+v"(zi));
#pragma unroll 1
            for (int r = cntH[tid]; r < n * 256; ++r) { STOK[base + r] = zi; SW[base + r] = __int_as_float(zi); } }
    }
    for (int blk = C.vcu; blk < M / 256; blk += C.G) {
        const int hf = blk >> 7;
        { const int e = tid & 63, part = tid >> 6; int s = 0; const int lo = 128 * hf + 16 * part; int hi = lo + 16; if (hi > blk) hi = blk;
            for (int b2 = lo; b2 < hi; ++b2) s += HIST[b2 * 64 + e];
            psum[part * 64 + e] = s; }
        __syncthreads();
        if (tid < 64) { int s = M + (hf ? 256 * NTL0 : 0) + rstart[hf * 64 + tid];
#pragma unroll
            for (int p = 0; p < 8; ++p) s += psum[p * 64 + tid];
            cur[tid] = s; }
        __syncthreads();
        for (int q = 0; q < 4; ++q) {
            const int pair = tid + 512 * q; const size_t idx = (size_t)blk * 2048 + pair; const int e = TOKE[idx];
            int rnk = 0, mycnt = 0;
            for (int ee = 0; ee < 64; ++ee) { const unsigned long long mk = __ballot(e == ee);
                if (e == ee) rnk = __popcll(mk & ((1ull << lane) - 1ull));
                if (lane == ee) mycnt = __popcll(mk); }
            wcnt[w * 64 + lane] = mycnt;
            __syncthreads();
            int pos = cur[e] + rnk;
            for (int w2 = 0; w2 < w; ++w2) pos += wcnt[w2 * 64 + e];
            STOK[pos] = (int)(idx >> 3); SW[pos] = TOKW[idx]; POS[idx] = pos;
            __syncthreads();
            if (tid < 64) { int a = 0;
#pragma unroll
                for (int w2 = 0; w2 < 8; ++w2) a += wcnt[w2 * 64 + tid];
                cur[tid] += a; }
            __syncthreads();
        }
        if (tid < 256) { const int r = blk * 256 + tid; STOK[r] = r; SW[r] = 1.0f; }
        __syncthreads();
    }
}

__device__ __forceinline__ void load_wif_wide(const Ctx& C0, int l, LAS float* wif) {
    CTX_LOCAL(C0);
    const float* win = INP(I_WIN) + (size_t)l * D * DIN;
    for (int i = fresh_tid(); i < 1024 * 8; i += 512) { const int k = i >> 3, g = i & 7; wif[(((k & 15) * 2 + (g >> 2)) * 64 + (k >> 4)) * 4 + (g & 3)] = win[(size_t)k * DIN + 5120 + g]; }
    __syncthreads();
}
__device__ __forceinline__ void phase_ln2(const Ctx& C0, int l, bool dry = false) {
    CTX_LOCAL(C0);
    PHASE_IDS();
    const int gw = C.vcu * 8 + w, NGW = C.G * 8;
    bf16* X = WSP(bf16, WS_XR); bf16* XO = dry ? WSP(bf16, WS_GBUF) : X; float* OUT = C.out; const int* POS = WSP(int, WS_POS); const unsigned char* OUTS = WSP(unsigned char, WS_OUTS);
    unsigned char* XB = WSP(unsigned char, WS_XB); float* IFp = WSP(float, WS_IF);
    const float* g2 = INP(I_LN2G) + (size_t)l * D; const float* b2 = INP(I_LN2B) + (size_t)l * D;
    const int obase = M;
    LAS float* wif = (LAS float*)C.lds;
    const bool nxt = l + 1 < DEPTH;
    if (nxt) load_wif_wide(C, l + 1, wif);
    const float bifl = (INP(I_BIN) + (size_t)(nxt ? l + 1 : l) * DIN + 5120)[(lane >> 1) & 7];
    f32x4 gv[4], bv[4];
#pragma unroll
    for (int q = 0; q < 4; ++q) { gv[q] = *(const f32x4*)(g2 + 16 * lane + 4 * q); bv[q] = *(const f32x4*)(b2 + 16 * lane + 4 * q); }
    const bool b3 = (lane & 8) != 0, b2_ = (lane & 4) != 0, b1 = (lane & 2) != 0;
    int npos[8]; u32x4 ov[8]; u32x4 xq[2];
    if (gw < M) {
#pragma unroll
        for (int k = 0; k < 8; ++k) npos[k] = POS[(size_t)gw * 8 + k] - obase;
#pragma unroll
        for (int k = 0; k < 8; ++k) ov[k] = __builtin_nontemporal_load((const u32x4*)(OUTS + (size_t)npos[k] * D + 16 * lane));
#pragma unroll
        for (int h2 = 0; h2 < 2; ++h2) xq[h2] = *(const u32x4*)(X + (size_t)gw * D + 16 * lane + 8 * h2);
        { const int mn = (gw + NGW < M) ? gw + NGW : gw;
#pragma unroll
          for (int k = 0; k < 8; ++k) npos[k] = POS[(size_t)mn * 8 + k] - obase; }
    }
    for (int m = gw; m < M; m += NGW) {
        f32x4 v[4]; u32x4 ovn[8]; u32x4 xqn[2];
        const int mnx = (m + NGW < M) ? m + NGW : m;
#pragma unroll
        for (int k = 0; k < 8; ++k) ovn[k] = __builtin_nontemporal_load((const u32x4*)(OUTS + (size_t)npos[k] * D + 16 * lane));
#pragma unroll
        for (int h2 = 0; h2 < 2; ++h2) xqn[h2] = *(const u32x4*)(X + (size_t)mnx * D + 16 * lane + 8 * h2);
        { const int mn2 = (m + 2 * NGW < M) ? m + 2 * NGW : mnx;
#pragma unroll
          for (int k = 0; k < 8; ++k) npos[k] = POS[(size_t)mn2 * 8 + k] - obase; }
#pragma unroll
        for (int h2 = 0; h2 < 2; ++h2) { const u32x4 q = xq[h2]; v[2 * h2] = (f32x4){bflo(q.x), bfhi(q.x), bflo(q.y), bfhi(q.y)}; v[2 * h2 + 1] = (f32x4){bflo(q.z), bfhi(q.z), bflo(q.w), bfhi(q.w)}; }
#pragma unroll
        for (int q = 0; q < 4; ++q) { f32x4 a = (f32x4){0.f, 0.f, 0.f, 0.f};
#pragma unroll
            for (int k = 0; k < 8; ++k) { const int w8 = (int)ov[k][q]; a[0] += __builtin_amdgcn_cvt_f32_fp8(w8, 0); a[1] += __builtin_amdgcn_cvt_f32_fp8(w8, 1); a[2] += __builtin_amdgcn_cvt_f32_fp8(w8, 2); a[3] += __builtin_amdgcn_cvt_f32_fp8(w8, 3); }
            v[q] = v[q] + a * (1.0f / 256.0f); }
        float s = 0.f;
#pragma unroll
        for (int q = 0; q < 4; ++q) s += (v[q][0] + v[q][1]) + (v[q][2] + v[q][3]);
        const float mean = wave_sum(s) * (1.0f / D); float qq = 0.f;
#pragma unroll
        for (int q = 0; q < 4; ++q) { v[q] = v[q] - mean; qq += (v[q][0] * v[q][0] + v[q][1] * v[q][1]) + (v[q][2] * v[q][2] + v[q][3] * v[q][3]); }
        const float rstd = __builtin_amdgcn_rsqf(wave_sum(qq) * (1.0f / D) + kf(LN_EPS));
#pragma unroll
        for (int q = 0; q < 4; ++q) v[q] = v[q] * rstd * gv[q] + bv[q];
        if (nxt) {
#pragma unroll
            for (int h2 = 0; h2 < 2; ++h2) { u32x4 o; o.x = cvt_pk_bf16(v[2 * h2][0], v[2 * h2][1]); o.y = cvt_pk_bf16(v[2 * h2][2], v[2 * h2][3]); o.z = cvt_pk_bf16(v[2 * h2 + 1][0], v[2 * h2 + 1][1]); o.w = cvt_pk_bf16(v[2 * h2 + 1][2], v[2 * h2 + 1][3]);
                __builtin_nontemporal_store(o, (u32x4*)(XO + (size_t)m * D + 16 * lane + 8 * h2)); }
            { u32x4 o;
#pragma unroll
              for (int q = 0; q < 4; ++q) { int w8 = __builtin_amdgcn_cvt_pk_fp8_f32(v[q][0] * 16.f, v[q][1] * 16.f, 0, false); w8 = __builtin_amdgcn_cvt_pk_fp8_f32(v[q][2] * 16.f, v[q][3] * 16.f, w8, true); o[q] = (unsigned)w8; }
              *(u32x4*)(XB + (size_t)m * D + 16 * lane) = o; }
            float g[8];
#pragma unroll
            for (int i = 0; i < 8; ++i) g[i] = 0.f;
#pragma unroll
            for (int q = 0; q < 4; ++q)
#pragma unroll
                for (int e = 0; e < 4; ++e) { const int kk = 4 * q + e; const f32x4 w0 = *(const LAS f32x4*)(wif + ((kk * 2) * 64 + lane) * 4), w1 = *(const LAS f32x4*)(wif + ((kk * 2 + 1) * 64 + lane) * 4); const float x = v[q][e];
                    g[0] += x * w0[0]; g[1] += x * w0[1]; g[2] += x * w0[2]; g[3] += x * w0[3]; g[4] += x * w1[0]; g[5] += x * w1[1]; g[6] += x * w1[2]; g[7] += x * w1[3]; }
            float h4[4], p2[2], r;
#pragma unroll
            for (int i = 0; i < 4; ++i) h4[i] = (b3 ? g[i + 4] : g[i]) + dppf<0x140>(b3 ? g[i] : g[i + 4]);
#pragma unroll
            for (int i = 0; i < 2; ++i) p2[i] = (b2_ ? h4[i + 2] : h4[i]) + dppf<0x141>(b2_ ? h4[i] : h4[i + 2]);
            r = (b1 ? p2[1] : p2[0]) + dppf<0x4E>(b1 ? p2[0] : p2[1]);
            r += dppf<0xB1>(r);
            { const auto t = __builtin_amdgcn_permlane32_swap(__float_as_uint(r), __float_as_uint(r), false, false); r = __uint_as_float(t[0]) + __uint_as_float(t[1]); }
            { const auto t = __builtin_amdgcn_permlane16_swap(__float_as_uint(r), __float_as_uint(r), false, false); r = __uint_as_float(t[0]) + __uint_as_float(t[1]); }
            if (lane < 16 && (lane & 1) == 0) IFp[(size_t)m * 8 + (lane >> 1)] = r + bifl;
        } else {
#pragma unroll
            for (int q = 0; q < 4; ++q) *(f32x4*)(OUT + (size_t)m * D + 16 * lane + 4 * q) = v[q];
        }
#pragma unroll
        for (int k = 0; k < 8; ++k) ov[k] = ovn[k];
#pragma unroll
        for (int h2 = 0; h2 < 2; ++h2) xq[h2] = xqn[h2];
    }
}

__device__ __forceinline__ void load_tile_table(const Ctx& C0, int n) {
    CTX_LOCAL(C0);
    const int* TILEE = WSP(int, WS_TILEE); LAS int* t = (LAS int*)(C.lds + LDS_TILE);
    for (int i = fresh_tid(); i < n; i += 512) t[i] = TILEE[i];
    __syncthreads();
}

__global__ void __launch_bounds__(512, 2) mk_fwd(KArgs args) {
    Ctx CK; CK.lds = (LAS unsigned char*)lds_raw;
    if ((threadIdx.x & 63) == 0) *(volatile LAS int*)(CK.lds + LDS_WTAB + 4 * hw_wave_key()) = (int)(threadIdx.x >> 6);
    CK.G = gridDim.x; { const int bx = blockIdx.x; CK.vcu = (CK.G % 8 == 0) ? (bx % 8) * (CK.G / 8) + bx / 8 : bx; }
    CK.out = args.out; CK.ws = args.ws;
    volatile LAS unsigned* MISC = (volatile LAS unsigned*)(CK.lds + LDS_MISC);
    if (threadIdx.x < 64) MISC[threadIdx.x] = 0u;
    if (threadIdx.x == 0) {
#pragma unroll
        for (int k = 0; k < 27; ++k) *(LAS unsigned long long*)(CK.lds + LDS_PTRS + 8 * k) = (unsigned long long)args.in[k];
    }
    __syncthreads();
    const bool use_bar = (args.ph_hi - args.ph_lo) > 1;
    if (use_bar && threadIdx.x == 0) (void)xb_add((unsigned*)(args.ws + WS_CTL) + CW_BAR + XB_XCNT(xb_xcc_id()), 1u);
    const int lo = args.ph_lo, hi = args.ph_hi;

    for (int l = 0; l < DEPTH; ++l) {
        const int p0 = l * NPH;
        if (p0 + NPH <= lo || p0 >= hi) continue;
#define IN(k) (((PH_MASK >> (k)) & 1u) && opq_int(lo) <= p0 + (k) && p0 + (k) < hi)
#define REP(k) (((TREP >> (k)) & 1u) != 0u)
#define SEAM(k) do { if (IN(k) && (p0 + (k) + 1 < hi)) { XcdBarrier bar_; unsigned zo_ = 0u; asm volatile("" : "+v"(zo_)); bar_.bar = (unsigned*)(opq_ptr(CK.ws) + WS_CTL + zo_) + CW_BAR;     bar_.x = (unsigned)__builtin_amdgcn_readfirstlane((int)xb_xcc_id()); \
        bar_.st = (volatile LAS unsigned*)(CK.lds + LDS_MISC) + 8; xcd_barrier(bar_); } } while (0)
        if (l == 0) { if (IN(0)) { if (REP(0)) { phase_convert(CK, 0, true); __syncthreads(); } phase_convert(CK, 0, true); } SEAM(0); }
        if (IN(1)) {
            CTX_LOCAL(CK); bf16* Z = WSP(bf16, WS_Z); bf16* XB = WSP(bf16, WS_XB); const int bx = opq_int((int)blockIdx.x);
            phase_gates(CK);
            if (REP(1)) {
                g8::SchedDenseT<M / 256, ZW / 256> S; S.init(M, ZW, C.G, bx, XB, D / 2, WSP(bf16, WS_WIN), D / 2);
                g8::EpiZ E{WSP(unsigned char, WS_Z), WSP(bf16, WS_ZG), WSP(float, WS_BIAS1), WSP(float, WS_VPART), REP(22)};
                g8::gemm_phase<g8::EpiZ, g8::SchedDenseT<M / 256, ZW / 256>, false, g8::MidNone, G8_SP2, true>(C.lds, D / 2, D / 2, D / 2, S, E, nullptr);
                __syncthreads();
            }
            g8::SchedDenseT<M / 256, ZW / 256> S; S.init(M, ZW, C.G, bx, XB, D / 2, WSP(bf16, WS_WIN), D / 2);
            g8::EpiZ E{WSP(unsigned char, WS_Z), WSP(bf16, WS_ZG), WSP(float, WS_BIAS1), WSP(float, WS_VPART), false};
            g8::gemm_phase<g8::EpiZ, g8::SchedDenseT<M / 256, ZW / 256>, false, g8::MidNone, G8_SP2, true>(C.lds, D / 2, D / 2, D / 2, S, E, nullptr);
        } SEAM(1);
        if (IN(2)) {
            if (REP(16)) phase_sgu(CK, l);
            phase_sgu(CK, l);
            if (REP(17)) phase_kvchain(CK);
            phase_kvchain(CK);
        } SEAM(2);
        if (IN(4)) { if (REP(4)) phase_mlstm(CK, l); phase_mlstm(CK, l); } SEAM(4);
        if (IN(5)) {
            CTX_LOCAL(CK); bf16* Z = WSP(bf16, WS_Z); const int bx = opq_int((int)blockIdx.x);
            if (REP(5)) {
                g8::SchedDenseT<M / 256, D / 256> S; S.init(M, D, C.G, bx, C.out, 1024, WSP(bf16, WS_W4), 1024);
                g8::EpiGate E{WSP(bf16, WS_ZG), ZGP, 1024, nullptr, 0, 0, (bf16*)WSP(unsigned char, WS_Z), Z8W / 2, ZY / 2, true};
                g8::MidMulP Md{WSP(bf16, WS_ZG), ZGP, 0};
                g8::gemm_phase<g8::EpiGate, g8::SchedDenseT<M / 256, D / 256>, false, g8::MidMulP, G8_SP2, true>(C.lds, 1024, 1024, 1024, S, E, nullptr, Md);
                __syncthreads();
            }
            g8::SchedDenseT<M / 256, D / 256> S; S.init(M, D, C.G, bx, C.out, 1024, WSP(bf16, WS_W4), 1024);
            g8::EpiGate E{WSP(bf16, WS_ZG), ZGP, 1024, nullptr, 0, 0, (bf16*)WSP(unsigned char, WS_Z), Z8W / 2, ZY / 2, true};
            g8::MidMulP Md{WSP(bf16, WS_ZG), ZGP, 0};
            g8::gemm_phase<g8::EpiGate, g8::SchedDenseT<M / 256, D / 256>, false, g8::MidMulP, G8_SP2, true>(C.lds, 1024, 1024, 1024, S, E, nullptr, Md);
        } SEAM(5);
        if (IN(6)) {
            CTX_LOCAL(CK); bf16* Z = WSP(bf16, WS_Z); const int bx = opq_int((int)blockIdx.x);
            g8::SchedDenseT<M / 256, D / 256> S; S.init(M, D, C.G, bx, WSP(unsigned char, WS_Z) + ZY, Z8W / 2, WSP(bf16, WS_W4) + (size_t)2 * D * D, D / 2);
            g8::EpiResid E{l == 0 ? INP(I_X) : (const float*)nullptr, WSP(bf16, WS_XR)};
            g8::gemm_phase<g8::EpiResid, g8::SchedDenseT<M / 256, D / 256>, false, g8::MidNone, G8_SP2, true>(C.lds, Z8W / 2, D / 2, D / 2, S, E, nullptr);
        } SEAM(6);
        if (IN(7)) { if (REP(7)) phase_ln1_router(CK, l, true); phase_ln1_router(CK, l); } SEAM(7);
        if (IN(8)) { if (REP(8)) { phase_sort(CK); convert_pb(CK, l); __syncthreads(); } phase_sort(CK); convert_pb(CK, l); } SEAM(8);
        if (IN(9)) {
            CTX_LOCAL(CK); bf16* XB = WSP(bf16, WS_XB); const int bx = opq_int((int)blockIdx.x);
            const int* CNT = WSP(int, WS_CNT); const int nexp = CNT[0] + CNT[1];
            if (REP(9)) {
                load_tile_table(C, nexp);
                g8::SchedUp S{(const LAS int*)(C.lds + LDS_TILE), NSH_TILES + nexp, C.G, C.vcu, (const char*)XB, (const char*)WSP(bf16, WS_UPT)};
                g8::EpiMoeUp E{WSP(bf16, WS_HID), WSP(float, WS_SW), WSP(bf16, WS_PBH)};
                g8::gemm_phase<g8::EpiMoeUp, g8::SchedUp, true, g8::MidNone, G8_SP2, true>(C.lds, D / 2, D / 2, D / 2, S, E, WSP(int, WS_STOK));
                g8::SchedDenseT<M / 256, D / 256> S2; S2.init(M, D, C.G, bx, XB, D / 2, WSP(bf16, WS_W4) + (size_t)3 * D * D, D / 2);
                g8::EpiBiasAct E2{WSP(bf16, WS_GBUF), D, INP(I_BPG) + (size_t)l * D, 0xAAull, nullptr};
                g8::gemm_phase<g8::EpiBiasAct, g8::SchedDenseT<M / 256, D / 256>, false, g8::MidNone, G8_SP2, true>(C.lds, D / 2, D / 2, D / 2, S2, E2, nullptr);
                __syncthreads();
            }
            load_tile_table(C, nexp);
            g8::SchedUp S{(const LAS int*)(C.lds + LDS_TILE), NSH_TILES + nexp, C.G, C.vcu, (const char*)XB, (const char*)WSP(bf16, WS_UPT)};
            g8::EpiMoeUp E{WSP(bf16, WS_HID), WSP(float, WS_SW), WSP(bf16, WS_PBH)};
            g8::gemm_phase<g8::EpiMoeUp, g8::SchedUp, true, g8::MidNone, G8_SP2, true>(C.lds, D / 2, D / 2, D / 2, S, E, WSP(int, WS_STOK));
            g8::SchedDenseT<M / 256, D / 256> S2; S2.init(M, D, C.G, bx, XB, D / 2, WSP(bf16, WS_W4) + (size_t)3 * D * D, D / 2);
            g8::EpiBiasAct E2{WSP(bf16, WS_GBUF), D, INP(I_BPG) + (size_t)l * D, 0xAAull, nullptr};
            g8::gemm_phase<g8::EpiBiasAct, g8::SchedDenseT<M / 256, D / 256>, false, g8::MidNone, G8_SP2, true>(C.lds, D / 2, D / 2, D / 2, S2, E2, nullptr);
        } SEAM(9);
        if (IN(10)) {
            CTX_LOCAL(CK); const int bx = opq_int((int)blockIdx.x);
            {
                g8::SchedDenseT<M / 256, D / 256> S; S.init(M, D, C.G, bx, WSP(bf16, WS_PBH), 256, WSP(bf16, WS_WPT), 256);
                g8::EpiResid E{(const float*)nullptr, WSP(bf16, WS_XR)};
                g8::MidMulP Md{WSP(bf16, WS_GBUF), D, 0};
                g8::gemm_phase<g8::EpiResid, g8::SchedDenseT<M / 256, D / 256>, false, g8::MidMulP, G8_SP2, true>(C.lds, 256, 256, 256, S, E, nullptr, Md);
            }
            const int* CNT = WSP(int, WS_CNT); const int n0 = CNT[0], n1 = CNT[1];
            if (REP(12)) {
                load_tile_table(C, n0 + n1);
                g8::SchedDown S{(const LAS int*)(C.lds + LDS_TILE), n0 + n1, 0, C.G, C.vcu, (const char*)WSP(bf16, WS_HID), (const char*)WSP(bf16, WS_DNT)};
                g8::EpiOut8 E{WSP(unsigned char, WS_OUTS), D};
                g8::gemm_phase<g8::EpiOut8, g8::SchedDown, false, g8::MidNone, G8_SP2, true>(C.lds, DEXP / 2, DEXP / 2, DEXP / 2, S, E, nullptr);
                __syncthreads();
            }
            load_tile_table(C, n0 + n1);
            g8::SchedDown S{(const LAS int*)(C.lds + LDS_TILE), n0 + n1, 0, C.G, C.vcu, (const char*)WSP(bf16, WS_HID), (const char*)WSP(bf16, WS_DNT)};
            g8::EpiOut8 E{WSP(unsigned char, WS_OUTS), D};
            g8::gemm_phase<g8::EpiOut8, g8::SchedDown, false, g8::MidNone, G8_SP2, true>(C.lds, DEXP / 2, DEXP / 2, DEXP / 2, S, E, nullptr);
        } SEAM(10);
        if (IN(11)) { if (REP(11)) { phase_ln2(CK, l, true); __syncthreads(); } phase_ln2(CK, l); if (l + 1 < DEPTH) { __syncthreads(); phase_convert(CK, l + 1, false); if (REP(20)) { __syncthreads(); phase_convert(CK, l + 1, false); } } } SEAM(11);
#undef IN
#undef SEAM
    }
}

__global__ void k_fill(float* out, int n, float v) { for (int i = blockIdx.x * blockDim.x + threadIdx.x; i < n; i += gridDim.x * blockDim.x) out[i] = v; }

#if MK_DEBUG
__global__ void k_hash(const unsigned* p, size_t nwords, unsigned long long* out, unsigned poison) {
    unsigned long long s = 0;
    for (size_t i = (size_t)blockIdx.x * blockDim.x + threadIdx.x; i < nwords; i += (size_t)gridDim.x * blockDim.x) { const unsigned w = p[i]; if (w != poison) s += (unsigned long long)w * (2ull * i + 1ull); }
    for (int o = 32; o >= 1; o >>= 1) s += __shfl_xor(s, o);
    if ((threadIdx.x & 63) == 0) atomicAdd(out, s);
}
__global__ void k_dbg_final(const unsigned long long* ha, const unsigned long long* hb, int nph, float* code) {
    if (threadIdx.x == 0 && blockIdx.x == 0) { int first = -1, cnt = 0;
        for (int i = 0; i < nph; ++i) if (ha[i] != hb[i]) { if (first < 0) first = i; ++cnt; }
        float v;
        if (first < 0) v = 5000.f;
        else { v = (float)(10 + first % 90); if (first >= 90) v *= 100.f; if (cnt > 1) v *= 1.0f; }
        code[0] = sqrtf(v - 1.0f); }
}
__global__ void k_fill_from(float* out, int n, const float* v) { const float x = v[0]; for (int i = blockIdx.x * blockDim.x + threadIdx.x; i < n; i += gridDim.x * blockDim.x) out[i] = x; }
static void dbg_run(KArgs a, int grid, hipStream_t stream) {
    const int NPHASES = DEPTH * NPH;
    unsigned long long* H = (unsigned long long*)(a.ws + WS_CTL) + CW_DBG / 2;
    float* code = (float*)(a.ws + WS_CTL) + CW_DBG + 1024;
    for (int run = 0; run < 2; ++run) {
        const int pb = run ? 0x55 : 0xAA; const unsigned pw = run ? 0x55555555u : 0xAAAAAAAAu;
        (void)hipMemsetAsync((char*)a.ws + CTL_ZERO_BYTES, pb, WS_END - CTL_ZERO_BYTES, stream);
        (void)hipMemsetAsync((char*)a.out, pb, (size_t)M * D * 4, stream);
        for (int ph = 0; ph < NPHASES; ++ph) {
            const int nsub = (ph % NPH == 3) ? 2 : 1;
            for (int sub = 0; sub < nsub; ++sub) {
                a.ph_lo = ph; a.ph_hi = ph + 1; a.dbg = nsub == 2 ? sub + 1 : 0; mk_fwd<<<grid, 512, LDS_BYTES, stream>>>(a);
                unsigned long long* h = H + run * 160 + 2 * ph + sub;
                k_hash<<<2048, 256, 0, stream>>>((const unsigned*)(a.ws + CTL_ZERO_BYTES), (WS_END - CTL_ZERO_BYTES) / 4, h, pw);
                k_hash<<<2048, 256, 0, stream>>>((const unsigned*)a.out, (size_t)M * D, h, pw);
            }
        }
    }
    k_dbg_final<<<1, 64, 0, stream>>>(H, H + 160, 160, code);
    k_fill_from<<<1024, 256, 0, stream>>>(a.out, M * D, code);
}
#endif

extern "C" void kernel_launch(void* const* d_in, const int* in_sizes, int n_in, void* d_out, int out_size, void* d_ws, size_t ws_size, hipStream_t stream) {
    static int grid = 0;
    if (grid == 0) {
        if (n_in != 27 || out_size != M * D || ws_size < WS_END) {
            fprintf(stderr, "kernel_launch: unexpected shapes / workspace (n_in %d, out %d, ws %zu < %zu)\n", n_in, out_size, ws_size, (size_t)WS_END);
            grid = -1;
        } else {
            int dev = 0, cus = 0, per_cu = 0;
            hipGetDevice(&dev); hipDeviceGetAttribute(&cus, hipDeviceAttributeMultiprocessorCount, dev);
            hipFuncSetAttribute((const void*)mk_fwd, hipFuncAttributeMaxDynamicSharedMemorySize, LDS_BYTES);
            hipOccupancyMaxActiveBlocksPerMultiprocessor(&per_cu, (const void*)mk_fwd, 512, LDS_BYTES);
            (void)hipGetLastError();
            grid = cus;
        }
    }
    if (grid < 0) { k_fill<<<1024, 256, 0, stream>>>((float*)d_out, out_size, ws_size < WS_END ? 3.0e8f : 2.0e8f); return; }
    hipMemsetAsync((char*)d_ws + WS_CTL, 0, CTL_ZERO_BYTES, stream);
    KArgs a{};
    for (int i = 0; i < 27; ++i) a.in[i] = (const float*)d_in[i];
    a.out = (float*)d_out; a.ws = (unsigned char*)d_ws; a.dbg = 0; a.pad = 0;
    const int NPHASES = DEPTH * NPH;
#if MK_DEBUG
    dbg_run(a, grid, stream);
#elif MK_LAUNCH_PER_PHASE
    for (int ph = 0; ph < NPHASES; ++ph) { a.ph_lo = ph; a.ph_hi = ph + 1; mk_fwd<<<grid, 512, LDS_BYTES, stream>>>(a); }
#else
    a.ph_lo = 0; a.ph_hi = NPHASES;
    mk_fwd<<<grid, 512, LDS_BYTES, stream>>>(a);
#endif
}
```
